# Optimizing an MI355X kernel written in HIP

```python
import jax, jax.numpy as jnp
from jax import lax
import numpy as np

D_MODEL = 2048
BATCH = 4
SEQ = 2048
DEPTH = 4

ATT_HEADS = 12
ATT_KV_HEADS = 4
HEAD_DIM = 64
WINDOW = 128
ATT_BLOCK = 128
ROPE_THETA = 10000.0
ATT_Q_W = ATT_HEADS * HEAD_DIM
ATT_KV_W = ATT_KV_HEADS * HEAD_DIM
POOL_WINDOWS = (2, 4, 8, 16)
POOL_GROUPS = 4
POOL_GROUP_DIM = 192
POOL_WIDTH = POOL_GROUPS * POOL_GROUP_DIM
GLA_HEADS = 4
GLA_DK = 96
GLA_DV = 192
GLA_QK_W = GLA_HEADS * GLA_DK
GLA_V_W = GLA_HEADS * GLA_DV
GLA_LOWRANK = 16
GLA_TAU = 16.0
GLA_CHUNK = 64
N_BRANCH = 3
D_FF = 5632
EPS = 1e-6
W_IN_COLS = ATT_Q_W + 2 * ATT_KV_W + POOL_WIDTH + 2 * GLA_QK_W + 2 * GLA_V_W + GLA_LOWRANK + N_BRANCH * D_MODEL

kernel_name = "hybrid_gated_swa_pool_gla_macaron"


def rms_norm(x, g):
    xf = x.astype(jnp.float32)
    y = xf * lax.rsqrt(jnp.mean(xf * xf, axis=-1, keepdims=True) + EPS)
    return (y * g.astype(jnp.float32)).astype(x.dtype)


def swiglu(h, wi, wo):
    a, b = jnp.split(h @ wi, 2, axis=-1)
    return (jax.nn.silu(a) * b) @ wo


def rope(x, positions):
    half = HEAD_DIM // 2
    inv_freq = ROPE_THETA ** (-jnp.arange(half, dtype=jnp.float32) / half)
    ang = positions.astype(jnp.float32)[..., None] * inv_freq
    cos = jnp.cos(ang)[:, :, None, :]
    sin = jnp.sin(ang)[:, :, None, :]
    xf = x.astype(jnp.float32)
    x1, x2 = xf[..., :half], xf[..., half:]
    out = jnp.concatenate([x1 * cos - x2 * sin, x2 * cos + x1 * sin], axis=-1)
    return out.astype(x.dtype)


def sliding_window_sink_attention(q, k, v, sinks):
    B, S, H, Dh = q.shape
    nb = S // ATT_BLOCK
    G = H // ATT_KV_HEADS
    qb = q.reshape(B, nb, ATT_BLOCK, ATT_KV_HEADS, G, Dh)
    kb = k.reshape(B, nb, ATT_BLOCK, ATT_KV_HEADS, Dh)
    vb = v.reshape(B, nb, ATT_BLOCK, ATT_KV_HEADS, Dh)
    pad = ((0, 0), (1, 0), (0, 0), (0, 0), (0, 0))
    kw = jnp.concatenate([jnp.pad(kb, pad)[:, :-1], kb], axis=2)
    vw = jnp.concatenate([jnp.pad(vb, pad)[:, :-1], vb], axis=2)
    s = jnp.einsum('bnqkgd,bnskd->bnkgqs', qb, kw, preferred_element_type=jnp.float32) * (HEAD_DIM ** -0.5)
    qi = jnp.arange(ATT_BLOCK)[:, None]
    si = jnp.arange(2 * ATT_BLOCK)[None, :]
    rel = ATT_BLOCK + qi - si
    band = (rel >= 0) & (rel < WINDOW)
    has_prev = (jnp.arange(nb) > 0)[:, None, None] | (si >= ATT_BLOCK)[None]
    mask = band[None] & has_prev
    s = jnp.where(mask[None, :, None, None], s, -jnp.inf)
    sink = sinks.astype(jnp.float32).reshape(ATT_KV_HEADS, G)[None, None, :, :, None, None]
    sink_col = jnp.broadcast_to(sink, s.shape[:-1] + (1,))
    p = jax.nn.softmax(jnp.concatenate([s, sink_col], axis=-1), axis=-1)[..., :-1]
    o = jnp.einsum('bnkgqs,bnskd->bnqkgd', p.astype(v.dtype), vw)
    return o.reshape(B, S, H * Dh)


def pool_mixer(u, w_pool, pool_scale):
    B, S, _ = u.shape
    uf = u.astype(jnp.float32)
    c = jnp.pad(jnp.cumsum(uf, axis=1), ((0, 0), (1, 0), (0, 0)))
    outs = []
    for gi, w in enumerate(POOL_WINDOWS):
        sl = slice(gi * POOL_GROUP_DIM, (gi + 1) * POOL_GROUP_DIM)
        cg = c[..., sl]
        upper = cg[:, 1:]
        lower = jnp.pad(cg, ((0, 0), (w - 1, 0), (0, 0)))[:, :S]
        cnt = jnp.minimum(jnp.arange(1, S + 1), w).astype(jnp.float32)[None, :, None]
        outs.append((upper - lower) / cnt - uf[..., sl])
    d = jnp.stack(outs, axis=2)
    y = jnp.einsum('bsgc,gcd->bsgd', d, w_pool.astype(jnp.float32)).reshape(B, S, POOL_WIDTH)
    return (y * pool_scale.astype(jnp.float32)).astype(u.dtype)


def gla_chunked(q, k, v, gk):
    B, S, H, dk = q.shape
    dv = v.shape[-1]
    nc = S // GLA_CHUNK

    def to_chunks(a):
        return a.reshape(B, nc, GLA_CHUNK, H, a.shape[-1]).transpose(1, 0, 3, 2, 4)

    q, k, v, gk = to_chunks(q * (GLA_DK ** -0.5)), to_chunks(k), to_chunks(v), to_chunks(gk)
    b = jnp.cumsum(gk, axis=3)
    b_last = b[..., -1:, :]
    q_t = q * jnp.exp(b)
    k_t = k * jnp.exp(-b)
    k_s = k * jnp.exp(b_last - b)
    causal = jnp.tril(jnp.ones((GLA_CHUNK, GLA_CHUNK), dtype=bool))
    a = jnp.where(causal, jnp.einsum('nbhid,nbhjd->nbhij', q_t, k_t), 0.0)
    o_intra = jnp.einsum('nbhij,nbhjv->nbhiv', a, v)

    def step(state, inp):
        qn, kn, vn, decay = inp
        o = jnp.einsum('bhid,bhdv->bhiv', qn, state)
        state = state * decay[:, :, 0, :, None] + jnp.einsum('bhjd,bhjv->bhdv', kn, vn)
        return state, o

    s0 = jnp.zeros((B, H, dk, dv), jnp.float32)
    _, o_inter = lax.scan(step, s0, (q_t, k_s, v, jnp.exp(b_last)))
    o = o_intra + o_inter
    return o.transpose(1, 0, 3, 2, 4).reshape(B, S, H, dv)


def hybrid_mixer(h, positions, w_in, b_gate, att_sinks, w_pool, pool_scale, w_gla_a2, b_gla_a,
                 gla_norm, w_br_att, w_br_pool, w_br_gla, w_out):
    B, S, _ = h.shape
    proj = h @ w_in
    sizes = [ATT_Q_W, ATT_KV_W, ATT_KV_W, POOL_WIDTH, GLA_QK_W, GLA_QK_W, GLA_V_W, GLA_V_W, GLA_LOWRANK]
    points, acc = [], 0
    for sz in sizes:
        acc += sz
        points.append(acc)
    qa, ka, va, pu, qg, kg, vg, og, lr, gate_logits = jnp.split(proj, points, axis=-1)

    qa = rope(qa.reshape(B, S, ATT_HEADS, HEAD_DIM), positions)
    ka = rope(ka.reshape(B, S, ATT_KV_HEADS, HEAD_DIM), positions)
    va = va.reshape(B, S, ATT_KV_HEADS, HEAD_DIM)
    y_att = sliding_window_sink_attention(qa, ka, va, att_sinks)

    y_pool = pool_mixer(pu, w_pool, pool_scale)

    f32 = jnp.float32
    gk = jax.nn.log_sigmoid((lr @ w_gla_a2).astype(f32) + b_gla_a.astype(f32)) / GLA_TAU
    o = gla_chunked(qg.astype(f32).reshape(B, S, GLA_HEADS, GLA_DK),
                    kg.astype(f32).reshape(B, S, GLA_HEADS, GLA_DK),
                    vg.astype(f32).reshape(B, S, GLA_HEADS, GLA_DV),
                    gk.reshape(B, S, GLA_HEADS, GLA_DK))
    o = o * lax.rsqrt(jnp.mean(o * o, axis=-1, keepdims=True) + EPS)
    o = o.reshape(B, S, GLA_V_W) * gla_norm.astype(f32) * jax.nn.silu(og.astype(f32))
    y_gla = o.astype(h.dtype)

    gates = jax.nn.sigmoid(gate_logits.astype(f32) + b_gate.astype(f32)).reshape(B, S, N_BRANCH, D_MODEL)
    merged = (gates[:, :, 0] * (y_att @ w_br_att).astype(f32)
              + gates[:, :, 1] * (y_pool @ w_br_pool).astype(f32)
              + gates[:, :, 2] * (y_gla @ w_br_gla).astype(f32))
    return merged.astype(h.dtype) @ w_out


def setup_inputs(seed: int = 0) -> dict:
    key = jax.random.key(seed)
    ks = jax.random.split(key, 24)
    L, D, F = DEPTH, D_MODEL, D_FF

    def nrm(k, shape, scale):
        return jax.random.normal(k, shape, jnp.float32) * scale

    def gain(k, shape):
        return 1.0 + 0.02 * jax.random.normal(k, shape, jnp.float32)

    offsets = jax.random.randint(ks[1], (BATCH, 1), 0, 4096, dtype=jnp.int32)
    positions = offsets + jnp.arange(SEQ, dtype=jnp.int32)[None, :]
    return {
        "x": jax.random.normal(ks[0], (BATCH, SEQ, D), jnp.float32),
        "positions": positions,
        "norm_ffn1": gain(ks[2], (L, D)),
        "ffn1_wi": nrm(ks[3], (L, D, 2 * F), D ** -0.5),
        "ffn1_wo": nrm(ks[4], (L, F, D), F ** -0.5),
        "norm_mix": gain(ks[5], (L, D)),
        "w_in": nrm(ks[6], (L, D, W_IN_COLS), D ** -0.5),
        "b_gate": nrm(ks[7], (L, N_BRANCH * D), 0.02),
        "att_sinks": nrm(ks[8], (L, ATT_HEADS), 0.5),
        "w_pool": nrm(ks[9], (L, POOL_GROUPS, POOL_GROUP_DIM, POOL_GROUP_DIM), POOL_GROUP_DIM ** -0.5),
        "pool_scale": gain(ks[10], (L, POOL_WIDTH)),
        "w_gla_a2": nrm(ks[11], (L, GLA_LOWRANK, GLA_QK_W), GLA_LOWRANK ** -0.5),
        "b_gla_a": nrm(ks[12], (L, GLA_QK_W), 0.1),
        "gla_norm": gain(ks[13], (L, GLA_V_W)),
        "w_br_att": nrm(ks[14], (L, ATT_Q_W, D), ATT_Q_W ** -0.5),
        "w_br_pool": nrm(ks[15], (L, POOL_WIDTH, D), POOL_WIDTH ** -0.5),
        "w_br_gla": nrm(ks[16], (L, GLA_V_W, D), GLA_V_W ** -0.5),
        "w_out": nrm(ks[17], (L, D, D), D ** -0.5),
        "norm_ffn2": gain(ks[18], (L, D)),
        "ffn2_wi": nrm(ks[19], (L, D, 2 * F), D ** -0.5),
        "ffn2_wo": nrm(ks[20], (L, F, D), F ** -0.5),
        "norm_final": gain(ks[21], (D,)),
    }


def reference(x, positions, norm_ffn1, ffn1_wi, ffn1_wo, norm_mix, w_in, b_gate, att_sinks, w_pool,
              pool_scale, w_gla_a2, b_gla_a, gla_norm, w_br_att, w_br_pool, w_br_gla, w_out,
              norm_ffn2, ffn2_wi, ffn2_wo, norm_final):
    for l in range(DEPTH):
        x = x + 0.5 * swiglu(rms_norm(x, norm_ffn1[l]), ffn1_wi[l], ffn1_wo[l])
        h = rms_norm(x, norm_mix[l])
        x = x + hybrid_mixer(h, positions, w_in[l], b_gate[l], att_sinks[l], w_pool[l], pool_scale[l],
                             w_gla_a2[l], b_gla_a[l], gla_norm[l], w_br_att[l], w_br_pool[l],
                             w_br_gla[l], w_out[l])
        x = x + 0.5 * swiglu(rms_norm(x, norm_ffn2[l]), ffn2_wi[l], ffn2_wo[l])
    return rms_norm(x, norm_final)
```

```cpp
#include <hip/hip_runtime.h>
#include <cstdio>
#include <cstdint>
#include <cmath>
namespace pg8 {
#define PG8_LAS __attribute__((address_space(3)))
typedef unsigned short bf16_t;
typedef short bf16x8 __attribute__((ext_vector_type(8)));
typedef float f32x4 __attribute__((ext_vector_type(4)));
typedef unsigned u32x4 __attribute__((ext_vector_type(4)));
constexpr int BM = 256, BK = 64, HALF = 128, HTB = HALF * BK * 2  , STAGE_BYTES = 8 * HTB, NXCD = 8, WGM = 8;

__host__ __device__ __forceinline__ int lds_byte(int r, int c) { const int st = (r >> 4) * 2 + (c >> 5), rr = r & 15, cc = c & 31, ob = rr * 64 + cc * 2; return st * 1024 + (ob ^ (((ob >> 9) & 1) << 5)); }
__host__ __device__ __forceinline__ void stage_rc(int b, int& R, int& C) { const int st = b / 1024, sb = b % 1024, swz = sb ^ (((sb >> 9) & 1) << 5); R = (st >> 1) * 16 + swz / 64; C = (st & 1) * 32 + (swz % 64) / 2; }
__host__ __device__ __forceinline__ int perm32(int rho) { const int n = rho >> 4, i = rho & 15; return 8 * (i >> 2) + 4 * n + (i & 3); }

__host__ __device__ __forceinline__ size_t blk_off(int r, int c, int C) { return ((size_t)(r >> 6) * (size_t)(C >> 6) + (size_t)(c >> 6)) * 4096 + (size_t)(r & 63) * 64 + (size_t)(c & 63); }
struct Unit { int pm, pn, seg; };
struct Gemm { const bf16_t* A; const bf16_t* Bt; int M, N, K; size_t segA = 0, segB = 0; };

struct StaticOrder {
    int nM, nN, nwg, G, c;
    __host__ __device__ void init(int M, int N, int G_, int c_) { nM = M / BM; nN = N / BM; nwg = nM * nN; G = G_; c = c_; }
    __host__ __device__ bool next(int i, Unit& u) const {
        const long L = (long)i * G + c; if (L >= nwg) return false;
        int wgid = (int)L; { const int q = nwg / NXCD, r = nwg % NXCD, xcd = wgid % NXCD, off = wgid / NXCD; wgid = (xcd < r ? xcd * (q + 1) : r * (q + 1) + (xcd - r) * q) + off; }
        const int nig = WGM * nN, gid = wgid / nig, fm = gid * WGM, gsz = (nM - fm) < WGM ? (nM - fm) : WGM;
        u.pm = fm + ((wgid % nig) % gsz); u.pn = (wgid % nig) / gsz; u.seg = 0; return true;
    }
    __device__ __forceinline__ void a_ready(const Unit&) const {}
    __device__ __forceinline__ void done(const Unit&) const {}
};
struct RangeOrder : StaticOrder { int i0, n;
    __host__ __device__ bool next(int i, Unit& u) const { if (i >= n) return false; return StaticOrder::next(i + i0, u); } };
struct SegOrder : StaticOrder { int nseg;
    __host__ __device__ bool next(int i, Unit& u) const { const int t = i / nseg; if (!StaticOrder::next(t, u)) return false; u.seg = i - t * nseg; return true; } };
__device__ __forceinline__ unsigned cvt_pk_bf16(float lo, float hi) { unsigned r; asm volatile("v_cvt_pk_bf16_f32 %0, %1, %2" : "=v"(r) : "v"(lo), "v"(hi)); return r; }
typedef float f32x2 __attribute__((ext_vector_type(2)));
__device__ __forceinline__ float bf_lo(unsigned w) { return __uint_as_float(w << 16); }
__device__ __forceinline__ float bf_hi(unsigned w) { return __uint_as_float(w & 0xffff0000u); }
__device__ __forceinline__ float sigmoid_f(float v) { return __builtin_amdgcn_rcpf(1.0f + __builtin_amdgcn_exp2f(v * -1.4426950408889634f)); }
__device__ __forceinline__ float rstd_of(unsigned long long q) { return 1.0f / sqrtf((float)q * (1.0f / 1048576.0f / 2048.0f) + 1e-6f); }
#define PG8_LOAD_RSTD(rs, ssq, row0) float rs[2][4]; { unsigned long long q_[2][4]; _Pragma("unroll") for (int ai = 0; ai < 2; ++ai) _Pragma("unroll") for (int m = 0; m < 4; ++m) q_[ai][m] = (ssq)[(row0) + ai * HALF + m * 16]; \
    _Pragma("unroll") for (int ai = 0; ai < 2; ++ai) _Pragma("unroll") for (int m = 0; m < 4; ++m) rs[ai][m] = rstd_of(q_[ai][m]); }
struct EpiSwiglu {
    static constexpr bool PERM = true, AFTER_DRAIN = false, SEGMENTED = false;
    bf16_t* O; int ldo; const unsigned long long* ssq;
    __device__ __forceinline__ void operator()(const f32x4 (&acc)[2][2][4][2], const Unit& u, int wr, int wc, int fr, int fq) const {
        const int row0 = u.pm * BM + wr * 64 + fr, hid0 = u.pn * HALF + wc * 32 + 8 * fq;
        PG8_LOAD_RSTD(rsv, ssq, row0)
#pragma unroll
        for (int ai = 0; ai < 2; ++ai)
#pragma unroll
            for (int m = 0; m < 4; ++m) { const int row = row0 + ai * HALF + m * 16; bf16_t* rowp = O + blk_off(row, hid0, ldo);
                const float rs = rsv[ai][m];
                f32x4 v0, v1;
#pragma unroll
                for (int j = 0; j < 4; ++j) { const float a0 = acc[ai][0][m][0][j] * rs, a1 = acc[ai][0][m][1][j] * rs;
                    v0[j] = a0 * sigmoid_f(a0) * (acc[ai][1][m][0][j] * rs); v1[j] = a1 * sigmoid_f(a1) * (acc[ai][1][m][1][j] * rs); }
                u32x4 w; w.x = cvt_pk_bf16(v0[0], v0[1]); w.y = cvt_pk_bf16(v0[2], v0[3]); w.z = cvt_pk_bf16(v1[0], v1[1]); w.w = cvt_pk_bf16(v1[2], v1[3]);
                *(u32x4*)rowp = w; }
    }
};
struct EpiResid {
    static constexpr bool PERM = true, AFTER_DRAIN = false, SEGMENTED = false;
    bf16_t* xb; unsigned long long* ssq_next; int ldc; float scale;
    __device__ __forceinline__ void operator()(const f32x4 (&acc)[2][2][4][2], const Unit& u, int wr, int wc, int fr, int fq) const {
        const int row0 = u.pm * BM + wr * 64 + fr, col0 = u.pn * BM + wc * 32 + 8 * fq;
#pragma unroll
        for (int ai = 0; ai < 2; ++ai) {
            u32x4 t[4][2];
#pragma unroll
            for (int m = 0; m < 4; ++m)
#pragma unroll
                for (int bj = 0; bj < 2; ++bj) t[m][bj] = *(const u32x4*)(xb + blk_off(row0 + ai * HALF + m * 16, col0 + bj * HALF, ldc));
#pragma unroll
            for (int m = 0; m < 4; ++m) { const int row = row0 + ai * HALF + m * 16; float ss = 0.f;
#pragma unroll
                for (int bj = 0; bj < 2; ++bj) { const u32x4 x = t[m][bj];
                    f32x4 v0 = (f32x4){bf_lo(x.x), bf_hi(x.x), bf_lo(x.y), bf_hi(x.y)} + acc[ai][bj][m][0] * scale, v1 = (f32x4){bf_lo(x.z), bf_hi(x.z), bf_lo(x.w), bf_hi(x.w)} + acc[ai][bj][m][1] * scale;
                    u32x4 w; w.x = cvt_pk_bf16(v0[0], v0[1]); w.y = cvt_pk_bf16(v0[2], v0[3]); w.z = cvt_pk_bf16(v1[0], v1[1]); w.w = cvt_pk_bf16(v1[2], v1[3]);
                    *(u32x4*)(xb + blk_off(row, col0 + bj * HALF, ldc)) = w;
                    ss += (v0[0] * v0[0] + v0[1] * v0[1]) + (v0[2] * v0[2] + v0[3] * v0[3]) + (v1[0] * v1[0] + v1[1] * v1[1]) + (v1[2] * v1[2] + v1[3] * v1[3]); }
                ss += __shfl_xor(ss, 16); ss += __shfl_xor(ss, 32);
                if (fq == 0) atomicAdd(ssq_next + row, (unsigned long long)(ss * 1048576.0f + 0.5f)); } }
    }
};
struct EpiProj {
    static constexpr bool PERM = true, AFTER_DRAIN = false, SEGMENTED = false;
    bf16_t* O; int ldo; const float* bias; int gate_tile0; const unsigned long long* ssq;
    __device__ __forceinline__ void operator()(const f32x4 (&acc)[2][2][4][2], const Unit& u, int wr, int wc, int fr, int fq) const {
        const int row0 = u.pm * BM + wr * 64 + fr, col0 = u.pn * BM + wc * 32 + 8 * fq;
        const bool gate = u.pn >= gate_tile0;
        PG8_LOAD_RSTD(rsv, ssq, row0)
        f32x4 bv[2][2];
#pragma unroll
        for (int bj = 0; bj < 2; ++bj)
#pragma unroll
            for (int n = 0; n < 2; ++n) bv[bj][n] = gate ? *(const f32x4*)(bias + (col0 - gate_tile0 * BM) + bj * HALF + 4 * n) : (f32x4){0.f, 0.f, 0.f, 0.f};
#pragma unroll
        for (int ai = 0; ai < 2; ++ai)
#pragma unroll
            for (int m = 0; m < 4; ++m) { const int row = row0 + ai * HALF + m * 16; bf16_t* rowp = O + (size_t)row * ldo + col0;
                const float rs = rsv[ai][m];
#pragma unroll
                for (int bj = 0; bj < 2; ++bj) { f32x4 v0 = acc[ai][bj][m][0] * rs + bv[bj][0], v1 = acc[ai][bj][m][1] * rs + bv[bj][1];
                    if (gate) {
#pragma unroll
                        for (int j = 0; j < 4; ++j) { v0[j] = sigmoid_f(v0[j]); v1[j] = sigmoid_f(v1[j]); } }
                    u32x4 w; w.x = cvt_pk_bf16(v0[0], v0[1]); w.y = cvt_pk_bf16(v0[2], v0[3]); w.z = cvt_pk_bf16(v1[0], v1[1]); w.w = cvt_pk_bf16(v1[2], v1[3]);
                    *(u32x4*)(rowp + bj * HALF) = w; } }
    }
};
struct EpiMergeSeg {
    static constexpr bool PERM = true, AFTER_DRAIN = false, SEGMENTED = true;
    const bf16_t* gate; int ldg; int gseg; bf16_t* outb; int ldc;
    __device__ __forceinline__ bool run(f32x4 (&acc)[2][2][4][2], const Unit& u, int wr, int wc, int fr, int fq) const {
        const int row0 = u.pm * BM + wr * 64 + fr, col0 = u.pn * BM + wc * 32 + 8 * fq;
        const bf16_t* gs = gate + (size_t)u.seg * gseg; const bool last = u.seg == 2;
#pragma unroll
        for (int ai = 0; ai < 2; ++ai) {
            u32x4 ga[4][2], gb[4][2];
#pragma unroll
            for (int m = 0; m < 4; ++m)
#pragma unroll
                for (int bj = 0; bj < 2; ++bj) { const size_t p = (size_t)(row0 + ai * HALF + m * 16) * ldg + col0 + bj * HALF;
                    ga[m][bj] = *(const u32x4*)(gs + p); gb[m][bj] = last ? ga[m][bj] : *(const u32x4*)(gs + gseg + p); }
#pragma unroll
            for (int m = 0; m < 4; ++m)
#pragma unroll
                for (int bj = 0; bj < 2; ++bj) { const u32x4 a = ga[m][bj], b = gb[m][bj];
                    float f[8] = {bf_lo(a.x), bf_hi(a.x), bf_lo(a.y), bf_hi(a.y), bf_lo(a.z), bf_hi(a.z), bf_lo(a.w), bf_hi(a.w)};
                    if (!last) { const float d[8] = {bf_lo(b.x), bf_hi(b.x), bf_lo(b.y), bf_hi(b.y), bf_lo(b.z), bf_hi(b.z), bf_lo(b.w), bf_hi(b.w)};
#pragma unroll
                        for (int j = 0; j < 8; ++j) f[j] *= __builtin_amdgcn_rcpf(fmaxf(d[j], 1e-20f)); }
                    f32x4 v0 = acc[ai][bj][m][0], v1 = acc[ai][bj][m][1];
                    v0[0] *= f[0]; v0[1] *= f[1]; v0[2] *= f[2]; v0[3] *= f[3]; v1[0] *= f[4]; v1[1] *= f[5]; v1[2] *= f[6]; v1[3] *= f[7];
                    acc[ai][bj][m][0] = v0; acc[ai][bj][m][1] = v1;
                    if (last) { u32x4 w; w.x = cvt_pk_bf16(v0[0], v0[1]); w.y = cvt_pk_bf16(v0[2], v0[3]); w.z = cvt_pk_bf16(v1[0], v1[1]); w.w = cvt_pk_bf16(v1[2], v1[3]);
                        *(u32x4*)(outb + blk_off(row0 + ai * HALF + m * 16, col0 + bj * HALF, ldc)) = w; } } }
        return last;
    }
};

template <class Epi, class Sched, bool ALIGN_EPI = false, bool SP2 = false>
__device__ __forceinline__ void gemm_phase(PG8_LAS unsigned char* lds, const Gemm g, const Sched& S, const Epi& E) {
    int tid_o = threadIdx.x; asm volatile("" : "+v"(tid_o));
    const int tid = tid_o, wid = __builtin_amdgcn_readfirstlane(tid >> 6), lane = tid & 63, wr = wid >> 2, wc = wid & 3, fr = lane & 15, fq = lane >> 4;
    const int K = g.K, nt = K / BK;
    unsigned voffA[2], voffB[2];
#pragma unroll
    for (int i = 0; i < 2; ++i) { int R, C; stage_rc(tid * 16 + i * 8192, R, C); const int Rb = Epi::PERM ? ((R & ~31) + perm32(R & 31)) : R;
        voffA[i] = (unsigned)((R >> 6) * (K >> 6) * 4096 + (R & 63) * 64 + C) * 2u; voffB[i] = (unsigned)((Rb >> 6) * (K >> 6) * 4096 + (Rb & 63) * 64 + C) * 2u; }
    const size_t kstep = (size_t)8192;
    const size_t hstep = (size_t)2 * (K >> 6) * 8192;
    const size_t tstep = 2 * hstep;
    const unsigned ldsw = (unsigned)wid * 1024u;
    const int aoff = lds_byte(wr * 64 + fr, fq * 8), boff = lds_byte(wc * 32 + fr, fq * 8);
#define PG8_SA(b, h) (((b) * 2 + (h)) * HTB)
#define PG8_SB(b, h) ((4 + (b) * 2 + (h)) * HTB)
#define PG8_STAGE(bufoff, gbase, voff) do { _Pragma("unroll") for (int _i = 0; _i < 2; ++_i) \
        __builtin_amdgcn_global_load_lds((const unsigned*)((const char*)(gbase) + (voff)[_i]), (PG8_LAS unsigned*)(lds + (bufoff) + ldsw + _i * 8192), 16, 0, 0); } while (0)
#define PG8_LDA(dst, b, h) do { _Pragma("unroll") for (int m = 0; m < 4; ++m) _Pragma("unroll") for (int k = 0; k < 2; ++k) dst[m][k] = *(const PG8_LAS bf16x8*)(lds + PG8_SA(b, h) + aoff + m * 2048 + k * 1024); } while (0)
#define PG8_LDB(dst, b, h) do { _Pragma("unroll") for (int n = 0; n < 2; ++n) _Pragma("unroll") for (int k = 0; k < 2; ++k) dst[n][k] = *(const PG8_LAS bf16x8*)(lds + PG8_SB(b, h) + boff + n * 2048 + k * 1024); } while (0)
#define PG8_MMA(ai, bj, At, Bt) do { __builtin_amdgcn_s_setprio(1); _Pragma("unroll") for (int m = 0; m < 4; ++m) _Pragma("unroll") for (int n = 0; n < 2; ++n) _Pragma("unroll") for (int k = 0; k < 2; ++k) \
        acc[ai][bj][m][n] = __builtin_amdgcn_mfma_f32_16x16x32_bf16(Bt[n][k], At[m][k], acc[ai][bj][m][n], 0, 0, 0); __builtin_amdgcn_s_setprio(0); } while (0)
#define PG8_WAIT_V(n) asm volatile("s_waitcnt vmcnt(" #n ")" ::: "memory")
#define PG8_WAIT_L(n) asm volatile("s_waitcnt lgkmcnt(" #n ")" ::: "memory")
#define PG8_BAR __builtin_amdgcn_s_barrier()
#define PG8_SCHED __builtin_amdgcn_sched_barrier(0)
    Unit cur, nxt; int ui = 0;
    if (!S.next(0, cur)) return;
    f32x4 acc[2][2][4][2];
#pragma unroll
    for (int a = 0; a < 2; ++a)
#pragma unroll
        for (int b = 0; b < 2; ++b)
#pragma unroll
            for (int m = 0; m < 4; ++m)
#pragma unroll
                for (int n = 0; n < 2; ++n) acc[a][b][m][n] = (f32x4){0.f, 0.f, 0.f, 0.f};
    bf16x8 At[4][2], B0[2][2], B1[2][2];
    const char* cA = (const char*)g.A + (size_t)cur.pm * tstep + (size_t)cur.seg * g.segA; const char* cB = (const char*)g.Bt + (size_t)cur.pn * tstep + (size_t)cur.seg * g.segB;
    S.a_ready(cur);
    if constexpr (SP2) {
        PG8_STAGE(PG8_SB(0, 0), cB, voffB); PG8_STAGE(PG8_SB(0, 1), cB + hstep, voffB); PG8_STAGE(PG8_SA(0, 0), cA, voffA); PG8_STAGE(PG8_SA(0, 1), cA + hstep, voffA);
        if (wr == 1) PG8_BAR;
        PG8_WAIT_V(2); PG8_BAR;
        PG8_STAGE(PG8_SB(1, 0), cB + kstep, voffB); PG8_STAGE(PG8_SA(1, 0), cA + kstep, voffA); PG8_STAGE(PG8_SB(1, 1), cB + hstep + kstep, voffB);
        PG8_WAIT_V(6); PG8_BAR;
    } else {
        PG8_STAGE(PG8_SB(0, 0), cB, voffB); PG8_STAGE(PG8_SA(0, 0), cA, voffA); PG8_STAGE(PG8_SB(0, 1), cB + hstep, voffB); PG8_STAGE(PG8_SA(0, 1), cA + hstep, voffA);
        if (wr == 1) PG8_BAR;
        PG8_WAIT_V(4); PG8_BAR;
        PG8_STAGE(PG8_SB(1, 0), cB + kstep, voffB); PG8_STAGE(PG8_SA(1, 0), cA + kstep, voffA); PG8_STAGE(PG8_SB(1, 1), cB + hstep + kstep, voffB);
        PG8_WAIT_V(6); PG8_BAR;
    }
    for (;;) {
        const bool has_next = S.next(ui + 1, nxt);
        const char* nA = has_next ? (const char*)g.A + (size_t)nxt.pm * tstep + (size_t)nxt.seg * g.segA : cA; const char* nB = has_next ? (const char*)g.Bt + (size_t)nxt.pn * tstep + (size_t)nxt.seg * g.segB : cB;
        for (int t = 0; t < nt; t += 2) {
            const bool last = (t == nt - 2);
            const char* a1 = cA + (size_t)(t + 1) * kstep;
            const char* a2 = last ? nA : cA + (size_t)(t + 2) * kstep; const char* b2 = last ? nB : cB + (size_t)(t + 2) * kstep;
            const char* a3 = a2 + kstep; const char* b3 = b2 + kstep;
            if (last && has_next) S.a_ready(nxt);
            if constexpr (SP2) {
            PG8_LDB(B0, 0, 0); PG8_LDB(B1, 0, 1); PG8_SCHED; PG8_LDA(At, 0, 0); PG8_STAGE(PG8_SA(1, 1), a1 + hstep, voffA);
            PG8_WAIT_V(8); PG8_WAIT_L(0); PG8_BAR; PG8_MMA(0, 0, At, B0); PG8_MMA(0, 1, At, B1); PG8_BAR; PG8_SCHED;
            PG8_LDA(At, 0, 1); PG8_STAGE(PG8_SB(0, 0), b2, voffB); PG8_STAGE(PG8_SB(0, 1), b2 + hstep, voffB); PG8_STAGE(PG8_SA(0, 0), a2, voffA);
            PG8_WAIT_V(8); PG8_WAIT_L(0); PG8_BAR; PG8_MMA(1, 0, At, B0); PG8_MMA(1, 1, At, B1); PG8_BAR; PG8_SCHED;
            PG8_LDB(B0, 1, 0); PG8_LDB(B1, 1, 1); PG8_SCHED; PG8_LDA(At, 1, 0); PG8_STAGE(PG8_SA(0, 1), a2 + hstep, voffA);
            PG8_WAIT_V(8); PG8_WAIT_L(0); PG8_BAR; PG8_MMA(0, 0, At, B0); PG8_MMA(0, 1, At, B1); PG8_BAR; PG8_SCHED;
            PG8_LDA(At, 1, 1); PG8_STAGE(PG8_SB(1, 0), b3, voffB); PG8_STAGE(PG8_SB(1, 1), b3 + hstep, voffB); PG8_STAGE(PG8_SA(1, 0), a3, voffA);
            PG8_WAIT_V(8); PG8_WAIT_L(0); PG8_BAR; PG8_MMA(1, 0, At, B0); PG8_MMA(1, 1, At, B1); PG8_BAR; PG8_SCHED;
            } else {
            PG8_LDB(B0, 0, 0); PG8_SCHED; PG8_LDA(At, 0, 0); PG8_STAGE(PG8_SA(1, 1), a1 + hstep, voffA);
            PG8_WAIT_L(8); PG8_BAR; PG8_WAIT_L(0); PG8_MMA(0, 0, At, B0); PG8_BAR; PG8_SCHED;
            PG8_LDB(B1, 0, 1); PG8_STAGE(PG8_SB(0, 0), b2, voffB);
            PG8_BAR; PG8_WAIT_L(0); PG8_MMA(0, 1, At, B1); PG8_BAR;
            PG8_LDA(At, 0, 1); PG8_STAGE(PG8_SA(0, 0), a2, voffA);
            PG8_BAR; PG8_WAIT_L(0); PG8_MMA(1, 0, At, B0); PG8_BAR; PG8_SCHED;
            PG8_STAGE(PG8_SB(0, 1), b2 + hstep, voffB);
            PG8_WAIT_V(6); PG8_BAR; PG8_MMA(1, 1, At, B1); PG8_BAR;
            PG8_LDB(B0, 1, 0); PG8_SCHED; PG8_LDA(At, 1, 0); PG8_STAGE(PG8_SA(0, 1), a2 + hstep, voffA);
            PG8_WAIT_L(8); PG8_BAR; PG8_WAIT_L(0); PG8_MMA(0, 0, At, B0); PG8_BAR; PG8_SCHED;
            PG8_LDB(B1, 1, 1); PG8_STAGE(PG8_SB(1, 0), b3, voffB);
            PG8_BAR; PG8_WAIT_L(0); PG8_MMA(0, 1, At, B1); PG8_BAR;
            PG8_LDA(At, 1, 1); PG8_STAGE(PG8_SA(1, 0), a3, voffA);
            PG8_BAR; PG8_WAIT_L(0); PG8_MMA(1, 0, At, B0); PG8_BAR; PG8_SCHED;
            PG8_STAGE(PG8_SB(1, 1), b3 + hstep, voffB);
            PG8_WAIT_V(6); PG8_BAR; PG8_MMA(1, 1, At, B1); PG8_BAR;
            }
        }
        if constexpr (ALIGN_EPI) { if (wr == 0) PG8_BAR; }
        bool zero_acc = true;
        if constexpr (Epi::SEGMENTED) { zero_acc = E.run(acc, cur, wr, wc, fr, fq); S.done(cur); }
        else if constexpr (!Epi::AFTER_DRAIN) { E(acc, cur, wr, wc, fr, fq); S.done(cur); }
        if (!has_next) break;
        if (zero_acc) {
#pragma unroll
        for (int a = 0; a < 2; ++a)
#pragma unroll
            for (int b = 0; b < 2; ++b)
#pragma unroll
                for (int m = 0; m < 4; ++m)
#pragma unroll
                    for (int n = 0; n < 2; ++n) acc[a][b][m][n] = (f32x4){0.f, 0.f, 0.f, 0.f};
        }
        cur = nxt; cA = nA; cB = nB; ++ui;
        if constexpr (ALIGN_EPI) { if (wr == 1) PG8_BAR; }
    }
    PG8_WAIT_V(0);
    if constexpr (!ALIGN_EPI) { if (wr == 0) PG8_BAR; }
    PG8_BAR;
    if constexpr (Epi::AFTER_DRAIN) { E.fused(acc, cur, wr, wc, fr, fq, lds, wid, lane); S.done(cur); }
#undef PG8_SA
#undef PG8_SB
#undef PG8_STAGE
#undef PG8_LDA
#undef PG8_LDB
#undef PG8_MMA
#undef PG8_WAIT_V
#undef PG8_WAIT_L
#undef PG8_BAR
#undef PG8_SCHED
}
}

constexpr int NWAVES = 8;
constexpr int NB = 4, SEQ = 2048, NTOK = NB * SEQ, DM = 2048, DEPTH = 4;
constexpr int DFF = 5632, NWI = 2 * DFF;
constexpr int NPROJ_SRC = 10512, NPROJ = 10752;
constexpr int C_QA = 0, C_KA = 768, C_VA = 1024, C_PU = 1280, C_QG = 2048, C_KG = 2432, C_VG = 2816, C_OG = 3584, C_LR = 4352, C_GATE = 4608;
constexpr int GATE_TILE0 = C_GATE / 256;
constexpr int BRW = 768;
constexpr float EPS = 1e-6f;

constexpr size_t MiB = 1u << 20;
constexpr size_t WS_CTL = 0, CTL_ZERO_BYTES = 1 * MiB;
constexpr size_t SZ_WI = (size_t)NWI * DM * 2, SZ_WO = (size_t)DM * DFF * 2, SZ_WIN = (size_t)NPROJ * DM * 2, SZ_WBR = (size_t)3 * DM * BRW * 2, SZ_WOUT = (size_t)DM * DM * 2;
constexpr size_t LW_WI1 = 0, LW_WO1 = LW_WI1 + SZ_WI, LW_WIN = LW_WO1 + SZ_WO, LW_WBR = LW_WIN + SZ_WIN, LW_WOUT = LW_WBR + SZ_WBR, LW_WI2 = LW_WOUT + SZ_WOUT, LW_WO2 = LW_WI2 + SZ_WI, LW_END = LW_WO2 + SZ_WO;
constexpr size_t WS_W = 2 * MiB;
constexpr size_t WS_X = ((WS_W + DEPTH * LW_END + MiB - 1) / MiB) * MiB;
constexpr size_t WS_H = WS_X + (size_t)NTOK * DM * 4;
constexpr size_t WS_ACT = WS_H + (size_t)NTOK * DM * 2;
constexpr size_t WS_PROJ = WS_ACT + (size_t)NTOK * DFF * 2;
constexpr size_t WS_Y = WS_PROJ + (size_t)NTOK * NPROJ * 2;
constexpr size_t WS_MACC = WS_Y + (size_t)3 * NTOK * BRW * 2;
constexpr size_t WS_MB = WS_MACC + (size_t)NTOK * DM * 4;
constexpr size_t WS_GO = WS_MB + (size_t)NTOK * DM * 2;
constexpr size_t WS_ROPE = WS_GO + (size_t)NTOK * BRW * 4;
constexpr size_t WS_GPRE = WS_ROPE + (size_t)2 * NTOK * 32 * 4;
constexpr size_t WS_WPT = WS_GPRE + (size_t)512 * 57856;
constexpr size_t WS_END = WS_WPT + (size_t)DEPTH * 4 * 192 * 192 * 2;
constexpr int CW_BAR = 4096;
constexpr size_t CTL_SSQ = 65536; static_assert(CTL_SSQ + (size_t)13 * 8192 * 8 <= CTL_ZERO_BYTES, "SSQ inside the zeroed CTL region");

constexpr int RING_OFF = 0, RING_BYTES = 131072;
constexpr int LDSCTL_OFF = RING_BYTES, MISC_OFF = LDSCTL_OFF + 320;
constexpr int LDS_BYTES = 147456;

#define GAS __attribute__((address_space(1)))
#define LAS __attribute__((address_space(3)))
typedef unsigned short bf16;
typedef unsigned v4u __attribute__((ext_vector_type(4)));
typedef float f32x4 __attribute__((ext_vector_type(4)));
#define LDS_WAIT() asm volatile("s_waitcnt lgkmcnt(0)" ::: "memory")
__device__ __forceinline__ unsigned f2bf(float f) { unsigned u = __builtin_bit_cast(unsigned, f); return (u + 0x7fffu + ((u >> 16) & 1u)) >> 16; }
__device__ __forceinline__ unsigned pk2(float lo, float hi) { return f2bf(lo) | (f2bf(hi) << 16); }
__device__ __forceinline__ float bf2f(bf16 b) { return __uint_as_float(((unsigned)b) << 16); }
__device__ __forceinline__ float bflo(unsigned w) { return __uint_as_float(w << 16); }
__device__ __forceinline__ float bfhi(unsigned w) { return __uint_as_float(w & 0xffff0000u); }
__device__ __forceinline__ float wave_sum(float v) {
#pragma unroll
    for (int o = 1; o < 64; o <<= 1) v += __shfl_xor(v, o);
    return v;
}

#define XB_TMO      128
#define XB_XCNT(j)  (256  + 64 * (j))
#define XB_XSUB(j)  (1280 + 64 * (j))
#define XB_XGEN(j)  (2304 + 64 * (j))
#define XB_TOP      3328
#define XB_TOPGEN   3392
#define XCD_BAR_WORDS 3456
#define XB_SPIN_CAP (1u << 18)

__device__ __forceinline__ unsigned xb_ld(unsigned* p)              { return __hip_atomic_load(p, __ATOMIC_RELAXED, __HIP_MEMORY_SCOPE_AGENT); }
__device__ __forceinline__ unsigned xb_add(unsigned* p, unsigned v) { return __hip_atomic_fetch_add(p, v, __ATOMIC_RELAXED, __HIP_MEMORY_SCOPE_AGENT); }
__device__ __forceinline__ unsigned xb_xcc_id() { return (unsigned)__builtin_amdgcn_s_getreg((3 << 11) | 20) & 0xFu; }
#define XB_SPIN(cond, bar) do { unsigned _sp = 0; while (cond) { __builtin_amdgcn_s_sleep(1); \
    if ((++_sp & 255u) == 0u) { if (xb_ld(&(bar)[XB_TMO])) break; if (_sp > XB_SPIN_CAP) { atomicAdd(&(bar)[XB_TMO], 1u); break; } } } } while (0)

struct XcdBarrier {
    unsigned* bar; unsigned x;
    volatile LAS unsigned* st;
};

__device__ __forceinline__ XcdBarrier xcd_barrier_post(unsigned* bar, volatile LAS unsigned* st) {
    XcdBarrier b; b.bar = bar; b.x = xb_xcc_id(); b.st = st;
    if (threadIdx.x == 0) (void)xb_add(&bar[XB_XCNT(b.x)], 1u);
    return b;
}
__device__ __forceinline__ void xcd_barrier_complete(unsigned* bar, unsigned x, unsigned& nloc, unsigned& nx) {
    const unsigned G = gridDim.x * gridDim.y * gridDim.z;
    unsigned sum, cnt, mine, sp = 0u;
    for (;;) {
        sum = 0u; cnt = 0u; mine = 0u;
#pragma unroll
        for (unsigned j = 0; j < 16; ++j) { const unsigned c = xb_ld(&bar[XB_XCNT(j)]); sum += c; cnt += (c > 0u) ? 1u : 0u; mine = (j == x) ? c : mine; }
        if (sum == G) break;
        __builtin_amdgcn_s_sleep(1);
        if ((++sp & 255u) == 0u) { if (xb_ld(&bar[XB_TMO])) break; if (sp > XB_SPIN_CAP) { atomicAdd(&bar[XB_TMO], 1u); break; } }
    }
    nloc = mine > 0u ? mine : 1u; nx = cnt > 0u ? cnt : 1u;
}

__device__ __forceinline__ void xcd_barrier(const XcdBarrier& b) {
    asm volatile("s_waitcnt vmcnt(0)" ::: "memory");
    __syncthreads();
    if (threadIdx.x == 0) {
        unsigned* bar = b.bar; const unsigned bx_ = xb_xcc_id();
        __builtin_amdgcn_s_waitcnt(0);
        unsigned nloc = b.st[0], nx = b.st[1];
        if (nloc == 0u) { xcd_barrier_complete(bar, bx_, nloc, nx); b.st[0] = nloc; b.st[1] = nx; }
        const unsigned old = xb_add(&bar[XB_XSUB(bx_)], 1u);
        const unsigned gen = old / nloc;
        if (old + 1u == (gen + 1u) * nloc) {
            __builtin_amdgcn_fence(__ATOMIC_RELEASE, "agent");
            asm volatile("s_waitcnt vmcnt(0)" ::: "memory");
            const unsigned og = xb_add(&bar[XB_TOP], 1u);
            const unsigned tg = og / nx;
            if (og + 1u == (tg + 1u) * nx) xb_add(&bar[XB_TOPGEN], 1u);
            else XB_SPIN(xb_ld(&bar[XB_TOPGEN]) == tg, bar);
            __builtin_amdgcn_fence(__ATOMIC_ACQUIRE, "agent");
            xb_add(&bar[XB_XGEN(bx_)], 1u);
            asm volatile("s_waitcnt vmcnt(0)" ::: "memory");
        } else {
            XB_SPIN(xb_ld(&bar[XB_XGEN(bx_)]) == gen, bar);
            __builtin_amdgcn_fence(__ATOMIC_ACQUIRE, "agent");
            asm volatile("s_waitcnt vmcnt(0)" ::: "memory");
        }
    }
    __syncthreads();
}


template <int MAP> __device__ __forceinline__ int map_row(int n) {
    if (MAP == 1) { const int isb = n >= DFF ? 1 : 0; const int h = n - isb * DFF; return (h >> 7) * 256 + isb * 128 + (h & 127); }
    if (MAP == 2) return n < 4368 ? n : n + 240;
    return n;
}
struct TrJob { const float* W; bf16* WT; const float* gain; int K, N, map; };
__device__ __forceinline__ int map_row_rt(int map, int n) { return map == 1 ? map_row<1>(n) : (map == 2 ? map_row<2>(n) : n); }
__device__ __forceinline__ void tr_load(const TrJob& jb, int tile, int tid, f32x4 (&v)[8][2], int& k0, int& n0) {
    const int nblk = (jb.N + 127) / 128, kt = tile / nblk, nt = tile - kt * nblk; k0 = 256 * kt; n0 = 128 * nt;
    const int c4 = (tid & 15) + 16 * ((tid >> 6) & 1), rp = ((tid >> 4) & 3) + 4 * (tid >> 7);
    int col = n0 + 4 * c4; col = col < jb.N - 4 ? col : jb.N - 4;
    const float* wp = jb.W + (size_t)(k0 + 2 * rp) * jb.N + col;
#pragma unroll
    for (int i = 0; i < 8; ++i) { v[i][0] = *(const f32x4*)(wp + (size_t)(32 * i) * jb.N); v[i][1] = *(const f32x4*)(wp + (size_t)(32 * i + 1) * jb.N); }
    if (jb.gain) {
#pragma unroll
        for (int i = 0; i < 8; ++i) { const float ga = jb.gain[k0 + 32 * i + 2 * rp], gb = jb.gain[k0 + 32 * i + 2 * rp + 1]; v[i][0] = v[i][0] * ga; v[i][1] = v[i][1] * gb; } }
}
__device__ __forceinline__ void tr_to_lds(LAS unsigned* T, int tid, const f32x4 (&v)[8][2]) {
    const int c4 = (tid & 15) + 16 * ((tid >> 6) & 1), rp = ((tid >> 4) & 3) + 4 * (tid >> 7);
#pragma unroll
    for (int i = 0; i < 8; ++i)
#pragma unroll
        for (int j = 0; j < 4; ++j) T[(4 * c4 + j) * 132 + 16 * i + rp] = pk2(v[i][0][j], v[i][1][j]);
}
__device__ __forceinline__ void tr_store(const TrJob& jb, const LAS unsigned* T, int tid, int k0, int n0) {
    const int w = tid >> 6, lane = tid & 63, c = 8 * (w >> 1) + (lane & 7), nb = 64 * (w & 1) + (lane >> 3);
#pragma unroll
    for (int j = 0; j < 8; ++j) { const int n = nb + 8 * j; const v4u o = *(const LAS v4u*)(T + n * 132 + 4 * c);
        if (n0 + n < jb.N) *(v4u*)(jb.WT + pg8::blk_off(map_row_rt(jb.map, n0 + n), k0 + 8 * c, jb.K)) = o; }
}

struct Args { const void* in[22]; float* out; unsigned char* ws; };

constexpr int TL_WI1 = 0, TL_WO1 = 704, TL_WIN = 1056, TL_BRA = 1720, TL_BRP = 1768, TL_BRG = 1816, TL_WOUT = 1864, TL_WI2 = 1992, TL_WO2 = 2696, TL_LAYER = 3048, TL_ALL = DEPTH * TL_LAYER;
constexpr int CW_CLAIM = 8192;
__device__ __forceinline__ void conv_job(const Args& A, int T, TrJob& jb, int& t) {
    const int l = T / TL_LAYER, r = T - l * TL_LAYER;
    unsigned char* wl = A.ws + WS_W + (size_t)l * LW_END;
    if (r < TL_WO1)       { jb = TrJob{(const float*)A.in[3] + (size_t)l * DM * NWI, (bf16*)(wl + LW_WI1), (const float*)A.in[2] + (size_t)l * DM, DM, NWI, 1}; t = r; }
    else if (r < TL_WIN)  { jb = TrJob{(const float*)A.in[4] + (size_t)l * DFF * DM, (bf16*)(wl + LW_WO1), nullptr, DFF, DM, 0}; t = r - TL_WO1; }
    else if (r < TL_BRA)  { jb = TrJob{(const float*)A.in[6] + (size_t)l * DM * NPROJ_SRC, (bf16*)(wl + LW_WIN), (const float*)A.in[5] + (size_t)l * DM, DM, NPROJ_SRC, 2}; t = r - TL_WIN; }
    else if (r < TL_BRP)  { jb = TrJob{(const float*)A.in[14] + (size_t)l * BRW * DM, (bf16*)(wl + LW_WBR), nullptr, BRW, DM, 0}; t = r - TL_BRA; }
    else if (r < TL_BRG)  { jb = TrJob{(const float*)A.in[15] + (size_t)l * BRW * DM, (bf16*)(wl + LW_WBR) + (size_t)DM * BRW, nullptr, BRW, DM, 0}; t = r - TL_BRP; }
    else if (r < TL_WOUT) { jb = TrJob{(const float*)A.in[16] + (size_t)l * BRW * DM, (bf16*)(wl + LW_WBR) + (size_t)2 * DM * BRW, nullptr, BRW, DM, 0}; t = r - TL_BRG; }
    else if (r < TL_WI2)  { jb = TrJob{(const float*)A.in[17] + (size_t)l * DM * DM, (bf16*)(wl + LW_WOUT), nullptr, DM, DM, 0}; t = r - TL_WOUT; }
    else if (r < TL_WO2)  { jb = TrJob{(const float*)A.in[19] + (size_t)l * DM * NWI, (bf16*)(wl + LW_WI2), (const float*)A.in[18] + (size_t)l * DM, DM, NWI, 1}; t = r - TL_WI2; }
    else                  { jb = TrJob{(const float*)A.in[20] + (size_t)l * DFF * DM, (bf16*)(wl + LW_WO2), nullptr, DFF, DM, 0}; t = r - TL_WO2; }
}
__device__ __forceinline__ void conv_claim(unsigned* ctr, volatile LAS unsigned* slot, int limit, int extra) {
    unsigned T = 0xffffffffu; const unsigned cur = __hip_atomic_load(ctr, __ATOMIC_RELAXED, __HIP_MEMORY_SCOPE_AGENT);
    const bool need = (int)cur < limit, opt = !need && extra > 0 && (int)cur < TL_ALL;
    if (need || opt) T = __hip_atomic_fetch_add(ctr, 1u, __ATOMIC_RELAXED, __HIP_MEMORY_SCOPE_AGENT);
    if (T != 0xffffffffu && (int)T >= TL_ALL) T = 0xffffffffu;
    slot[0] = T; slot[1] = need ? 0u : 1u;
}
__device__ __forceinline__ void conv_until(const Args& A, LAS unsigned char* lds, int limit, int extra) {
    unsigned* ctr = (unsigned*)(A.ws + WS_CTL) + CW_CLAIM; volatile LAS unsigned* slot = (volatile LAS unsigned*)(lds + MISC_OFF) + 16;
    LAS unsigned* Tl = (LAS unsigned*)(lds + RING_OFF);
    if (limit > TL_ALL) limit = TL_ALL;
    int tid = threadIdx.x; asm volatile("" : "+v"(tid));
    if (tid == 0) conv_claim(ctr, slot, limit, extra);
    __syncthreads();
    unsigned T = slot[0]; if (slot[1]) --extra;
    __syncthreads();
    if (T == 0xffffffffu) return;
    f32x4 v[8][2]; TrJob jb; int t, k0, n0;
    conv_job(A, (int)T, jb, t); tr_load(jb, t, tid, v, k0, n0);
#pragma unroll 1
    for (;;) {
        tr_to_lds(Tl, tid, v);
        if (tid == 0) conv_claim(ctr, slot, limit, extra);
        __syncthreads();
        const unsigned Tn = slot[0]; if (slot[1]) --extra;
        const TrJob cj = jb; const int ck0 = k0, cn0 = n0;
        if (Tn != 0xffffffffu) { conv_job(A, (int)Tn, jb, t); tr_load(jb, t, tid, v, k0, n0); }
        tr_store(cj, Tl, tid, ck0, cn0);
        __syncthreads();
        if (Tn == 0xffffffffu) break;
    }
}

__device__ __forceinline__ void p0_prologue(const Args& A, LAS unsigned char* lds, int gw, int NGW, int wave, int lane) {
    for (int i = gw * 64 + lane; i < DEPTH * 240 * DM / 8; i += NGW * 64) { const int l = i / (240 * DM / 8), j = i - l * (240 * DM / 8);
        *(v4u*)((bf16*)(A.ws + WS_W + (size_t)l * LW_END + LW_WIN) + pg8::blk_off(4368 + (j >> 8), 8 * (j & 255), DM)) = (v4u){0u, 0u, 0u, 0u}; }
    { const float* x = (const float*)A.in[0]; bf16* XB = (bf16*)(A.ws + WS_H); unsigned long long* ssq0 = (unsigned long long*)(A.ws + WS_CTL + CTL_SSQ);
      for (int r = gw; r < NTOK; r += NGW) { const f32x4* xr = (const f32x4*)(x + (size_t)r * DM); float sq = 0.f;
#pragma unroll
          for (int j = 0; j < 4; ++j) { const f32x4 a = xr[j * 128 + lane * 2], b = xr[j * 128 + lane * 2 + 1];
              sq += (a.x * a.x + a.y * a.y) + (a.z * a.z + a.w * a.w) + (b.x * b.x + b.y * b.y) + (b.z * b.z + b.w * b.w);
              v4u o; o.x = pk2(a.x, a.y); o.y = pk2(a.z, a.w); o.z = pk2(b.x, b.y); o.w = pk2(b.z, b.w);
              *(v4u*)(XB + pg8::blk_off(r, j * 512 + lane * 8, DM)) = o; }
          sq = wave_sum(sq); if (lane == 0) ssq0[r] = (unsigned long long)(sq * 1048576.0f + 0.5f); } }
    { const float* wp = (const float*)A.in[9]; const float* ps = (const float*)A.in[10]; bf16* wpt = (bf16*)(A.ws + WS_WPT);
      for (int i = gw * 64 + lane; i < DEPTH * 4 * 192 * 192; i += NGW * 64) { const int cc = i % 192, d = (i / 192) % 192, lg = i / (192 * 192);
          wpt[i] = (bf16)f2bf(wp[((size_t)lg * 192 + cc) * 192 + d] * ps[lg * 192 + d]); } }
    const int* pos = (const int*)A.in[1];
    float* cs = (float*)(A.ws + WS_ROPE); float* sn = cs + (size_t)NTOK * 32;
    for (int i = gw * 64 + lane; i < NTOK * 32; i += NGW * 64) { const int t = i >> 5, f = i & 31;
        const double inv = exp(-(double)f * (9.210340371976184 / 32.0));
        const double ang = (double)pos[t] * inv; cs[i] = (float)cos(ang); sn[i] = (float)sin(ang); }
}

__device__ __forceinline__ void rmsnorm_phase(const float* X, const float* g, bf16* H, int gw, int NGW, int lane) {
    asm volatile("" : "+v"(lane));
    for (int r = gw; r < NTOK; r += NGW) {
        const f32x4* xr = (const f32x4*)(X + (size_t)r * DM);
        f32x4 v[8]; float s = 0.f;
#pragma unroll
        for (int j = 0; j < 4; ++j) { v[2 * j] = xr[j * 128 + lane * 2]; v[2 * j + 1] = xr[j * 128 + lane * 2 + 1]; }
#pragma unroll
        for (int j = 0; j < 8; ++j) s += (v[j].x * v[j].x + v[j].y * v[j].y) + (v[j].z * v[j].z + v[j].w * v[j].w);
        const float rstd = 1.0f / sqrtf(wave_sum(s) * (1.0f / DM) + EPS);
#pragma unroll
        for (int j = 0; j < 4; ++j) { const f32x4 g0 = ((const f32x4*)g)[j * 128 + lane * 2], g1 = ((const f32x4*)g)[j * 128 + lane * 2 + 1];
            const f32x4 a = v[2 * j] * rstd * g0, b = v[2 * j + 1] * rstd * g1;
            v4u o; o.x = pk2(a.x, a.y); o.y = pk2(a.z, a.w); o.z = pk2(b.x, b.y); o.w = pk2(b.z, b.w);
            *(v4u*)(H + (size_t)r * DM + j * 512 + lane * 8) = o; }
    }
}
__device__ __forceinline__ void final_phase(const bf16* XB, const unsigned long long* ssq, const float* g, float* out, int gw, int NGW, int lane) {
    asm volatile("" : "+v"(lane));
    for (int r = gw; r < NTOK; r += NGW) {
        const float rstd = pg8::rstd_of(ssq[r]);
#pragma unroll
        for (int j = 0; j < 4; ++j) { const int c0 = j * 512 + lane * 8; const v4u x = *(const v4u*)(XB + pg8::blk_off(r, c0, DM));
            const f32x4 g0 = *(const f32x4*)(g + c0), g1 = *(const f32x4*)(g + c0 + 4);
            *(f32x4*)(out + (size_t)r * DM + c0) = (f32x4){bflo(x.x), bfhi(x.x), bflo(x.y), bfhi(x.y)} * rstd * g0;
            *(f32x4*)(out + (size_t)r * DM + c0 + 4) = (f32x4){bflo(x.z), bfhi(x.z), bflo(x.w), bfhi(x.w)} * rstd * g1; }
    }
}

typedef short bf16x8_t __attribute__((ext_vector_type(8)));
typedef unsigned v2u __attribute__((ext_vector_type(2)));
__device__ __forceinline__ void att_unit(LAS unsigned char* lds, const bf16* PROJ, const float* COS, const float* SIN, const float* sinks, bf16* YA, int u) {
    int tid = threadIdx.x; asm volatile("" : "+v"(tid));
    const int b = u >> 6, kvh = (u >> 4) & 3, blk = u & 15;
    LAS bf16* Ks = (LAS bf16*)lds;
    LAS bf16* VT = Ks + 256 * 72;
    const int tok0 = b * SEQ + 128 * (blk - 1);
    const int kk0 = blk == 0 ? 128 : 0;
    for (int idx = tid; idx < 256 * 4; idx += 512) { const int kk = idx >> 2, c4 = idx & 3;
        v4u w1 = (v4u){0u, 0u, 0u, 0u}, w2 = w1;
        if (kk >= kk0) { const size_t t = (size_t)(tok0 + kk);
            const v4u lo = *(const v4u*)(PROJ + t * NPROJ + C_KA + kvh * 64 + 8 * c4), hi = *(const v4u*)(PROJ + t * NPROJ + C_KA + kvh * 64 + 32 + 8 * c4);
            const f32x4 c0 = *(const f32x4*)(COS + t * 32 + 8 * c4), c1 = *(const f32x4*)(COS + t * 32 + 8 * c4 + 4), s0 = *(const f32x4*)(SIN + t * 32 + 8 * c4), s1 = *(const f32x4*)(SIN + t * 32 + 8 * c4 + 4);
            const float x1[8] = {bflo(lo.x), bfhi(lo.x), bflo(lo.y), bfhi(lo.y), bflo(lo.z), bfhi(lo.z), bflo(lo.w), bfhi(lo.w)};
            const float x2[8] = {bflo(hi.x), bfhi(hi.x), bflo(hi.y), bfhi(hi.y), bflo(hi.z), bfhi(hi.z), bflo(hi.w), bfhi(hi.w)};
            const float cc[8] = {c0.x, c0.y, c0.z, c0.w, c1.x, c1.y, c1.z, c1.w}, ss[8] = {s0.x, s0.y, s0.z, s0.w, s1.x, s1.y, s1.z, s1.w};
            float q1[8], q2[8];
#pragma unroll
            for (int j = 0; j < 8; ++j) { q1[j] = x1[j] * cc[j] - x2[j] * ss[j]; q2[j] = x2[j] * cc[j] + x1[j] * ss[j]; }
            w1.x = pk2(q1[0], q1[1]); w1.y = pk2(q1[2], q1[3]); w1.z = pk2(q1[4], q1[5]); w1.w = pk2(q1[6], q1[7]);
            w2.x = pk2(q2[0], q2[1]); w2.y = pk2(q2[2], q2[3]); w2.z = pk2(q2[4], q2[5]); w2.w = pk2(q2[6], q2[7]); }
        *(LAS v4u*)(Ks + kk * 72 + 8 * c4) = w1; *(LAS v4u*)(Ks + kk * 72 + 32 + 8 * c4) = w2; }
    for (int idx = tid; idx < 256 * 8; idx += 512) { const int ch = idx >> 8, kk = idx & 255;
        v4u w = (v4u){0u, 0u, 0u, 0u};
        if (kk >= kk0) w = *(const v4u*)(PROJ + (size_t)(tok0 + kk) * NPROJ + C_VA + kvh * 64 + ch * 8);
        LAS bf16* vp = VT + (ch * 8) * 264 + kk;
        vp[0 * 264] = (bf16)(w.x & 0xffffu); vp[1 * 264] = (bf16)(w.x >> 16); vp[2 * 264] = (bf16)(w.y & 0xffffu); vp[3 * 264] = (bf16)(w.y >> 16);
        vp[4 * 264] = (bf16)(w.z & 0xffffu); vp[5 * 264] = (bf16)(w.z >> 16); vp[6 * 264] = (bf16)(w.w & 0xffffu); vp[7 * 264] = (bf16)(w.w >> 16); }
    const int wave = __builtin_amdgcn_readfirstlane(tid >> 6), lane = tid & 63, g = lane >> 4, c = lane & 15;
    v4u qlo, qhi, nlo, nhi; f32x4 qc0, qc1, qs0, qs1, nc0, nc1, ns0, ns1;
#define ATT_LOADQ(LO, HI, C0, C1, S0, S1, ti_) do { const int id_ = 3 * wave + (ti_), hq_ = kvh * 3 + (id_ >> 3); const size_t t_ = (size_t)(b * SEQ + 128 * blk + 16 * (id_ & 7) + c); \
        LO = *(const v4u*)(PROJ + t_ * NPROJ + C_QA + hq_ * 64 + 8 * g); HI = *(const v4u*)(PROJ + t_ * NPROJ + C_QA + hq_ * 64 + 32 + 8 * g); \
        C0 = *(const f32x4*)(COS + t_ * 32 + 8 * g); C1 = *(const f32x4*)(COS + t_ * 32 + 8 * g + 4); S0 = *(const f32x4*)(SIN + t_ * 32 + 8 * g); S1 = *(const f32x4*)(SIN + t_ * 32 + 8 * g + 4); } while (0)
    ATT_LOADQ(qlo, qhi, qc0, qc1, qs0, qs1, 0);
    __syncthreads();
#pragma unroll 1
    for (int ti = 0; ti < 3; ++ti) {
        const int id = 3 * wave + ti, gq = id >> 3, qt = id & 7, hq = kvh * 3 + gq, qi = 16 * qt + c, kb0 = qt >> 1;
        const size_t t = (size_t)(b * SEQ + 128 * blk + qi);
        if (ti + 1 < 3) ATT_LOADQ(nlo, nhi, nc0, nc1, ns0, ns1, ti + 1);
        bf16x8_t qb[2];
        { const float x1[8] = {bflo(qlo.x), bfhi(qlo.x), bflo(qlo.y), bfhi(qlo.y), bflo(qlo.z), bfhi(qlo.z), bflo(qlo.w), bfhi(qlo.w)};
          const float x2[8] = {bflo(qhi.x), bfhi(qhi.x), bflo(qhi.y), bfhi(qhi.y), bflo(qhi.z), bfhi(qhi.z), bflo(qhi.w), bfhi(qhi.w)};
          const float cc[8] = {qc0.x, qc0.y, qc0.z, qc0.w, qc1.x, qc1.y, qc1.z, qc1.w}, ss[8] = {qs0.x, qs0.y, qs0.z, qs0.w, qs1.x, qs1.y, qs1.z, qs1.w};
          float q1[8], q2[8];
#pragma unroll
          for (int j = 0; j < 8; ++j) { q1[j] = (x1[j] * cc[j] - x2[j] * ss[j]) * 0.125f; q2[j] = (x2[j] * cc[j] + x1[j] * ss[j]) * 0.125f; }
          v4u w1, w2; w1.x = pk2(q1[0], q1[1]); w1.y = pk2(q1[2], q1[3]); w1.z = pk2(q1[4], q1[5]); w1.w = pk2(q1[6], q1[7]);
          w2.x = pk2(q2[0], q2[1]); w2.y = pk2(q2[2], q2[3]); w2.z = pk2(q2[4], q2[5]); w2.w = pk2(q2[6], q2[7]);
          qb[0] = __builtin_bit_cast(bf16x8_t, w1); qb[1] = __builtin_bit_cast(bf16x8_t, w2); }
        bf16x8_t kf[10][2];
#pragma unroll
        for (int kt = 0; kt < 10; ++kt)
#pragma unroll
            for (int ks = 0; ks < 2; ++ks) kf[kt][ks] = *(const LAS bf16x8_t*)(Ks + (32 * kb0 + 16 * kt + c) * 72 + 32 * ks + 8 * g);
        __builtin_amdgcn_sched_barrier(0);
        f32x4 st[10];
#pragma unroll
        for (int kt = 0; kt < 10; ++kt) { f32x4 acc = (f32x4){0.f, 0.f, 0.f, 0.f};
#pragma unroll
            for (int ks = 0; ks < 2; ++ks) acc = __builtin_amdgcn_mfma_f32_16x16x32_bf16(kf[kt][ks], qb[ks], acc, 0, 0, 0);
            st[kt] = acc; }
        v2u vlo[5][4], vhi[5][4];
#pragma unroll
        for (int ks = 0; ks < 5; ++ks)
#pragma unroll
            for (int dt = 0; dt < 4; ++dt) { const LAS bf16* vr = VT + (16 * dt + c) * 264 + 32 * (kb0 + ks) + 4 * g; vlo[ks][dt] = *(const LAS v2u*)vr; vhi[ks][dt] = *(const LAS v2u*)(vr + 16); }
        const float sink = sinks[hq];
        float m = sink;
#pragma unroll
        for (int kt = 0; kt < 10; ++kt)
#pragma unroll
            for (int r = 0; r < 4; ++r) { const int kk = 32 * kb0 + 16 * kt + 4 * g + r; const bool ok = (kk >= qi + 1) && (kk <= qi + 128) && (kk >= kk0);
                st[kt][r] = ok ? st[kt][r] : -1e30f; m = fmaxf(m, st[kt][r]); }
        m = fmaxf(m, __shfl_xor(m, 16)); m = fmaxf(m, __shfl_xor(m, 32));
        float l = 0.f;
#pragma unroll
        for (int kt = 0; kt < 10; ++kt)
#pragma unroll
            for (int r = 0; r < 4; ++r) { const float p = (st[kt][r] > -1e29f) ? __expf(st[kt][r] - m) : 0.f; st[kt][r] = p; l += p; }
        l += __shfl_xor(l, 16); l += __shfl_xor(l, 32);
        l += __expf(sink - m);
        f32x4 o[4];
#pragma unroll
        for (int dt = 0; dt < 4; ++dt) o[dt] = (f32x4){0.f, 0.f, 0.f, 0.f};
#pragma unroll
        for (int ks = 0; ks < 5; ++ks) { v4u pw; pw.x = pk2(st[2 * ks][0], st[2 * ks][1]); pw.y = pk2(st[2 * ks][2], st[2 * ks][3]); pw.z = pk2(st[2 * ks + 1][0], st[2 * ks + 1][1]); pw.w = pk2(st[2 * ks + 1][2], st[2 * ks + 1][3]);
            const bf16x8_t pb = __builtin_bit_cast(bf16x8_t, pw);
#pragma unroll
            for (int dt = 0; dt < 4; ++dt) { const v4u aw = (v4u){vlo[ks][dt].x, vlo[ks][dt].y, vhi[ks][dt].x, vhi[ks][dt].y};
                o[dt] = __builtin_amdgcn_mfma_f32_16x16x32_bf16(__builtin_bit_cast(bf16x8_t, aw), pb, o[dt], 0, 0, 0); } }
        const float inv = 1.0f / l;
#pragma unroll
        for (int dt = 0; dt < 4; ++dt) { v2u w; w.x = pk2(o[dt][0] * inv, o[dt][1] * inv); w.y = pk2(o[dt][2] * inv, o[dt][3] * inv);
            *(v2u*)(YA + pg8::blk_off((int)t, hq * 64 + 16 * dt + 4 * g, BRW)) = w; }
        qlo = nlo; qhi = nhi; qc0 = nc0; qc1 = nc1; qs0 = ns0; qs1 = ns1;
    }
#undef ATT_LOADQ
    __syncthreads();
}

__device__ __forceinline__ void pool_unit(LAS unsigned char* lds, const bf16* PROJ, const bf16* WPT, bf16* YP, int u) {
    int tid = threadIdx.x; asm volatile("" : "+v"(tid));
    const int tile = u >> 2, gp = u & 3, w = 2 << gp;
    const int t0 = tile * 64, s0 = t0 & (SEQ - 1);
    LAS float* U = (LAS float*)lds;
    LAS bf16* DA = (LAS bf16*)(U + 79 * 192);
    for (int idx = tid; idx < 79 * 24; idx += 512) { const int rr = idx / 24, cq = idx - rr * 24; const int srel = s0 - 15 + rr;
        v4u w = (v4u){0u, 0u, 0u, 0u}; if (srel >= 0) w = *(const v4u*)(PROJ + (size_t)(t0 - 15 + rr) * NPROJ + C_PU + gp * 192 + cq * 8);
        *(LAS f32x4*)(U + rr * 192 + cq * 8) = (f32x4){bflo(w.x), bfhi(w.x), bflo(w.y), bfhi(w.y)}; *(LAS f32x4*)(U + rr * 192 + cq * 8 + 4) = (f32x4){bflo(w.z), bfhi(w.z), bflo(w.w), bfhi(w.w)}; }
    __syncthreads();
    for (int idx = tid; idx < 64 * 192; idx += 512) { const int tok = idx / 192, c = idx - tok * 192; const int sq = s0 + tok; const int cnt = (sq + 1) < w ? (sq + 1) : w;
        float sum = 0.f; for (int j = 0; j < cnt; ++j) sum += U[(15 + tok - j) * 192 + c];
        DA[tok * 200 + c] = (bf16)f2bf(sum / (float)cnt - U[(15 + tok) * 192 + c]); }
    __syncthreads();
    {
        const int wave = __builtin_amdgcn_readfirstlane(tid >> 6), lane = tid & 63, g = lane >> 4, c = lane & 15, mt = wave & 3, nh = wave >> 2;
        bf16x8_t db[6];
#pragma unroll
        for (int ks = 0; ks < 6; ++ks) db[ks] = *(const LAS bf16x8_t*)(DA + (16 * mt + c) * 200 + 32 * ks + 8 * g);
        const bf16* wbase = WPT + (size_t)gp * 192 * 192;
#pragma unroll 2
        for (int ni = 0; ni < 6; ++ni) { const int nt = 6 * nh + ni;
            f32x4 acc = (f32x4){0.f, 0.f, 0.f, 0.f};
#pragma unroll
            for (int ks = 0; ks < 6; ++ks) { const bf16x8_t a = *(const bf16x8_t*)(wbase + (size_t)(16 * nt + c) * 192 + 32 * ks + 8 * g);
                acc = __builtin_amdgcn_mfma_f32_16x16x32_bf16(a, db[ks], acc, 0, 0, 0); }
            v2u wv; wv.x = pk2(acc[0], acc[1]); wv.y = pk2(acc[2], acc[3]);
            *(v2u*)(YP + pg8::blk_off(t0 + 16 * mt + c, gp * 192 + 16 * nt + 4 * g, BRW)) = wv; }
    }
    __syncthreads();
}

constexpr size_t GP_QT = 0, GP_KST = 12288, GP_A = 24576, GP_VT = 32768, GP_DEC = 57344, GP_ITEM = 57856;
__device__ __forceinline__ void gla_pre_item(LAS unsigned char* lds, const bf16* PROJ, const float* A2, const float* ba, unsigned char* GPRE, int item) {
    int tid = threadIdx.x; asm volatile("" : "+v"(tid));
    const int bh = item >> 5, ch = item & 31, b = bh >> 2, h = bh & 3;
    const size_t tok0 = (size_t)(b * SEQ + ch * 64);
    unsigned char* gp = GPRE + (size_t)item * GP_ITEM;
    LAS float* LRs = (LAS float*)lds;
    LAS float* A2s = LRs + 64 * 16;
    LAS float* Bs = A2s + 16 * 96;
    LAS bf16* QTs = (LAS bf16*)(Bs + 64 * 96);
    LAS bf16* KTs = QTs + 64 * 104;
    LAS bf16* KSTs = KTs + 64 * 104;
    LAS bf16* VTs = KSTs + 96 * 72;
    if (tid < 128) { const int t = tid >> 1, hq = tid & 1; const v4u w = *(const v4u*)(PROJ + (tok0 + t) * NPROJ + C_LR + hq * 8);
        *(LAS f32x4*)(LRs + t * 16 + hq * 8) = (f32x4){bflo(w.x), bfhi(w.x), bflo(w.y), bfhi(w.y)}; *(LAS f32x4*)(LRs + t * 16 + hq * 8 + 4) = (f32x4){bflo(w.z), bfhi(w.z), bflo(w.w), bfhi(w.w)}; }
    for (int idx = tid; idx < 64 * 24; idx += 512) { const int t = idx / 24, cq = idx - t * 24;
        if (cq < 12) *(LAS v4u*)(QTs + t * 104 + cq * 8) = *(const v4u*)(PROJ + (tok0 + t) * NPROJ + C_QG + h * 96 + cq * 8);
        else *(LAS v4u*)(KTs + t * 104 + (cq - 12) * 8) = *(const v4u*)(PROJ + (tok0 + t) * NPROJ + C_KG + h * 96 + (cq - 12) * 8); }
    for (int idx = tid; idx < 16 * 96; idx += 512) { const int r = idx / 96, d = idx - r * 96; A2s[idx] = A2[r * 384 + h * 96 + d]; }
    for (int idx = tid; idx < 64 * 24; idx += 512) { const int t = idx / 24, cq = idx - t * 24;
        const v4u w = *(const v4u*)(PROJ + (tok0 + t) * NPROJ + C_VG + h * 192 + cq * 8);
        LAS bf16* vp = VTs + (cq * 8) * 72 + t;
        vp[0 * 72] = (bf16)(w.x & 0xffffu); vp[1 * 72] = (bf16)(w.x >> 16); vp[2 * 72] = (bf16)(w.y & 0xffffu); vp[3 * 72] = (bf16)(w.y >> 16);
        vp[4 * 72] = (bf16)(w.z & 0xffffu); vp[5 * 72] = (bf16)(w.z >> 16); vp[6 * 72] = (bf16)(w.w & 0xffffu); vp[7 * 72] = (bf16)(w.w >> 16); }
    __syncthreads();
    for (int idx = tid; idx < 64 * 96; idx += 512) { const int t = idx / 96, d = idx - t * 96;
        float z = ba[h * 96 + d];
#pragma unroll
        for (int r = 0; r < 16; ++r) z += LRs[t * 16 + r] * A2s[r * 96 + d];
        const float ls = fminf(z, 0.f) - __logf(1.0f + __expf(-fabsf(z)));
        Bs[idx] = ls * (1.0f / 16.0f); }
    __syncthreads();
    if (tid < 96) { float gv[64];
#pragma unroll
        for (int t = 0; t < 64; ++t) gv[t] = Bs[t * 96 + tid];
        float run = 0.f;
#pragma unroll
        for (int t = 0; t < 64; ++t) { run += gv[t]; Bs[t * 96 + tid] = run; } }
    __syncthreads();
    const float qscale = 0.10206207261596575f;
    for (int idx = tid; idx < 64 * 96; idx += 512) { const int t = idx / 96, d = idx - t * 96;
        const float bb = Bs[idx], bl = Bs[63 * 96 + d];
        const float q = bf2f(QTs[t * 104 + d]), k = bf2f(KTs[t * 104 + d]);
        QTs[t * 104 + d] = (bf16)f2bf(q * qscale * __expf(bb)); KTs[t * 104 + d] = (bf16)f2bf(k * __expf(-bb)); KSTs[d * 72 + t] = (bf16)f2bf(k * __expf(bl - bb)); }
    if (tid < 96) ((float*)(gp + GP_DEC))[tid] = __expf(Bs[63 * 96 + tid]);
    __syncthreads();
    for (int idx = tid; idx < 64 * 12; idx += 512) { const int r = idx / 12, cq = idx - r * 12; *(v4u*)(gp + GP_QT + r * 192 + cq * 16) = *(const LAS v4u*)(QTs + r * 104 + cq * 8); }
    for (int idx = tid; idx < 96 * 8; idx += 512) { const int r = idx >> 3, cq = idx & 7; *(v4u*)(gp + GP_KST + r * 128 + cq * 16) = *(const LAS v4u*)(KSTs + r * 72 + cq * 8); }
    for (int idx = tid; idx < 192 * 8; idx += 512) { const int r = idx >> 3, cq = idx & 7; *(v4u*)(gp + GP_VT + r * 128 + cq * 16) = *(const LAS v4u*)(VTs + r * 72 + cq * 8); }
    {
        const int wave = __builtin_amdgcn_readfirstlane(tid >> 6), lane = tid & 63, g = lane >> 4, c = lane & 15;
#pragma unroll
        for (int rep = 0; rep < 2; ++rep) { const int id = wave + 8 * rep, it = id >> 2, jt = id & 3;
            f32x4 acc = (f32x4){0.f, 0.f, 0.f, 0.f};
            if (jt <= it) {
#pragma unroll
                for (int ks = 0; ks < 3; ++ks) { const bf16x8_t a = *(const LAS bf16x8_t*)(KTs + (16 * jt + c) * 104 + 32 * ks + 8 * g), bq = *(const LAS bf16x8_t*)(QTs + (16 * it + c) * 104 + 32 * ks + 8 * g);
                    acc = __builtin_amdgcn_mfma_f32_16x16x32_bf16(a, bq, acc, 0, 0, 0); } }
            const int i = 16 * it + c, j0 = 16 * jt + 4 * g;
            v2u w; w.x = pk2(j0 + 0 <= i ? acc[0] : 0.f, j0 + 1 <= i ? acc[1] : 0.f); w.y = pk2(j0 + 2 <= i ? acc[2] : 0.f, j0 + 3 <= i ? acc[3] : 0.f);
            *(v2u*)(gp + GP_A + i * 128 + j0 * 2) = w; }
    }
    __syncthreads();
}
constexpr int GS_QT = 0, GS_KST = 13312, GS_A = 27136, GS_VT = 36352, GS_DEC = 45568, GS_BUF = 46080;
__device__ __forceinline__ void gla_scan_unit(LAS unsigned char* lds, const unsigned char* GPRE, float* GO, int u) {
    int tid = threadIdx.x; asm volatile("" : "+v"(tid));
    const int bh = u / 3, s3 = u - 3 * bh, b = bh >> 2, h = bh & 3;
    const int wave = __builtin_amdgcn_readfirstlane(tid >> 6), lane = tid & 63, g = lane >> 4, c = lane & 15, th = wave >> 2, jt = wave & 3;
    int goff[5], loff[5];
#pragma unroll
    for (int i = 0; i < 5; ++i) { const int q = tid + 512 * i;
        if (q < 768) { const int r = q / 12, cq = q - r * 12; goff[i] = (int)GP_QT + r * 192 + cq * 16; loff[i] = GS_QT + r * 208 + cq * 16; }
        else if (q < 1536) { const int p = q - 768, r = p >> 3, cq = p & 7; goff[i] = (int)GP_KST + r * 128 + cq * 16; loff[i] = GS_KST + r * 144 + cq * 16; }
        else if (q < 2048) { const int p = q - 1536, r = p >> 3, cq = p & 7; goff[i] = (int)GP_A + r * 128 + cq * 16; loff[i] = GS_A + r * 144 + cq * 16; }
        else { const int p = q - 2048, r = p >> 3, cq = p & 7; goff[i] = (int)GP_VT + (64 * s3 + r) * 128 + cq * 16; loff[i] = GS_VT + r * 144 + cq * 16; } }
    f32x4 S[6];
#pragma unroll
    for (int i = 0; i < 6; ++i) S[i] = (f32x4){0.f, 0.f, 0.f, 0.f};
    v4u rg[5]; v4u rd = (v4u){0u, 0u, 0u, 0u};
    { const unsigned char* gp = GPRE + (size_t)(bh * 32) * GP_ITEM;
#pragma unroll
      for (int i = 0; i < 5; ++i) rg[i] = *(const v4u*)(gp + goff[i]);
      if (tid < 24) rd = *(const v4u*)(gp + GP_DEC + tid * 16);
#pragma unroll
      for (int i = 0; i < 5; ++i) *(LAS v4u*)(lds + loff[i]) = rg[i];
      if (tid < 24) *(LAS v4u*)(lds + GS_DEC + tid * 16) = rd; }
    __syncthreads();
#pragma unroll 1
    for (int ch = 0; ch < 32; ++ch) {
        LAS unsigned char* cur = lds + (ch & 1) * GS_BUF; LAS unsigned char* nxt = lds + ((ch + 1) & 1) * GS_BUF;
        if (ch + 1 < 32) { const unsigned char* gp = GPRE + (size_t)(bh * 32 + ch + 1) * GP_ITEM;
#pragma unroll
            for (int i = 0; i < 5; ++i) rg[i] = *(const v4u*)(gp + goff[i]);
            if (tid < 24) rd = *(const v4u*)(gp + GP_DEC + tid * 16); }
        const size_t tokc = (size_t)(b * SEQ + ch * 64);
        bf16x8_t vb[2];
#pragma unroll
        for (int ks = 0; ks < 2; ++ks) vb[ks] = *(const LAS bf16x8_t*)(cur + GS_VT + (16 * jt + c) * 144 + (32 * ks + 8 * g) * 2);
        bf16x8_t sb[3];
#pragma unroll
        for (int ks = 0; ks < 3; ++ks) { v4u w; w.x = pk2(S[2 * ks][0], S[2 * ks][1]); w.y = pk2(S[2 * ks][2], S[2 * ks][3]); w.z = pk2(S[2 * ks + 1][0], S[2 * ks + 1][1]); w.w = pk2(S[2 * ks + 1][2], S[2 * ks + 1][3]);
            sb[ks] = __builtin_bit_cast(bf16x8_t, w); }
#pragma unroll
        for (int ti = 0; ti < 2; ++ti) { const int it = 2 * th + ti;
            f32x4 acc = (f32x4){0.f, 0.f, 0.f, 0.f};
#pragma unroll
            for (int ks = 0; ks < 2; ++ks) { const bf16x8_t a = *(const LAS bf16x8_t*)(cur + GS_A + (16 * it + c) * 144 + (32 * ks + 8 * g) * 2);
                acc = __builtin_amdgcn_mfma_f32_16x16x32_bf16(a, vb[ks], acc, 0, 0, 0); }
#pragma unroll
            for (int ks = 0; ks < 3; ++ks) { const v2u lo = *(const LAS v2u*)(cur + GS_QT + (16 * it + c) * 208 + (32 * ks + 4 * g) * 2), hi = *(const LAS v2u*)(cur + GS_QT + (16 * it + c) * 208 + (32 * ks + 16 + 4 * g) * 2);
                const v4u w = (v4u){lo.x, lo.y, hi.x, hi.y};
                acc = __builtin_amdgcn_mfma_f32_16x16x32_bf16(__builtin_bit_cast(bf16x8_t, w), sb[ks], acc, 0, 0, 0); }
            float* op = GO + (tokc + 16 * it + 4 * g) * BRW + h * 192 + 64 * s3 + 16 * jt + c;
            op[0 * BRW] = acc[0]; op[1 * BRW] = acc[1]; op[2 * BRW] = acc[2]; op[3 * BRW] = acc[3]; }
#pragma unroll
        for (int i = 0; i < 6; ++i) { const f32x4 d4 = *(const LAS f32x4*)(cur + GS_DEC + (16 * i + 4 * g) * 4);
            S[i] = S[i] * d4;
#pragma unroll
            for (int ks = 0; ks < 2; ++ks) { const bf16x8_t a = *(const LAS bf16x8_t*)(cur + GS_KST + (16 * i + c) * 144 + (32 * ks + 8 * g) * 2);
                S[i] = __builtin_amdgcn_mfma_f32_16x16x32_bf16(a, vb[ks], S[i], 0, 0, 0); } }
        if (ch + 1 < 32) {
#pragma unroll
            for (int i = 0; i < 5; ++i) *(LAS v4u*)(nxt + loff[i]) = rg[i];
            if (tid < 24) *(LAS v4u*)(nxt + GS_DEC + tid * 16) = rd; }
        __syncthreads();
    }
}
__device__ __forceinline__ void gla_norm_phase(const float* GO, const bf16* PROJ, const float* gnorm, bf16* YG, int gw, int NGW, int lane) {
    asm volatile("" : "+v"(lane));
    f32x4 gn[3];
#pragma unroll
    for (int j = 0; j < 3; ++j) gn[j] = *(const f32x4*)(gnorm + 12 * lane + 4 * j);
#pragma unroll 1
    for (int t0 = gw; t0 < NTOK; t0 += 4 * NGW) {
        f32x4 o[4][3]; v2u og[4][3];
#pragma unroll
        for (int q = 0; q < 4; ++q) { const int tq = t0 + q * NGW; const size_t t = (size_t)(tq < NTOK ? tq : t0);
#pragma unroll
            for (int j = 0; j < 3; ++j) { o[q][j] = *(const f32x4*)(GO + t * BRW + 12 * lane + 4 * j); og[q][j] = *(const v2u*)(PROJ + t * NPROJ + C_OG + 12 * lane + 4 * j); } }
#pragma unroll
        for (int q = 0; q < 4; ++q) { const int tq = t0 + q * NGW; if (tq >= NTOK) break; const size_t t = (size_t)tq;
            float ss = 0.f;
#pragma unroll
            for (int j = 0; j < 3; ++j) ss += (o[q][j].x * o[q][j].x + o[q][j].y * o[q][j].y) + (o[q][j].z * o[q][j].z + o[q][j].w * o[q][j].w);
            ss += __shfl_xor(ss, 1); ss += __shfl_xor(ss, 2); ss += __shfl_xor(ss, 4); ss += __shfl_xor(ss, 8);
            const float rstd = 1.0f / sqrtf(ss * (1.0f / 192.0f) + EPS);
#pragma unroll
            for (int j = 0; j < 3; ++j) { const float g0 = bflo(og[q][j].x), g1 = bfhi(og[q][j].x), g2 = bflo(og[q][j].y), g3 = bfhi(og[q][j].y);
                const float y0 = o[q][j].x * rstd * gn[j].x * (g0 / (1.0f + __expf(-g0))), y1 = o[q][j].y * rstd * gn[j].y * (g1 / (1.0f + __expf(-g1)));
                const float y2 = o[q][j].z * rstd * gn[j].z * (g2 / (1.0f + __expf(-g2))), y3 = o[q][j].w * rstd * gn[j].w * (g3 / (1.0f + __expf(-g3)));
                v2u w; w.x = pk2(y0, y1); w.y = pk2(y2, y3);
                *(v2u*)(YG + pg8::blk_off((int)t, 12 * lane + 4 * j, BRW)) = w; } }
    }
}

__global__ void __launch_bounds__(NWAVES * 64, 2) mega_fwd(Args A) {
    extern __shared__ __attribute__((aligned(16))) unsigned char lds_raw[];
    LAS unsigned char* lds = (LAS unsigned char*)lds_raw;
    const int tid = threadIdx.x;
    const int G = gridDim.x, bx = blockIdx.x;
    unsigned char* ws = A.ws;
    for (int u = tid; u < (LDS_BYTES - LDSCTL_OFF) / 4; u += NWAVES * 64) ((LAS unsigned*)(lds + LDSCTL_OFF))[u] = 0u;
    __syncthreads();
    XcdBarrier bar = xcd_barrier_post((unsigned*)(ws + WS_CTL) + CW_BAR, (volatile LAS unsigned*)(lds + MISC_OFF) + 8);

    float* X = (float*)(ws + WS_X); bf16* H = (bf16*)(ws + WS_H); bf16* ACT = (bf16*)(ws + WS_ACT); bf16* PROJ = (bf16*)(ws + WS_PROJ);
    bf16* Y = (bf16*)(ws + WS_Y); float* MACC = (float*)(ws + WS_MACC); bf16* MB = (bf16*)(ws + WS_MB); float* GO = (float*)(ws + WS_GO);
    const float* COS = (const float*)(ws + WS_ROPE); const float* SIN = COS + (size_t)NTOK * 32;

    { int t_ = threadIdx.x; asm volatile("" : "+v"(t_)); const int w_ = __builtin_amdgcn_readfirstlane(t_ >> 6); p0_prologue(A, lds, bx * NWAVES + w_, G * NWAVES, w_, t_ & 63); }
    conv_until(A, lds, TL_WO1, 0);
    xcd_barrier(bar);

#pragma unroll 1
    for (int step = 0; step < 3 * DEPTH; ++step) {
        const int l = step / 3, kind = step - 3 * l;
        unsigned char* wl = ws + WS_W + (size_t)l * LW_END;
        const unsigned long long* ssq = (const unsigned long long*)(ws + WS_CTL + CTL_SSQ) + (size_t)step * NTOK; unsigned long long* ssq_next = (unsigned long long*)(ws + WS_CTL + CTL_SSQ) + (size_t)(step + 1) * NTOK;
        if (kind != 1) {
            { pg8::Gemm g{H, (const bf16*)(wl + (kind == 0 ? LW_WI1 : LW_WI2)), NTOK, NWI, DM}; pg8::StaticOrder S; S.init(NTOK, NWI, G, bx);
              pg8::EpiSwiglu E{ACT, DFF, ssq};
              pg8::gemm_phase<pg8::EpiSwiglu, pg8::StaticOrder, true, true>(lds + RING_OFF, g, S, E); }
            { const int rem1 = ((NTOK / 256) * (NWI / 256)) % G;
              conv_until(A, lds, l * TL_LAYER + (kind == 0 ? TL_WIN : TL_LAYER), (rem1 != 0 && bx >= rem1) ? 3 : 0); }
            xcd_barrier(bar);
        } else {
            const int nunits = (NTOK / 256) * (NPROJ / 256), nfull = nunits / G, rem = nunits - nfull * G;
#pragma unroll 1
            for (int part = 0; part < 2; ++part) {
                pg8::Gemm g{H, (const bf16*)(wl + LW_WIN), NTOK, NPROJ, DM}; pg8::RangeOrder S; S.init(NTOK, NPROJ, G, bx); S.i0 = part ? nfull : 0; S.n = part ? 1 : nfull;
                pg8::EpiProj E{PROJ, NPROJ, (const float*)A.in[7] + (size_t)l * 6144, GATE_TILE0, ssq};
                pg8::gemm_phase<pg8::EpiProj, pg8::RangeOrder, true, true>(lds + RING_OFF, g, S, E);
                if (part == 0) xcd_barrier(bar);
            }
            if (bx >= rem) { const int mb = bx - rem, ms = G - rem;
                for (int u = mb; u < 512; u += ms) pool_unit(lds, PROJ, (const bf16*)(ws + WS_WPT) + (size_t)l * 4 * 192 * 192, Y + (size_t)NTOK * BRW, u);
                for (int it = mb; it < 512; it += ms) gla_pre_item(lds, PROJ, (const float*)A.in[11] + (size_t)l * 16 * 384, (const float*)A.in[12] + l * 384, ws + WS_GPRE, it); }
            xcd_barrier(bar);
            if (G > 96) { if (bx < 48) gla_scan_unit(lds, ws + WS_GPRE, GO, bx);
                          else for (int u = bx - 48; u < 256; u += G - 48) att_unit(lds, PROJ, COS, SIN, (const float*)A.in[8] + l * 12, Y, u); }
            else { for (int u = bx; u < 48; u += G) gla_scan_unit(lds, ws + WS_GPRE, GO, u);
                   for (int u = bx; u < 256; u += G) att_unit(lds, PROJ, COS, SIN, (const float*)A.in[8] + l * 12, Y, u); }
            conv_until(A, lds, l * TL_LAYER + TL_WI2, (G > 96 && bx >= 48) ? 2 : 0);
            xcd_barrier(bar);
            { int t_ = threadIdx.x; asm volatile("" : "+v"(t_)); gla_norm_phase(GO, PROJ, (const float*)A.in[13] + l * 768, Y + (size_t)2 * NTOK * BRW, bx * NWAVES + __builtin_amdgcn_readfirstlane(t_ >> 6), G * NWAVES, t_ & 63); }
            xcd_barrier(bar);
            { pg8::Gemm g{Y, (const bf16*)(wl + LW_WBR), NTOK, DM, BRW, (size_t)NTOK * BRW * 2, (size_t)DM * BRW * 2}; pg8::SegOrder S; S.init(NTOK, DM, G, bx); S.nseg = 3;
              pg8::EpiMergeSeg E{PROJ + C_GATE, NPROJ, DM, MB, DM};
              pg8::gemm_phase<pg8::EpiMergeSeg, pg8::SegOrder, true, true>(lds + RING_OFF, g, S, E); }
            xcd_barrier(bar);
        }
        { const bf16* Ap = (kind == 1) ? (const bf16*)MB : (const bf16*)ACT; const int Kd = (kind == 1) ? DM : DFF;
          const bf16* Bp = (const bf16*)(wl + (kind == 0 ? LW_WO1 : (kind == 1 ? LW_WOUT : LW_WO2)));
          pg8::Gemm g{Ap, Bp, NTOK, DM, Kd}; pg8::StaticOrder S; S.init(NTOK, DM, G, bx);
          pg8::EpiResid E{H, ssq_next, DM, kind == 1 ? 1.0f : 0.5f};
          pg8::gemm_phase<pg8::EpiResid, pg8::StaticOrder, true, true>(lds + RING_OFF, g, S, E); }
        conv_until(A, lds, l * TL_LAYER + (kind == 0 ? TL_BRA : (kind == 1 ? TL_WO2 : TL_LAYER + TL_WO1)), 0);
        xcd_barrier(bar);
    }
    { int t_ = threadIdx.x; asm volatile("" : "+v"(t_)); final_phase(H, (const unsigned long long*)(ws + WS_CTL + CTL_SSQ) + (size_t)12 * NTOK, (const float*)A.in[21], A.out, bx * NWAVES + __builtin_amdgcn_readfirstlane(t_ >> 6), G * NWAVES, t_ & 63); }
}

extern "C" void kernel_launch(void* const* d_in, const int* in_sizes, int n_in, void* d_out, int out_size, void* d_ws, size_t ws_size, hipStream_t stream) {
    static int grid = 0;
    if (grid == 0) {
        if (n_in != 22 || in_sizes[0] != NTOK * DM || out_size != NTOK * DM || ws_size < WS_END) {
            fprintf(stderr, "kernel_launch: unexpected shapes (n_in %d, in0 %d, out %d, ws %zu < %zu); nothing launched\n", n_in, n_in > 0 ? in_sizes[0] : -1, out_size, ws_size, (size_t)WS_END); grid = -1; return; }
        int dev = 0, cus = 0, per_cu = 0;
        if (hipGetDevice(&dev) != hipSuccess || hipDeviceGetAttribute(&cus, hipDeviceAttributeMultiprocessorCount, dev) != hipSuccess) { grid = -1; return; }
        if (hipFuncSetAttribute((const void*)mega_fwd, hipFuncAttributeMaxDynamicSharedMemorySize, LDS_BYTES) != hipSuccess) { fprintf(stderr, "kernel_launch: hipFuncSetAttribute failed\n"); grid = -1; return; }
        if (hipOccupancyMaxActiveBlocksPerMultiprocessor(&per_cu, (const void*)mega_fwd, NWAVES * 64, LDS_BYTES) != hipSuccess || per_cu < 1) { fprintf(stderr, "kernel_launch: occupancy query says %d\n", per_cu); (void)hipGetLastError(); grid = -1; return; }
        grid = cus;
    }
    if (grid < 0) return;
    if (hipMemsetAsync((char*)d_ws + WS_CTL, 0, CTL_ZERO_BYTES, stream) != hipSuccess) return;
    Args a{};
    for (int i = 0; i < 22; ++i) a.in[i] = d_in[i];
    a.out = (float*)d_out; a.ws = (unsigned char*)d_ws;
    hipLaunchKernelGGL(mega_fwd, dim3(grid), dim3(NWAVES * 64), LDS_BYTES, stream, a);
}
```

```cpp
#include <hip/hip_runtime.h>
#include <cstdio>
#include <cstdint>
#include <cmath>
namespace pg8 {
#define PG8_LAS __attribute__((address_space(3)))
typedef unsigned short bf16_t;
typedef short bf16x8 __attribute__((ext_vector_type(8)));
typedef float f32x4 __attribute__((ext_vector_type(4)));
typedef unsigned u32x4 __attribute__((ext_vector_type(4)));
constexpr int BM = 256, BK = 64, HALF = 128, HTB = HALF * BK * 2  , STAGE_BYTES = 8 * HTB, NXCD = 8, WGM = 8;

__host__ __device__ __forceinline__ int lds_byte(int r, int c) { const int st = (r >> 4) * 2 + (c >> 5), rr = r & 15, cc = c & 31, ob = rr * 64 + cc * 2; return st * 1024 + (ob ^ (((ob >> 9) & 1) << 5)); }
__host__ __device__ __forceinline__ void stage_rc(int b, int& R, int& C) { const int st = b / 1024, sb = b % 1024, swz = sb ^ (((sb >> 9) & 1) << 5); R = (st >> 1) * 16 + swz / 64; C = (st & 1) * 32 + (swz % 64) / 2; }
__host__ __device__ __forceinline__ int perm32(int rho) { const int n = rho >> 4, i = rho & 15; return 8 * (i >> 2) + 4 * n + (i & 3); }

__host__ __device__ __forceinline__ size_t blk_off(int r, int c, int C) { return ((size_t)(r >> 6) * (size_t)(C >> 6) + (size_t)(c >> 6)) * 4096 + (size_t)(r & 63) * 64 + (size_t)(c & 63); }
struct Unit { int pm, pn, seg; };
struct Gemm { const bf16_t* A; const bf16_t* Bt; int M, N, K; size_t segA = 0, segB = 0; };

struct StaticOrder {
    int nM, nN, nwg, G, c;
    __host__ __device__ void init(int M, int N, int G_, int c_) { nM = M / BM; nN = N / BM; nwg = nM * nN; G = G_; c = c_; }
    __host__ __device__ bool next(int i, Unit& u) const {
        const long L = (long)i * G + c; if (L >= nwg) return false;
        int wgid = (int)L; { const int q = nwg / NXCD, r = nwg % NXCD, xcd = wgid % NXCD, off = wgid / NXCD; wgid = (xcd < r ? xcd * (q + 1) : r * (q + 1) + (xcd - r) * q) + off; }
        const int nig = WGM * nN, gid = wgid / nig, fm = gid * WGM, gsz = (nM - fm) < WGM ? (nM - fm) : WGM;
        u.pm = fm + ((wgid % nig) % gsz); u.pn = (wgid % nig) / gsz; u.seg = 0; return true;
    }
    __device__ __forceinline__ void a_ready(const Unit&) const {}
    __device__ __forceinline__ void done(const Unit&) const {}
};
struct RangeOrder : StaticOrder { int i0, n;
    __host__ __device__ bool next(int i, Unit& u) const { if (i >= n) return false; return StaticOrder::next(i + i0, u); } };
struct SegOrder : StaticOrder { int nseg;
    __host__ __device__ bool next(int i, Unit& u) const { const int t = i / nseg; if (!StaticOrder::next(t, u)) return false; u.seg = i - t * nseg; return true; } };
__device__ __forceinline__ unsigned cvt_pk_bf16(float lo, float hi) { unsigned r; asm volatile("v_cvt_pk_bf16_f32 %0, %1, %2" : "=v"(r) : "v"(lo), "v"(hi)); return r; }
typedef float f32x2 __attribute__((ext_vector_type(2)));
__device__ __forceinline__ float bf_lo(unsigned w) { return __uint_as_float(w << 16); }
__device__ __forceinline__ float bf_hi(unsigned w) { return __uint_as_float(w & 0xffff0000u); }
__device__ __forceinline__ float sigmoid_f(float v) { return __builtin_amdgcn_rcpf(1.0f + __builtin_amdgcn_exp2f(v * -1.4426950408889634f)); }
__device__ __forceinline__ float rstd_of(unsigned long long q) {
    const float f = (float)(unsigned)(q >> 32) * 4294967296.0f + (float)(unsigned)q; return __builtin_amdgcn_rsqf(f * (1.0f / 1048576.0f / 2048.0f) + 1e-6f); }
#define PG8_LOAD_RSTD(rs, ssq, row0) float rs[2][4]; { unsigned long long q_[2][4]; _Pragma("unroll") for (int ai = 0; ai < 2; ++ai) _Pragma("unroll") for (int m = 0; m < 4; ++m) q_[ai][m] = (ssq)[(row0) + ai * HALF + m * 16]; \
    _Pragma("unroll") for (int ai = 0; ai < 2; ++ai) _Pragma("unroll") for (int m = 0; m < 4; ++m) rs[ai][m] = rstd_of(q_[ai][m]); }
struct EpiSwiglu {
    static constexpr bool PERM = true, AFTER_DRAIN = false, SEGMENTED = false;
    bf16_t* O; int ldo; const unsigned long long* ssq;
    __device__ __forceinline__ void operator()(const f32x4 (&acc)[2][2][4][2], const Unit& u, int wr, int wc, int fr, int fq) const {
        const int row0 = u.pm * BM + wr * 64 + fr, hid0 = u.pn * HALF + wc * 32 + 8 * fq;
        PG8_LOAD_RSTD(rsv, ssq, row0)
#pragma unroll
        for (int ai = 0; ai < 2; ++ai)
#pragma unroll
            for (int m = 0; m < 4; ++m) { const int row = row0 + ai * HALF + m * 16; bf16_t* rowp = O + blk_off(row, hid0, ldo);
                const float rs = rsv[ai][m];
                f32x4 v0, v1;
#pragma unroll
                for (int j = 0; j < 4; ++j) { const float a0 = acc[ai][0][m][0][j] * rs, a1 = acc[ai][0][m][1][j] * rs;
                    v0[j] = a0 * sigmoid_f(a0) * (acc[ai][1][m][0][j] * rs); v1[j] = a1 * sigmoid_f(a1) * (acc[ai][1][m][1][j] * rs); }
                u32x4 w; w.x = cvt_pk_bf16(v0[0], v0[1]); w.y = cvt_pk_bf16(v0[2], v0[3]); w.z = cvt_pk_bf16(v1[0], v1[1]); w.w = cvt_pk_bf16(v1[2], v1[3]);
                *(u32x4*)rowp = w; }
    }
};
struct EpiResid {
    static constexpr bool PERM = true, AFTER_DRAIN = false, SEGMENTED = false;
    bf16_t* xb; unsigned long long* ssq_next; int ldc; float scale;
    __device__ __forceinline__ void operator()(const f32x4 (&acc)[2][2][4][2], const Unit& u, int wr, int wc, int fr, int fq) const {
        const int row0 = u.pm * BM + wr * 64 + fr, col0 = u.pn * BM + wc * 32 + 8 * fq;
#pragma unroll
        for (int ai = 0; ai < 2; ++ai) {
            u32x4 t[4][2];
#pragma unroll
            for (int m = 0; m < 4; ++m)
#pragma unroll
                for (int bj = 0; bj < 2; ++bj) t[m][bj] = *(const u32x4*)(xb + blk_off(row0 + ai * HALF + m * 16, col0 + bj * HALF, ldc));
#pragma unroll
            for (int m = 0; m < 4; ++m) { const int row = row0 + ai * HALF + m * 16; float ss = 0.f;
#pragma unroll
                for (int bj = 0; bj < 2; ++bj) { const u32x4 x = t[m][bj];
                    f32x4 v0 = (f32x4){bf_lo(x.x), bf_hi(x.x), bf_lo(x.y), bf_hi(x.y)} + acc[ai][bj][m][0] * scale, v1 = (f32x4){bf_lo(x.z), bf_hi(x.z), bf_lo(x.w), bf_hi(x.w)} + acc[ai][bj][m][1] * scale;
                    u32x4 w; w.x = cvt_pk_bf16(v0[0], v0[1]); w.y = cvt_pk_bf16(v0[2], v0[3]); w.z = cvt_pk_bf16(v1[0], v1[1]); w.w = cvt_pk_bf16(v1[2], v1[3]);
                    *(u32x4*)(xb + blk_off(row, col0 + bj * HALF, ldc)) = w;
                    ss += (v0[0] * v0[0] + v0[1] * v0[1]) + (v0[2] * v0[2] + v0[3] * v0[3]) + (v1[0] * v1[0] + v1[1] * v1[1]) + (v1[2] * v1[2] + v1[3] * v1[3]); }
                ss += __shfl_xor(ss, 16); ss += __shfl_xor(ss, 32);
                if (fq == 0) atomicAdd(ssq_next + row, (unsigned long long)(ss * 1048576.0f + 0.5f)); } }
    }
};
struct EpiProj {
    static constexpr bool PERM = true, AFTER_DRAIN = false, SEGMENTED = false;
    bf16_t* O; int ldo; const float* bias; int gate_tile0; const unsigned long long* ssq;
    __device__ __forceinline__ void operator()(const f32x4 (&acc)[2][2][4][2], const Unit& u, int wr, int wc, int fr, int fq) const {
        const int row0 = u.pm * BM + wr * 64 + fr, col0 = u.pn * BM + wc * 32 + 8 * fq;
        const bool gate = u.pn >= gate_tile0;
        PG8_LOAD_RSTD(rsv, ssq, row0)
        f32x4 bv[2][2];
#pragma unroll
        for (int bj = 0; bj < 2; ++bj)
#pragma unroll
            for (int n = 0; n < 2; ++n) bv[bj][n] = gate ? *(const f32x4*)(bias + (col0 - gate_tile0 * BM) + bj * HALF + 4 * n) : (f32x4){0.f, 0.f, 0.f, 0.f};
#pragma unroll
        for (int ai = 0; ai < 2; ++ai)
#pragma unroll
            for (int m = 0; m < 4; ++m) { const int row = row0 + ai * HALF + m * 16; bf16_t* rowp = O + (size_t)row * ldo + col0;
                const float rs = rsv[ai][m];
#pragma unroll
                for (int bj = 0; bj < 2; ++bj) { f32x4 v0 = acc[ai][bj][m][0] * rs + bv[bj][0], v1 = acc[ai][bj][m][1] * rs + bv[bj][1];
                    if (gate) {
#pragma unroll
                        for (int j = 0; j < 4; ++j) { v0[j] = sigmoid_f(v0[j]); v1[j] = sigmoid_f(v1[j]); } }
                    u32x4 w; w.x = cvt_pk_bf16(v0[0], v0[1]); w.y = cvt_pk_bf16(v0[2], v0[3]); w.z = cvt_pk_bf16(v1[0], v1[1]); w.w = cvt_pk_bf16(v1[2], v1[3]);
                    *(u32x4*)(rowp + bj * HALF) = w; } }
    }
};
struct EpiMergeSeg {
    static constexpr bool PERM = true, AFTER_DRAIN = false, SEGMENTED = true;
    const bf16_t* gate; int ldg; int gseg; bf16_t* outb; int ldc;
    __device__ __forceinline__ bool run(f32x4 (&acc)[2][2][4][2], const Unit& u, int wr, int wc, int fr, int fq) const {
        const int row0 = u.pm * BM + wr * 64 + fr, col0 = u.pn * BM + wc * 32 + 8 * fq;
        const bf16_t* gs = gate + (size_t)u.seg * gseg; const bool last = u.seg == 2;
#pragma unroll
        for (int ai = 0; ai < 2; ++ai) {
            u32x4 ga[4][2], gb[4][2];
#pragma unroll
            for (int m = 0; m < 4; ++m)
#pragma unroll
                for (int bj = 0; bj < 2; ++bj) { const size_t p = (size_t)(row0 + ai * HALF + m * 16) * ldg + col0 + bj * HALF;
                    ga[m][bj] = *(const u32x4*)(gs + p); gb[m][bj] = last ? ga[m][bj] : *(const u32x4*)(gs + gseg + p); }
#pragma unroll
            for (int m = 0; m < 4; ++m)
#pragma unroll
                for (int bj = 0; bj < 2; ++bj) { const u32x4 a = ga[m][bj], b = gb[m][bj];
                    float f[8] = {bf_lo(a.x), bf_hi(a.x), bf_lo(a.y), bf_hi(a.y), bf_lo(a.z), bf_hi(a.z), bf_lo(a.w), bf_hi(a.w)};
                    if (!last) { const float d[8] = {bf_lo(b.x), bf_hi(b.x), bf_lo(b.y), bf_hi(b.y), bf_lo(b.z), bf_hi(b.z), bf_lo(b.w), bf_hi(b.w)};
#pragma unroll
                        for (int j = 0; j < 8; ++j) f[j] *= __builtin_amdgcn_rcpf(fmaxf(d[j], 1e-20f)); }
                    f32x4 v0 = acc[ai][bj][m][0], v1 = acc[ai][bj][m][1];
                    v0[0] *= f[0]; v0[1] *= f[1]; v0[2] *= f[2]; v0[3] *= f[3]; v1[0] *= f[4]; v1[1] *= f[5]; v1[2] *= f[6]; v1[3] *= f[7];
                    acc[ai][bj][m][0] = v0; acc[ai][bj][m][1] = v1;
                    if (last) { u32x4 w; w.x = cvt_pk_bf16(v0[0], v0[1]); w.y = cvt_pk_bf16(v0[2], v0[3]); w.z = cvt_pk_bf16(v1[0], v1[1]); w.w = cvt_pk_bf16(v1[2], v1[3]);
                        *(u32x4*)(outb + blk_off(row0 + ai * HALF + m * 16, col0 + bj * HALF, ldc)) = w; } } }
        return last;
    }
};

template <class Epi, class Sched, bool ALIGN_EPI = false, bool SP2 = false>
__device__ __forceinline__ void gemm_phase(PG8_LAS unsigned char* lds, const Gemm g, const Sched& S, const Epi& E) {
    int tid_o = threadIdx.x; asm volatile("" : "+v"(tid_o));
    const int tid = tid_o, wid = __builtin_amdgcn_readfirstlane(tid >> 6), lane = tid & 63, wr = wid >> 2, wc = wid & 3, fr = lane & 15, fq = lane >> 4;
    const int K = g.K, nt = K / BK;
    unsigned voffA[2], voffB[2];
#pragma unroll
    for (int i = 0; i < 2; ++i) { int R, C; stage_rc(tid * 16 + i * 8192, R, C); const int Rb = Epi::PERM ? ((R & ~31) + perm32(R & 31)) : R;
        voffA[i] = (unsigned)((R >> 6) * (K >> 6) * 4096 + (R & 63) * 64 + C) * 2u; voffB[i] = (unsigned)((Rb >> 6) * (K >> 6) * 4096 + (Rb & 63) * 64 + C) * 2u; }
    const size_t kstep = (size_t)8192;
    const size_t hstep = (size_t)2 * (K >> 6) * 8192;
    const size_t tstep = 2 * hstep;
    const unsigned ldsw = (unsigned)wid * 1024u;
    const int aoff = lds_byte(wr * 64 + fr, fq * 8), boff = lds_byte(wc * 32 + fr, fq * 8);
#define PG8_SA(b, h) (((b) * 2 + (h)) * HTB)
#define PG8_SB(b, h) ((4 + (b) * 2 + (h)) * HTB)
#define PG8_STAGE(bufoff, gbase, voff) do { _Pragma("unroll") for (int _i = 0; _i < 2; ++_i) \
        __builtin_amdgcn_global_load_lds((const unsigned*)((const char*)(gbase) + (voff)[_i]), (PG8_LAS unsigned*)(lds + (bufoff) + ldsw + _i * 8192), 16, 0, 0); } while (0)
#define PG8_LDA(dst, b, h) do { _Pragma("unroll") for (int m = 0; m < 4; ++m) _Pragma("unroll") for (int k = 0; k < 2; ++k) dst[m][k] = *(const PG8_LAS bf16x8*)(lds + PG8_SA(b, h) + aoff + m * 2048 + k * 1024); } while (0)
#define PG8_LDB(dst, b, h) do { _Pragma("unroll") for (int n = 0; n < 2; ++n) _Pragma("unroll") for (int k = 0; k < 2; ++k) dst[n][k] = *(const PG8_LAS bf16x8*)(lds + PG8_SB(b, h) + boff + n * 2048 + k * 1024); } while (0)
#define PG8_MMA(ai, bj, At, Bt) do { __builtin_amdgcn_s_setprio(1); _Pragma("unroll") for (int m = 0; m < 4; ++m) _Pragma("unroll") for (int n = 0; n < 2; ++n) _Pragma("unroll") for (int k = 0; k < 2; ++k) \
        acc[ai][bj][m][n] = __builtin_amdgcn_mfma_f32_16x16x32_bf16(Bt[n][k], At[m][k], acc[ai][bj][m][n], 0, 0, 0); __builtin_amdgcn_s_setprio(0); } while (0)
#define PG8_WAIT_V(n) asm volatile("s_waitcnt vmcnt(" #n ")" ::: "memory")
#define PG8_WAIT_L(n) asm volatile("s_waitcnt lgkmcnt(" #n ")" ::: "memory")
#define PG8_BAR __builtin_amdgcn_s_barrier()
#define PG8_SCHED __builtin_amdgcn_sched_barrier(0)
    Unit cur, nxt; int ui = 0;
    if (!S.next(0, cur)) return;
    f32x4 acc[2][2][4][2];
#pragma unroll
    for (int a = 0; a < 2; ++a)
#pragma unroll
        for (int b = 0; b < 2; ++b)
#pragma unroll
            for (int m = 0; m < 4; ++m)
#pragma unroll
                for (int n = 0; n < 2; ++n) acc[a][b][m][n] = (f32x4){0.f, 0.f, 0.f, 0.f};
    bf16x8 At[4][2], B0[2][2], B1[2][2];
    const char* cA = (const char*)g.A + (size_t)cur.pm * tstep + (size_t)cur.seg * g.segA; const char* cB = (const char*)g.Bt + (size_t)cur.pn * tstep + (size_t)cur.seg * g.segB;
    S.a_ready(cur);
    if constexpr (SP2) {
        PG8_STAGE(PG8_SB(0, 0), cB, voffB); PG8_STAGE(PG8_SB(0, 1), cB + hstep, voffB); PG8_STAGE(PG8_SA(0, 0), cA, voffA); PG8_STAGE(PG8_SA(0, 1), cA + hstep, voffA);
        if (wr == 1) PG8_BAR;
        PG8_WAIT_V(2); PG8_BAR;
        PG8_STAGE(PG8_SB(1, 0), cB + kstep, voffB); PG8_STAGE(PG8_SA(1, 0), cA + kstep, voffA); PG8_STAGE(PG8_SB(1, 1), cB + hstep + kstep, voffB);
        PG8_WAIT_V(6); PG8_BAR;
    } else {
        PG8_STAGE(PG8_SB(0, 0), cB, voffB); PG8_STAGE(PG8_SA(0, 0), cA, voffA); PG8_STAGE(PG8_SB(0, 1), cB + hstep, voffB); PG8_STAGE(PG8_SA(0, 1), cA + hstep, voffA);
        if (wr == 1) PG8_BAR;
        PG8_WAIT_V(4); PG8_BAR;
        PG8_STAGE(PG8_SB(1, 0), cB + kstep, voffB); PG8_STAGE(PG8_SA(1, 0), cA + kstep, voffA); PG8_STAGE(PG8_SB(1, 1), cB + hstep + kstep, voffB);
        PG8_WAIT_V(6); PG8_BAR;
    }
    for (;;) {
        const bool has_next = S.next(ui + 1, nxt);
        const char* nA = has_next ? (const char*)g.A + (size_t)nxt.pm * tstep + (size_t)nxt.seg * g.segA : cA; const char* nB = has_next ? (const char*)g.Bt + (size_t)nxt.pn * tstep + (size_t)nxt.seg * g.segB : cB;
        for (int t = 0; t < nt; t += 2) {
            const bool last = (t == nt - 2);
            const char* a1 = cA + (size_t)(t + 1) * kstep;
            const char* a2 = last ? nA : cA + (size_t)(t + 2) * kstep; const char* b2 = last ? nB : cB + (size_t)(t + 2) * kstep;
            const char* a3 = a2 + kstep; const char* b3 = b2 + kstep;
            if (last && has_next) S.a_ready(nxt);
            if constexpr (SP2) {
            PG8_LDB(B0, 0, 0); PG8_LDB(B1, 0, 1); PG8_SCHED; PG8_LDA(At, 0, 0); PG8_STAGE(PG8_SA(1, 1), a1 + hstep, voffA);
            PG8_WAIT_V(8); PG8_WAIT_L(0); PG8_BAR; PG8_MMA(0, 0, At, B0); PG8_MMA(0, 1, At, B1); PG8_BAR; PG8_SCHED;
            PG8_LDA(At, 0, 1); PG8_STAGE(PG8_SB(0, 0), b2, voffB); PG8_STAGE(PG8_SB(0, 1), b2 + hstep, voffB); PG8_STAGE(PG8_SA(0, 0), a2, voffA);
            PG8_WAIT_V(8); PG8_WAIT_L(0); PG8_BAR; PG8_MMA(1, 0, At, B0); PG8_MMA(1, 1, At, B1); PG8_BAR; PG8_SCHED;
            PG8_LDB(B0, 1, 0); PG8_LDB(B1, 1, 1); PG8_SCHED; PG8_LDA(At, 1, 0); PG8_STAGE(PG8_SA(0, 1), a2 + hstep, voffA);
            PG8_WAIT_V(8); PG8_WAIT_L(0); PG8_BAR; PG8_MMA(0, 0, At, B0); PG8_MMA(0, 1, At, B1); PG8_BAR; PG8_SCHED;
            PG8_LDA(At, 1, 1); PG8_STAGE(PG8_SB(1, 0), b3, voffB); PG8_STAGE(PG8_SB(1, 1), b3 + hstep, voffB); PG8_STAGE(PG8_SA(1, 0), a3, voffA);
            PG8_WAIT_V(8); PG8_WAIT_L(0); PG8_BAR; PG8_MMA(1, 0, At, B0); PG8_MMA(1, 1, At, B1); PG8_BAR; PG8_SCHED;
            } else {
            PG8_LDB(B0, 0, 0); PG8_SCHED; PG8_LDA(At, 0, 0); PG8_STAGE(PG8_SA(1, 1), a1 + hstep, voffA);
            PG8_WAIT_L(8); PG8_BAR; PG8_WAIT_L(0); PG8_MMA(0, 0, At, B0); PG8_BAR; PG8_SCHED;
            PG8_LDB(B1, 0, 1); PG8_STAGE(PG8_SB(0, 0), b2, voffB);
            PG8_BAR; PG8_WAIT_L(0); PG8_MMA(0, 1, At, B1); PG8_BAR;
            PG8_LDA(At, 0, 1); PG8_STAGE(PG8_SA(0, 0), a2, voffA);
            PG8_BAR; PG8_WAIT_L(0); PG8_MMA(1, 0, At, B0); PG8_BAR; PG8_SCHED;
            PG8_STAGE(PG8_SB(0, 1), b2 + hstep, voffB);
            PG8_WAIT_V(6); PG8_BAR; PG8_MMA(1, 1, At, B1); PG8_BAR;
            PG8_LDB(B0, 1, 0); PG8_SCHED; PG8_LDA(At, 1, 0); PG8_STAGE(PG8_SA(0, 1), a2 + hstep, voffA);
            PG8_WAIT_L(8); PG8_BAR; PG8_WAIT_L(0); PG8_MMA(0, 0, At, B0); PG8_BAR; PG8_SCHED;
            PG8_LDB(B1, 1, 1); PG8_STAGE(PG8_SB(1, 0), b3, voffB);
            PG8_BAR; PG8_WAIT_L(0); PG8_MMA(0, 1, At, B1); PG8_BAR;
            PG8_LDA(At, 1, 1); PG8_STAGE(PG8_SA(1, 0), a3, voffA);
            PG8_BAR; PG8_WAIT_L(0); PG8_MMA(1, 0, At, B0); PG8_BAR; PG8_SCHED;
            PG8_STAGE(PG8_SB(1, 1), b3 + hstep, voffB);
            PG8_WAIT_V(6); PG8_BAR; PG8_MMA(1, 1, At, B1); PG8_BAR;
            }
        }
        if constexpr (ALIGN_EPI) { if (wr == 0) PG8_BAR; }
        bool zero_acc = true;
        if constexpr (Epi::SEGMENTED) { zero_acc = E.run(acc, cur, wr, wc, fr, fq); S.done(cur); }
        else if constexpr (!Epi::AFTER_DRAIN) { E(acc, cur, wr, wc, fr, fq); S.done(cur); }
        if (!has_next) break;
        if (zero_acc) {
#pragma unroll
        for (int a = 0; a < 2; ++a)
#pragma unroll
            for (int b = 0; b < 2; ++b)
#pragma unroll
                for (int m = 0; m < 4; ++m)
#pragma unroll
                    for (int n = 0; n < 2; ++n) acc[a][b][m][n] = (f32x4){0.f, 0.f, 0.f, 0.f};
        }
        cur = nxt; cA = nA; cB = nB; ++ui;
        if constexpr (ALIGN_EPI) { if (wr == 1) PG8_BAR; }
    }
    PG8_WAIT_V(0);
    if constexpr (!ALIGN_EPI) { if (wr == 0) PG8_BAR; }
    PG8_BAR;
    if constexpr (Epi::AFTER_DRAIN) { E.fused(acc, cur, wr, wc, fr, fq, lds, wid, lane); S.done(cur); }
#undef PG8_SA
#undef PG8_SB
#undef PG8_STAGE
#undef PG8_LDA
#undef PG8_LDB
#undef PG8_MMA
#undef PG8_WAIT_V
#undef PG8_WAIT_L
#undef PG8_BAR
#undef PG8_SCHED
}
}

constexpr int NWAVES = 8;
constexpr int NB = 4, SEQ = 2048, NTOK = NB * SEQ, DM = 2048, DEPTH = 4;
constexpr int DFF = 5632, NWI = 2 * DFF;
constexpr int NPROJ_SRC = 10512, NPROJ = 10752;
constexpr int C_QA = 0, C_KA = 768, C_VA = 1024, C_PU = 1280, C_QG = 2048, C_KG = 2432, C_VG = 2816, C_OG = 3584, C_LR = 4352, C_GATE = 4608;
constexpr int GATE_TILE0 = C_GATE / 256;
constexpr int BRW = 768;
constexpr float EPS = 1e-6f;

constexpr size_t MiB = 1u << 20;
constexpr size_t WS_CTL = 0, CTL_ZERO_BYTES = 1 * MiB;
constexpr size_t SZ_WI = (size_t)NWI * DM * 2, SZ_WO = (size_t)DM * DFF * 2, SZ_WIN = (size_t)NPROJ * DM * 2, SZ_WBR = (size_t)3 * DM * BRW * 2, SZ_WOUT = (size_t)DM * DM * 2;
constexpr size_t LW_WI1 = 0, LW_WO1 = LW_WI1 + SZ_WI, LW_WIN = LW_WO1 + SZ_WO, LW_WBR = LW_WIN + SZ_WIN, LW_WOUT = LW_WBR + SZ_WBR, LW_WI2 = LW_WOUT + SZ_WOUT, LW_WO2 = LW_WI2 + SZ_WI, LW_END = LW_WO2 + SZ_WO;
constexpr size_t WS_W = 2 * MiB;
constexpr size_t WS_X = ((WS_W + DEPTH * LW_END + MiB - 1) / MiB) * MiB;
constexpr size_t WS_H = WS_X + (size_t)NTOK * DM * 4;
constexpr size_t WS_ACT = WS_H + (size_t)NTOK * DM * 2;
constexpr size_t WS_PROJ = WS_ACT + (size_t)NTOK * DFF * 2;
constexpr size_t WS_Y = WS_PROJ + (size_t)NTOK * NPROJ * 2;
constexpr size_t WS_MACC = WS_Y + (size_t)3 * NTOK * BRW * 2;
constexpr size_t WS_MB = WS_MACC + (size_t)NTOK * DM * 4;
constexpr size_t WS_GO = WS_MB + (size_t)NTOK * DM * 2;
constexpr size_t WS_ROPE = WS_GO + (size_t)NTOK * BRW * 4;
constexpr size_t WS_GPRE = WS_ROPE + (size_t)2 * NTOK * 32 * 4;
constexpr size_t WS_WPT = WS_GPRE + (size_t)512 * 57856;
constexpr size_t WS_END = WS_WPT + (size_t)DEPTH * 4 * 192 * 192 * 2;
constexpr int CW_BAR = 4096;
constexpr size_t CTL_SSQ = 65536; static_assert(CTL_SSQ + (size_t)13 * 8192 * 8 <= CTL_ZERO_BYTES, "SSQ inside the zeroed CTL region");

constexpr int RING_OFF = 0, RING_BYTES = 131072;
constexpr int LDSCTL_OFF = RING_BYTES, MISC_OFF = LDSCTL_OFF + 320;
constexpr int LDS_BYTES = 147456;

#define GAS __attribute__((address_space(1)))
#define LAS __attribute__((address_space(3)))
typedef unsigned short bf16;
typedef unsigned v4u __attribute__((ext_vector_type(4)));
typedef float f32x4 __attribute__((ext_vector_type(4)));
#define LDS_WAIT() asm volatile("s_waitcnt lgkmcnt(0)" ::: "memory")
__device__ __forceinline__ unsigned f2bf(float f) { unsigned u = __builtin_bit_cast(unsigned, f); return (u + 0x7fffu + ((u >> 16) & 1u)) >> 16; }
__device__ __forceinline__ unsigned pk2(float lo, float hi) { return f2bf(lo) | (f2bf(hi) << 16); }
__device__ __forceinline__ float bf2f(bf16 b) { return __uint_as_float(((unsigned)b) << 16); }
__device__ __forceinline__ float bflo(unsigned w) { return __uint_as_float(w << 16); }
__device__ __forceinline__ float bfhi(unsigned w) { return __uint_as_float(w & 0xffff0000u); }
__device__ __forceinline__ float wave_sum(float v) {
#pragma unroll
    for (int o = 1; o < 64; o <<= 1) v += __shfl_xor(v, o);
    return v;
}

#define XB_TMO      128
#define XB_XCNT(j)  (256  + 64 * (j))
#define XB_XSUB(j)  (1280 + 64 * (j))
#define XB_XGEN(j)  (2304 + 64 * (j))
#define XB_TOP      3328
#define XB_TOPGEN   3392
#define XCD_BAR_WORDS 3456
#define XB_SPIN_CAP (1u << 18)

__device__ __forceinline__ unsigned xb_ld(unsigned* p)              { return __hip_atomic_load(p, __ATOMIC_RELAXED, __HIP_MEMORY_SCOPE_AGENT); }
__device__ __forceinline__ unsigned xb_add(unsigned* p, unsigned v) { return __hip_atomic_fetch_add(p, v, __ATOMIC_RELAXED, __HIP_MEMORY_SCOPE_AGENT); }
__device__ __forceinline__ unsigned xb_xcc_id() { return (unsigned)__builtin_amdgcn_s_getreg((3 << 11) | 20) & 0xFu; }
#define XB_SPIN(cond, bar) do { unsigned _sp = 0; while (cond) { __builtin_amdgcn_s_sleep(1); \
    if ((++_sp & 255u) == 0u) { if (xb_ld(&(bar)[XB_TMO])) break; if (_sp > XB_SPIN_CAP) { atomicAdd(&(bar)[XB_TMO], 1u); break; } } } } while (0)

struct XcdBarrier {
    unsigned* bar; unsigned x;
    volatile LAS unsigned* st;
};

__device__ __forceinline__ XcdBarrier xcd_barrier_post(unsigned* bar, volatile LAS unsigned* st) {
    XcdBarrier b; b.bar = bar; b.x = xb_xcc_id(); b.st = st;
    if (threadIdx.x == 0) (void)xb_add(&bar[XB_XCNT(b.x)], 1u);
    return b;
}
__device__ __forceinline__ void xcd_barrier_complete(unsigned* bar, unsigned x, unsigned& nloc, unsigned& nx) {
    const unsigned G = gridDim.x * gridDim.y * gridDim.z;
    unsigned sum, cnt, mine, sp = 0u;
    for (;;) {
        sum = 0u; cnt = 0u; mine = 0u;
#pragma unroll
        for (unsigned j = 0; j < 16; ++j) { const unsigned c = xb_ld(&bar[XB_XCNT(j)]); sum += c; cnt += (c > 0u) ? 1u : 0u; mine = (j == x) ? c : mine; }
        if (sum == G) break;
        __builtin_amdgcn_s_sleep(1);
        if ((++sp & 255u) == 0u) { if (xb_ld(&bar[XB_TMO])) break; if (sp > XB_SPIN_CAP) { atomicAdd(&bar[XB_TMO], 1u); break; } }
    }
    nloc = mine > 0u ? mine : 1u; nx = cnt > 0u ? cnt : 1u;
}

__device__ __forceinline__ void xcd_barrier(const XcdBarrier& b) {
    asm volatile("s_waitcnt vmcnt(0)" ::: "memory");
    __syncthreads();
    if (threadIdx.x == 0) {
        unsigned* bar = b.bar; const unsigned bx_ = xb_xcc_id();
        __builtin_amdgcn_s_waitcnt(0);
        unsigned nloc = b.st[0], nx = b.st[1];
        if (nloc == 0u) { xcd_barrier_complete(bar, bx_, nloc, nx); b.st[0] = nloc; b.st[1] = nx; }
        const unsigned old = xb_add(&bar[XB_XSUB(bx_)], 1u);
        const unsigned gen = old / nloc;
        if (old + 1u == (gen + 1u) * nloc) {
            __builtin_amdgcn_fence(__ATOMIC_RELEASE, "agent");
            asm volatile("s_waitcnt vmcnt(0)" ::: "memory");
            const unsigned og = xb_add(&bar[XB_TOP], 1u);
            const unsigned tg = og / nx;
            if (og + 1u == (tg + 1u) * nx) xb_add(&bar[XB_TOPGEN], 1u);
            else XB_SPIN(xb_ld(&bar[XB_TOPGEN]) == tg, bar);
            __builtin_amdgcn_fence(__ATOMIC_ACQUIRE, "agent");
            xb_add(&bar[XB_XGEN(bx_)], 1u);
            asm volatile("s_waitcnt vmcnt(0)" ::: "memory");
        } else {
            XB_SPIN(xb_ld(&bar[XB_XGEN(bx_)]) == gen, bar);
            __builtin_amdgcn_fence(__ATOMIC_ACQUIRE, "agent");
            asm volatile("s_waitcnt vmcnt(0)" ::: "memory");
        }
    }
    __syncthreads();
}


template <int MAP> __device__ __forceinline__ int map_row(int n) {
    if (MAP == 1) { const int isb = n >= DFF ? 1 : 0; const int h = n - isb * DFF; return (h >> 7) * 256 + isb * 128 + (h & 127); }
    if (MAP == 2) return n < 4368 ? n : n + 240;
    return n;
}
struct TrJob { const float* W; bf16* WT; const float* gain; int K, N, map; };
__device__ __forceinline__ int map_row_rt(int map, int n) { return map == 1 ? map_row<1>(n) : (map == 2 ? map_row<2>(n) : n); }
__device__ __forceinline__ void tr_load(const TrJob& jb, int tile, int tid, f32x4 (&v)[8][2], int& k0, int& n0) {
    const int nblk = (jb.N + 127) / 128, kt = tile / nblk, nt = tile - kt * nblk; k0 = 256 * kt; n0 = 128 * nt;
    const int c4 = (tid & 15) + 16 * ((tid >> 6) & 1), rp = ((tid >> 4) & 3) + 4 * (tid >> 7);
    int col = n0 + 4 * c4; col = col < jb.N - 4 ? col : jb.N - 4;
    const float* wp = jb.W + (size_t)(k0 + 2 * rp) * jb.N + col;
#pragma unroll
    for (int i = 0; i < 8; ++i) { v[i][0] = *(const f32x4*)(wp + (size_t)(32 * i) * jb.N); v[i][1] = *(const f32x4*)(wp + (size_t)(32 * i + 1) * jb.N); }
    if (jb.gain) {
#pragma unroll
        for (int i = 0; i < 8; ++i) { const float ga = jb.gain[k0 + 32 * i + 2 * rp], gb = jb.gain[k0 + 32 * i + 2 * rp + 1]; v[i][0] = v[i][0] * ga; v[i][1] = v[i][1] * gb; } }
}
__device__ __forceinline__ void tr_to_lds(LAS unsigned* T, int tid, const f32x4 (&v)[8][2]) {
    const int c4 = (tid & 15) + 16 * ((tid >> 6) & 1), rp = ((tid >> 4) & 3) + 4 * (tid >> 7);
#pragma unroll
    for (int i = 0; i < 8; ++i)
#pragma unroll
        for (int j = 0; j < 4; ++j) T[(4 * c4 + j) * 132 + 16 * i + rp] = pk2(v[i][0][j], v[i][1][j]);
}
__device__ __forceinline__ void tr_store(const TrJob& jb, const LAS unsigned* T, int tid, int k0, int n0) {
    const int w = tid >> 6, lane = tid & 63, c = 8 * (w >> 1) + (lane & 7), nb = 64 * (w & 1) + (lane >> 3);
#pragma unroll
    for (int j = 0; j < 8; ++j) { const int n = nb + 8 * j; const v4u o = *(const LAS v4u*)(T + n * 132 + 4 * c);
        if (n0 + n < jb.N) *(v4u*)(jb.WT + pg8::blk_off(map_row_rt(jb.map, n0 + n), k0 + 8 * c, jb.K)) = o; }
}

struct Args { const void* in[22]; float* out; unsigned char* ws; };

constexpr int TL_WI1 = 0, TL_WO1 = 704, TL_WIN = 1056, TL_BRA = 1720, TL_BRP = 1768, TL_BRG = 1816, TL_WOUT = 1864, TL_WI2 = 1992, TL_WO2 = 2696, TL_LAYER = 3048, TL_ALL = DEPTH * TL_LAYER;
constexpr int CW_CLAIM = 8192;
__device__ __forceinline__ void conv_job(const Args& A, int T, TrJob& jb, int& t) {
    const int l = T / TL_LAYER, r = T - l * TL_LAYER;
    unsigned char* wl = A.ws + WS_W + (size_t)l * LW_END;
    if (r < TL_WO1)       { jb = TrJob{(const float*)A.in[3] + (size_t)l * DM * NWI, (bf16*)(wl + LW_WI1), (const float*)A.in[2] + (size_t)l * DM, DM, NWI, 1}; t = r; }
    else if (r < TL_WIN)  { jb = TrJob{(const float*)A.in[4] + (size_t)l * DFF * DM, (bf16*)(wl + LW_WO1), nullptr, DFF, DM, 0}; t = r - TL_WO1; }
    else if (r < TL_BRA)  { jb = TrJob{(const float*)A.in[6] + (size_t)l * DM * NPROJ_SRC, (bf16*)(wl + LW_WIN), (const float*)A.in[5] + (size_t)l * DM, DM, NPROJ_SRC, 2}; t = r - TL_WIN; }
    else if (r < TL_BRP)  { jb = TrJob{(const float*)A.in[14] + (size_t)l * BRW * DM, (bf16*)(wl + LW_WBR), nullptr, BRW, DM, 0}; t = r - TL_BRA; }
    else if (r < TL_BRG)  { jb = TrJob{(const float*)A.in[15] + (size_t)l * BRW * DM, (bf16*)(wl + LW_WBR) + (size_t)DM * BRW, nullptr, BRW, DM, 0}; t = r - TL_BRP; }
    else if (r < TL_WOUT) { jb = TrJob{(const float*)A.in[16] + (size_t)l * BRW * DM, (bf16*)(wl + LW_WBR) + (size_t)2 * DM * BRW, nullptr, BRW, DM, 0}; t = r - TL_BRG; }
    else if (r < TL_WI2)  { jb = TrJob{(const float*)A.in[17] + (size_t)l * DM * DM, (bf16*)(wl + LW_WOUT), nullptr, DM, DM, 0}; t = r - TL_WOUT; }
    else if (r < TL_WO2)  { jb = TrJob{(const float*)A.in[19] + (size_t)l * DM * NWI, (bf16*)(wl + LW_WI2), (const float*)A.in[18] + (size_t)l * DM, DM, NWI, 1}; t = r - TL_WI2; }
    else                  { jb = TrJob{(const float*)A.in[20] + (size_t)l * DFF * DM, (bf16*)(wl + LW_WO2), nullptr, DFF, DM, 0}; t = r - TL_WO2; }
}
__device__ __forceinline__ void conv_claim(unsigned* ctr, volatile LAS unsigned* slot, int limit, int extra) {
    unsigned T = 0xffffffffu; const unsigned cur = __hip_atomic_load(ctr, __ATOMIC_RELAXED, __HIP_MEMORY_SCOPE_AGENT);
    const bool need = (int)cur < limit, opt = !need && extra > 0 && (int)cur < TL_ALL;
    if (need || opt) T = __hip_atomic_fetch_add(ctr, 1u, __ATOMIC_RELAXED, __HIP_MEMORY_SCOPE_AGENT);
    if (T != 0xffffffffu && (int)T >= TL_ALL) T = 0xffffffffu;
    slot[0] = T; slot[1] = need ? 0u : 1u;
}
__device__ __forceinline__ void conv_until(const Args& A, LAS unsigned char* lds, int limit, int extra) {
    unsigned* ctr = (unsigned*)(A.ws + WS_CTL) + CW_CLAIM; volatile LAS unsigned* slot = (volatile LAS unsigned*)(lds + MISC_OFF) + 16;
    LAS unsigned* Tl = (LAS unsigned*)(lds + RING_OFF);
    if (limit > TL_ALL) limit = TL_ALL;
    int tid = threadIdx.x; asm volatile("" : "+v"(tid));
    if (tid == 0) conv_claim(ctr, slot, limit, extra);
    __syncthreads();
    unsigned T = slot[0]; if (slot[1]) --extra;
    __syncthreads();
    if (T == 0xffffffffu) return;
    f32x4 v[8][2]; TrJob jb; int t, k0, n0;
    conv_job(A, (int)T, jb, t); tr_load(jb, t, tid, v, k0, n0);
#pragma unroll 1
    for (;;) {
        tr_to_lds(Tl, tid, v);
        if (tid == 0) conv_claim(ctr, slot, limit, extra);
        __syncthreads();
        const unsigned Tn = slot[0]; if (slot[1]) --extra;
        const TrJob cj = jb; const int ck0 = k0, cn0 = n0;
        if (Tn != 0xffffffffu) { conv_job(A, (int)Tn, jb, t); tr_load(jb, t, tid, v, k0, n0); }
        tr_store(cj, Tl, tid, ck0, cn0);
        __syncthreads();
        if (Tn == 0xffffffffu) break;
    }
}

__device__ __forceinline__ void p0_prologue(const Args& A, LAS unsigned char* lds, int gw, int NGW, int wave, int lane) {
    for (int i = gw * 64 + lane; i < DEPTH * 240 * DM / 8; i += NGW * 64) { const int l = i / (240 * DM / 8), j = i - l * (240 * DM / 8);
        *(v4u*)((bf16*)(A.ws + WS_W + (size_t)l * LW_END + LW_WIN) + pg8::blk_off(4368 + (j >> 8), 8 * (j & 255), DM)) = (v4u){0u, 0u, 0u, 0u}; }
    { const float* x = (const float*)A.in[0]; bf16* XB = (bf16*)(A.ws + WS_H); unsigned long long* ssq0 = (unsigned long long*)(A.ws + WS_CTL + CTL_SSQ);
      for (int r = gw; r < NTOK; r += NGW) { const f32x4* xr = (const f32x4*)(x + (size_t)r * DM); float sq = 0.f;
#pragma unroll
          for (int j = 0; j < 4; ++j) { const f32x4 a = xr[j * 128 + lane * 2], b = xr[j * 128 + lane * 2 + 1];
              sq += (a.x * a.x + a.y * a.y) + (a.z * a.z + a.w * a.w) + (b.x * b.x + b.y * b.y) + (b.z * b.z + b.w * b.w);
              v4u o; o.x = pk2(a.x, a.y); o.y = pk2(a.z, a.w); o.z = pk2(b.x, b.y); o.w = pk2(b.z, b.w);
              *(v4u*)(XB + pg8::blk_off(r, j * 512 + lane * 8, DM)) = o; }
          sq = wave_sum(sq); if (lane == 0) ssq0[r] = (unsigned long long)(sq * 1048576.0f + 0.5f); } }
    { const float* wp = (const float*)A.in[9]; const float* ps = (const float*)A.in[10]; bf16* wpt = (bf16*)(A.ws + WS_WPT);
      for (int i = gw * 64 + lane; i < DEPTH * 4 * 192 * 192; i += NGW * 64) { const int cc = i % 192, d = (i / 192) % 192, lg = i / (192 * 192);
          wpt[i] = (bf16)f2bf(wp[((size_t)lg * 192 + cc) * 192 + d] * ps[lg * 192 + d]); } }
    const int* pos = (const int*)A.in[1];
    float* cs = (float*)(A.ws + WS_ROPE); float* sn = cs + (size_t)NTOK * 32;
    for (int i = gw * 64 + lane; i < NTOK * 32; i += NGW * 64) { const int t = i >> 5, f = i & 31;
        const double inv = exp(-(double)f * (9.210340371976184 / 32.0));
        const double ang = (double)pos[t] * inv; cs[i] = (float)cos(ang); sn[i] = (float)sin(ang); }
}

__device__ __forceinline__ void rmsnorm_phase(const float* X, const float* g, bf16* H, int gw, int NGW, int lane) {
    asm volatile("" : "+v"(lane));
    for (int r = gw; r < NTOK; r += NGW) {
        const f32x4* xr = (const f32x4*)(X + (size_t)r * DM);
        f32x4 v[8]; float s = 0.f;
#pragma unroll
        for (int j = 0; j < 4; ++j) { v[2 * j] = xr[j * 128 + lane * 2]; v[2 * j + 1] = xr[j * 128 + lane * 2 + 1]; }
#pragma unroll
        for (int j = 0; j < 8; ++j) s += (v[j].x * v[j].x + v[j].y * v[j].y) + (v[j].z * v[j].z + v[j].w * v[j].w);
        const float rstd = 1.0f / sqrtf(wave_sum(s) * (1.0f / DM) + EPS);
#pragma unroll
        for (int j = 0; j < 4; ++j) { const f32x4 g0 = ((const f32x4*)g)[j * 128 + lane * 2], g1 = ((const f32x4*)g)[j * 128 + lane * 2 + 1];
            const f32x4 a = v[2 * j] * rstd * g0, b = v[2 * j + 1] * rstd * g1;
            v4u o; o.x = pk2(a.x, a.y); o.y = pk2(a.z, a.w); o.z = pk2(b.x, b.y); o.w = pk2(b.z, b.w);
            *(v4u*)(H + (size_t)r * DM + j * 512 + lane * 8) = o; }
    }
}
__device__ __forceinline__ void final_phase(const bf16* XB, const unsigned long long* ssq, const float* g, float* out, int gw, int NGW, int lane) {
    asm volatile("" : "+v"(lane));
    for (int r = gw; r < NTOK; r += NGW) {
        const float rstd = pg8::rstd_of(ssq[r]);
#pragma unroll
        for (int j = 0; j < 4; ++j) { const int c0 = j * 512 + lane * 8; const v4u x = *(const v4u*)(XB + pg8::blk_off(r, c0, DM));
            const f32x4 g0 = *(const f32x4*)(g + c0), g1 = *(const f32x4*)(g + c0 + 4);
            *(f32x4*)(out + (size_t)r * DM + c0) = (f32x4){bflo(x.x), bfhi(x.x), bflo(x.y), bfhi(x.y)} * rstd * g0;
            *(f32x4*)(out + (size_t)r * DM + c0 + 4) = (f32x4){bflo(x.z), bfhi(x.z), bflo(x.w), bfhi(x.w)} * rstd * g1; }
    }
}

typedef short bf16x8_t __attribute__((ext_vector_type(8)));
typedef unsigned v2u __attribute__((ext_vector_type(2)));
__device__ __forceinline__ void att_unit(LAS unsigned char* lds, const bf16* PROJ, const float* COS, const float* SIN, const float* sinks, bf16* YA, int u) {
    int tid = threadIdx.x; asm volatile("" : "+v"(tid));
    const int b = u >> 6, kvh = (u >> 4) & 3, blk = u & 15;
    LAS bf16* Ks = (LAS bf16*)lds;
    LAS bf16* VT = Ks + 256 * 72;
    const int tok0 = b * SEQ + 128 * (blk - 1);
    const int kk0 = blk == 0 ? 128 : 0;
    for (int idx = tid; idx < 256 * 4; idx += 512) { const int kk = idx >> 2, c4 = idx & 3;
        v4u w1 = (v4u){0u, 0u, 0u, 0u}, w2 = w1;
        if (kk >= kk0) { const size_t t = (size_t)(tok0 + kk);
            const v4u lo = *(const v4u*)(PROJ + t * NPROJ + C_KA + kvh * 64 + 8 * c4), hi = *(const v4u*)(PROJ + t * NPROJ + C_KA + kvh * 64 + 32 + 8 * c4);
            const f32x4 c0 = *(const f32x4*)(COS + t * 32 + 8 * c4), c1 = *(const f32x4*)(COS + t * 32 + 8 * c4 + 4), s0 = *(const f32x4*)(SIN + t * 32 + 8 * c4), s1 = *(const f32x4*)(SIN + t * 32 + 8 * c4 + 4);
            const float x1[8] = {bflo(lo.x), bfhi(lo.x), bflo(lo.y), bfhi(lo.y), bflo(lo.z), bfhi(lo.z), bflo(lo.w), bfhi(lo.w)};
            const float x2[8] = {bflo(hi.x), bfhi(hi.x), bflo(hi.y), bfhi(hi.y), bflo(hi.z), bfhi(hi.z), bflo(hi.w), bfhi(hi.w)};
            const float cc[8] = {c0.x, c0.y, c0.z, c0.w, c1.x, c1.y, c1.z, c1.w}, ss[8] = {s0.x, s0.y, s0.z, s0.w, s1.x, s1.y, s1.z, s1.w};
            float q1[8], q2[8];
#pragma unroll
            for (int j = 0; j < 8; ++j) { q1[j] = x1[j] * cc[j] - x2[j] * ss[j]; q2[j] = x2[j] * cc[j] + x1[j] * ss[j]; }
            w1.x = pk2(q1[0], q1[1]); w1.y = pk2(q1[2], q1[3]); w1.z = pk2(q1[4], q1[5]); w1.w = pk2(q1[6], q1[7]);
            w2.x = pk2(q2[0], q2[1]); w2.y = pk2(q2[2], q2[3]); w2.z = pk2(q2[4], q2[5]); w2.w = pk2(q2[6], q2[7]); }
        *(LAS v4u*)(Ks + kk * 72 + 8 * c4) = w1; *(LAS v4u*)(Ks + kk * 72 + 32 + 8 * c4) = w2; }
    for (int idx = tid; idx < 256 * 8; idx += 512) { const int ch = idx >> 8, kk = idx & 255;
        v4u w = (v4u){0u, 0u, 0u, 0u};
        if (kk >= kk0) w = *(const v4u*)(PROJ + (size_t)(tok0 + kk) * NPROJ + C_VA + kvh * 64 + ch * 8);
        LAS bf16* vp = VT + (ch * 8) * 264 + kk;
        vp[0 * 264] = (bf16)(w.x & 0xffffu); vp[1 * 264] = (bf16)(w.x >> 16); vp[2 * 264] = (bf16)(w.y & 0xffffu); vp[3 * 264] = (bf16)(w.y >> 16);
        vp[4 * 264] = (bf16)(w.z & 0xffffu); vp[5 * 264] = (bf16)(w.z >> 16); vp[6 * 264] = (bf16)(w.w & 0xffffu); vp[7 * 264] = (bf16)(w.w >> 16); }
    const int wave = __builtin_amdgcn_readfirstlane(tid >> 6), lane = tid & 63, g = lane >> 4, c = lane & 15;
    v4u qlo, qhi, nlo, nhi; f32x4 qc0, qc1, qs0, qs1, nc0, nc1, ns0, ns1;
#define ATT_LOADQ(LO, HI, C0, C1, S0, S1, ti_) do { const int id_ = 3 * wave + (ti_), hq_ = kvh * 3 + (id_ >> 3); const size_t t_ = (size_t)(b * SEQ + 128 * blk + 16 * (id_ & 7) + c); \
        LO = *(const v4u*)(PROJ + t_ * NPROJ + C_QA + hq_ * 64 + 8 * g); HI = *(const v4u*)(PROJ + t_ * NPROJ + C_QA + hq_ * 64 + 32 + 8 * g); \
        C0 = *(const f32x4*)(COS + t_ * 32 + 8 * g); C1 = *(const f32x4*)(COS + t_ * 32 + 8 * g + 4); S0 = *(const f32x4*)(SIN + t_ * 32 + 8 * g); S1 = *(const f32x4*)(SIN + t_ * 32 + 8 * g + 4); } while (0)
    ATT_LOADQ(qlo, qhi, qc0, qc1, qs0, qs1, 0);
    __syncthreads();
#pragma unroll 1
    for (int ti = 0; ti < 3; ++ti) {
        const int id = 3 * wave + ti, gq = id >> 3, qt = id & 7, hq = kvh * 3 + gq, qi = 16 * qt + c, kb0 = qt >> 1;
        const size_t t = (size_t)(b * SEQ + 128 * blk + qi);
        if (ti + 1 < 3) ATT_LOADQ(nlo, nhi, nc0, nc1, ns0, ns1, ti + 1);
        bf16x8_t qb[2];
        { const float x1[8] = {bflo(qlo.x), bfhi(qlo.x), bflo(qlo.y), bfhi(qlo.y), bflo(qlo.z), bfhi(qlo.z), bflo(qlo.w), bfhi(qlo.w)};
          const float x2[8] = {bflo(qhi.x), bfhi(qhi.x), bflo(qhi.y), bfhi(qhi.y), bflo(qhi.z), bfhi(qhi.z), bflo(qhi.w), bfhi(qhi.w)};
          const float cc[8] = {qc0.x, qc0.y, qc0.z, qc0.w, qc1.x, qc1.y, qc1.z, qc1.w}, ss[8] = {qs0.x, qs0.y, qs0.z, qs0.w, qs1.x, qs1.y, qs1.z, qs1.w};
          float q1[8], q2[8];
#pragma unroll
          for (int j = 0; j < 8; ++j) { q1[j] = (x1[j] * cc[j] - x2[j] * ss[j]) * 0.125f; q2[j] = (x2[j] * cc[j] + x1[j] * ss[j]) * 0.125f; }
          v4u w1, w2; w1.x = pk2(q1[0], q1[1]); w1.y = pk2(q1[2], q1[3]); w1.z = pk2(q1[4], q1[5]); w1.w = pk2(q1[6], q1[7]);
          w2.x = pk2(q2[0], q2[1]); w2.y = pk2(q2[2], q2[3]); w2.z = pk2(q2[4], q2[5]); w2.w = pk2(q2[6], q2[7]);
          qb[0] = __builtin_bit_cast(bf16x8_t, w1); qb[1] = __builtin_bit_cast(bf16x8_t, w2); }
        bf16x8_t kf[10][2];
#pragma unroll
        for (int kt = 0; kt < 10; ++kt)
#pragma unroll
            for (int ks = 0; ks < 2; ++ks) kf[kt][ks] = *(const LAS bf16x8_t*)(Ks + (32 * kb0 + 16 * kt + c) * 72 + 32 * ks + 8 * g);
        __builtin_amdgcn_sched_barrier(0);
        f32x4 st[10];
#pragma unroll
        for (int kt = 0; kt < 10; ++kt) { f32x4 acc = (f32x4){0.f, 0.f, 0.f, 0.f};
#pragma unroll
            for (int ks = 0; ks < 2; ++ks) acc = __builtin_amdgcn_mfma_f32_16x16x32_bf16(kf[kt][ks], qb[ks], acc, 0, 0, 0);
            st[kt] = acc; }
        v2u vlo[5][4], vhi[5][4];
#pragma unroll
        for (int ks = 0; ks < 5; ++ks)
#pragma unroll
            for (int dt = 0; dt < 4; ++dt) { const LAS bf16* vr = VT + (16 * dt + c) * 264 + 32 * (kb0 + ks) + 4 * g; vlo[ks][dt] = *(const LAS v2u*)vr; vhi[ks][dt] = *(const LAS v2u*)(vr + 16); }
        const float sink = sinks[hq];
        float m = sink;
#pragma unroll
        for (int kt = 0; kt < 10; ++kt)
#pragma unroll
            for (int r = 0; r < 4; ++r) { const int kk = 32 * kb0 + 16 * kt + 4 * g + r; const bool ok = (kk >= qi + 1) && (kk <= qi + 128) && (kk >= kk0);
                st[kt][r] = ok ? st[kt][r] : -1e30f; m = fmaxf(m, st[kt][r]); }
        m = fmaxf(m, __shfl_xor(m, 16)); m = fmaxf(m, __shfl_xor(m, 32));
        float l = 0.f;
#pragma unroll
        for (int kt = 0; kt < 10; ++kt)
#pragma unroll
            for (int r = 0; r < 4; ++r) { const float p = (st[kt][r] > -1e29f) ? __expf(st[kt][r] - m) : 0.f; st[kt][r] = p; l += p; }
        l += __shfl_xor(l, 16); l += __shfl_xor(l, 32);
        l += __expf(sink - m);
        f32x4 o[4];
#pragma unroll
        for (int dt = 0; dt < 4; ++dt) o[dt] = (f32x4){0.f, 0.f, 0.f, 0.f};
#pragma unroll
        for (int ks = 0; ks < 5; ++ks) { v4u pw; pw.x = pk2(st[2 * ks][0], st[2 * ks][1]); pw.y = pk2(st[2 * ks][2], st[2 * ks][3]); pw.z = pk2(st[2 * ks + 1][0], st[2 * ks + 1][1]); pw.w = pk2(st[2 * ks + 1][2], st[2 * ks + 1][3]);
            const bf16x8_t pb = __builtin_bit_cast(bf16x8_t, pw);
#pragma unroll
            for (int dt = 0; dt < 4; ++dt) { const v4u aw = (v4u){vlo[ks][dt].x, vlo[ks][dt].y, vhi[ks][dt].x, vhi[ks][dt].y};
                o[dt] = __builtin_amdgcn_mfma_f32_16x16x32_bf16(__builtin_bit_cast(bf16x8_t, aw), pb, o[dt], 0, 0, 0); } }
        const float inv = 1.0f / l;
#pragma unroll
        for (int dt = 0; dt < 4; ++dt) { v2u w; w.x = pk2(o[dt][0] * inv, o[dt][1] * inv); w.y = pk2(o[dt][2] * inv, o[dt][3] * inv);
            *(v2u*)(YA + pg8::blk_off((int)t, hq * 64 + 16 * dt + 4 * g, BRW)) = w; }
        qlo = nlo; qhi = nhi; qc0 = nc0; qc1 = nc1; qs0 = ns0; qs1 = ns1;
    }
#undef ATT_LOADQ
    __syncthreads();
}

__device__ __forceinline__ void pool_unit(LAS unsigned char* lds, const bf16* PROJ, const bf16* WPT, bf16* YP, int u) {
    int tid = threadIdx.x; asm volatile("" : "+v"(tid));
    const int tile = u >> 2, gp = u & 3, w = 2 << gp;
    const int t0 = tile * 64, s0 = t0 & (SEQ - 1);
    LAS float* U = (LAS float*)lds;
    LAS bf16* DA = (LAS bf16*)(U + 79 * 192);
    for (int idx = tid; idx < 79 * 24; idx += 512) { const int rr = idx / 24, cq = idx - rr * 24; const int srel = s0 - 15 + rr;
        v4u w = (v4u){0u, 0u, 0u, 0u}; if (srel >= 0) w = *(const v4u*)(PROJ + (size_t)(t0 - 15 + rr) * NPROJ + C_PU + gp * 192 + cq * 8);
        *(LAS f32x4*)(U + rr * 192 + cq * 8) = (f32x4){bflo(w.x), bfhi(w.x), bflo(w.y), bfhi(w.y)}; *(LAS f32x4*)(U + rr * 192 + cq * 8 + 4) = (f32x4){bflo(w.z), bfhi(w.z), bflo(w.w), bfhi(w.w)}; }
    __syncthreads();
    for (int idx = tid; idx < 8 * 192; idx += 512) { const int run = idx / 192, c = idx - run * 192, tokb = 8 * run;
        int sq = s0 + tokb; int cnt = (sq + 1) < w ? (sq + 1) : w;
        float sum = 0.f; for (int j = 0; j < cnt; ++j) sum += U[(15 + tokb - j) * 192 + c];
        DA[tokb * 200 + c] = (bf16)f2bf(sum / (float)cnt - U[(15 + tokb) * 192 + c]);
#pragma unroll
        for (int i = 1; i < 8; ++i) { const int tok = tokb + i; sq = s0 + tok; const float ut = U[(15 + tok) * 192 + c];
            sum += ut; if (sq >= w) sum -= U[(15 + tok - w) * 192 + c];
            cnt = (sq + 1) < w ? (sq + 1) : w;
            DA[tok * 200 + c] = (bf16)f2bf(sum / (float)cnt - ut); } }
    __syncthreads();
    {
        const int wave = __builtin_amdgcn_readfirstlane(tid >> 6), lane = tid & 63, g = lane >> 4, c = lane & 15, mt = wave & 3, nh = wave >> 2;
        bf16x8_t db[6];
#pragma unroll
        for (int ks = 0; ks < 6; ++ks) db[ks] = *(const LAS bf16x8_t*)(DA + (16 * mt + c) * 200 + 32 * ks + 8 * g);
        const bf16* wbase = WPT + (size_t)gp * 192 * 192;
#pragma unroll 3
        for (int ni = 0; ni < 6; ++ni) { const int nt = 6 * nh + ni;
            f32x4 acc = (f32x4){0.f, 0.f, 0.f, 0.f};
#pragma unroll
            for (int ks = 0; ks < 6; ++ks) { const bf16x8_t a = *(const bf16x8_t*)(wbase + (size_t)(16 * nt + c) * 192 + 32 * ks + 8 * g);
                acc = __builtin_amdgcn_mfma_f32_16x16x32_bf16(a, db[ks], acc, 0, 0, 0); }
            v2u wv; wv.x = pk2(acc[0], acc[1]); wv.y = pk2(acc[2], acc[3]);
            *(v2u*)(YP + pg8::blk_off(t0 + 16 * mt + c, gp * 192 + 16 * nt + 4 * g, BRW)) = wv; }
    }
    __syncthreads();
}

constexpr size_t GP_QT = 0, GP_KST = 12288, GP_A = 24576, GP_VT = 32768, GP_DEC = 57344, GP_ITEM = 57856;
__device__ __forceinline__ void gla_pre_item(LAS unsigned char* lds, const bf16* PROJ, const float* A2, const float* ba, unsigned char* GPRE, int item) {
    int tid = threadIdx.x; asm volatile("" : "+v"(tid));
    const int bh = item >> 5, ch = item & 31, b = bh >> 2, h = bh & 3;
    const size_t tok0 = (size_t)(b * SEQ + ch * 64);
    unsigned char* gp = GPRE + (size_t)item * GP_ITEM;
    LAS float* LRs = (LAS float*)lds;
    LAS float* A2s = LRs + 64 * 16;
    LAS float* Bs = A2s + 16 * 96;
    LAS bf16* QTs = (LAS bf16*)(Bs + 64 * 96);
    LAS bf16* KTs = QTs + 64 * 104;
    LAS bf16* KSTs = KTs + 64 * 104;
    LAS bf16* VTs = KSTs + 96 * 72;
    if (tid < 128) { const int t = tid >> 1, hq = tid & 1; const v4u w = *(const v4u*)(PROJ + (tok0 + t) * NPROJ + C_LR + hq * 8);
        *(LAS f32x4*)(LRs + t * 16 + hq * 8) = (f32x4){bflo(w.x), bfhi(w.x), bflo(w.y), bfhi(w.y)}; *(LAS f32x4*)(LRs + t * 16 + hq * 8 + 4) = (f32x4){bflo(w.z), bfhi(w.z), bflo(w.w), bfhi(w.w)}; }
    for (int idx = tid; idx < 64 * 24; idx += 512) { const int t = idx / 24, cq = idx - t * 24;
        if (cq < 12) *(LAS v4u*)(QTs + t * 104 + cq * 8) = *(const v4u*)(PROJ + (tok0 + t) * NPROJ + C_QG + h * 96 + cq * 8);
        else *(LAS v4u*)(KTs + t * 104 + (cq - 12) * 8) = *(const v4u*)(PROJ + (tok0 + t) * NPROJ + C_KG + h * 96 + (cq - 12) * 8); }
    for (int idx = tid; idx < 16 * 96; idx += 512) { const int r = idx / 96, d = idx - r * 96; A2s[idx] = A2[r * 384 + h * 96 + d]; }
    for (int idx = tid; idx < 64 * 24; idx += 512) { const int t = idx / 24, cq = idx - t * 24;
        const v4u w = *(const v4u*)(PROJ + (tok0 + t) * NPROJ + C_VG + h * 192 + cq * 8);
        LAS bf16* vp = VTs + (cq * 8) * 72 + t;
        vp[0 * 72] = (bf16)(w.x & 0xffffu); vp[1 * 72] = (bf16)(w.x >> 16); vp[2 * 72] = (bf16)(w.y & 0xffffu); vp[3 * 72] = (bf16)(w.y >> 16);
        vp[4 * 72] = (bf16)(w.z & 0xffffu); vp[5 * 72] = (bf16)(w.z >> 16); vp[6 * 72] = (bf16)(w.w & 0xffffu); vp[7 * 72] = (bf16)(w.w >> 16); }
    __syncthreads();
    {
        const int wv = __builtin_amdgcn_readfirstlane(tid >> 6), ln = tid & 63, g = ln >> 4, c = ln & 15;
#pragma unroll
        for (int rep3 = 0; rep3 < 3; ++rep3) { const int id = wv + 8 * rep3, tt = id / 6, dd = id - tt * 6;
            f32x4 z = (f32x4){0.f, 0.f, 0.f, 0.f};
#pragma unroll
            for (int ks = 0; ks < 4; ++ks) z = __builtin_amdgcn_mfma_f32_16x16x4f32(LRs[(16 * tt + c) * 16 + 4 * ks + g], A2s[(4 * ks + g) * 96 + 16 * dd + c], z, 0, 0, 0);
            const float bb = ba[h * 96 + 16 * dd + c];
#pragma unroll
            for (int r = 0; r < 4; ++r) { const float zz = z[r] + bb; const float ls = fminf(zz, 0.f) - __logf(1.0f + __expf(-fabsf(zz)));
                Bs[(16 * tt + 4 * g + r) * 96 + 16 * dd + c] = ls * (1.0f / 16.0f); } }
    }
    __syncthreads();
    if (tid < 96) { float gv[64];
#pragma unroll
        for (int t = 0; t < 64; ++t) gv[t] = Bs[t * 96 + tid];
        float run = 0.f;
#pragma unroll
        for (int t = 0; t < 64; ++t) { run += gv[t]; Bs[t * 96 + tid] = run; } }
    __syncthreads();
    const float qscale = 0.10206207261596575f;
    for (int idx = tid; idx < 64 * 96; idx += 512) { const int t = idx / 96, d = idx - t * 96;
        const float bb = Bs[idx], bl = Bs[63 * 96 + d];
        const float q = bf2f(QTs[t * 104 + d]), k = bf2f(KTs[t * 104 + d]);
        QTs[t * 104 + d] = (bf16)f2bf(q * qscale * __expf(bb)); KTs[t * 104 + d] = (bf16)f2bf(k * __expf(-bb)); KSTs[d * 72 + t] = (bf16)f2bf(k * __expf(bl - bb)); }
    if (tid < 96) ((float*)(gp + GP_DEC))[tid] = __expf(Bs[63 * 96 + tid]);
    __syncthreads();
    for (int idx = tid; idx < 64 * 12; idx += 512) { const int r = idx / 12, cq = idx - r * 12; *(v4u*)(gp + GP_QT + r * 192 + cq * 16) = *(const LAS v4u*)(QTs + r * 104 + cq * 8); }
    for (int idx = tid; idx < 96 * 8; idx += 512) { const int r = idx >> 3, cq = idx & 7; *(v4u*)(gp + GP_KST + r * 128 + cq * 16) = *(const LAS v4u*)(KSTs + r * 72 + cq * 8); }
    for (int idx = tid; idx < 192 * 8; idx += 512) { const int r = idx >> 3, cq = idx & 7; *(v4u*)(gp + GP_VT + r * 128 + cq * 16) = *(const LAS v4u*)(VTs + r * 72 + cq * 8); }
    {
        const int wave = __builtin_amdgcn_readfirstlane(tid >> 6), lane = tid & 63, g = lane >> 4, c = lane & 15;
#pragma unroll
        for (int rep = 0; rep < 2; ++rep) { const int id = wave + 8 * rep, it = id >> 2, jt = id & 3;
            f32x4 acc = (f32x4){0.f, 0.f, 0.f, 0.f};
            if (jt <= it) {
#pragma unroll
                for (int ks = 0; ks < 3; ++ks) { const bf16x8_t a = *(const LAS bf16x8_t*)(KTs + (16 * jt + c) * 104 + 32 * ks + 8 * g), bq = *(const LAS bf16x8_t*)(QTs + (16 * it + c) * 104 + 32 * ks + 8 * g);
                    acc = __builtin_amdgcn_mfma_f32_16x16x32_bf16(a, bq, acc, 0, 0, 0); } }
            const int i = 16 * it + c, j0 = 16 * jt + 4 * g;
            v2u w; w.x = pk2(j0 + 0 <= i ? acc[0] : 0.f, j0 + 1 <= i ? acc[1] : 0.f); w.y = pk2(j0 + 2 <= i ? acc[2] : 0.f, j0 + 3 <= i ? acc[3] : 0.f);
            *(v2u*)(gp + GP_A + i * 128 + j0 * 2) = w; }
    }
    __syncthreads();
}
constexpr int GS_QT = 0, GS_KST = 13312, GS_A = 27136, GS_VT = 36352, GS_DEC = 45568, GS_BUF = 46080;
__device__ __forceinline__ void gla_scan_unit(LAS unsigned char* lds, const unsigned char* GPRE, float* GO, int u) {
    int tid = threadIdx.x; asm volatile("" : "+v"(tid));
    const int bh = u / 3, s3 = u - 3 * bh, b = bh >> 2, h = bh & 3;
    const int wave = __builtin_amdgcn_readfirstlane(tid >> 6), lane = tid & 63, g = lane >> 4, c = lane & 15, th = wave >> 2, jt = wave & 3;
    int goff[5], loff[5];
#pragma unroll
    for (int i = 0; i < 5; ++i) { const int q = tid + 512 * i;
        if (q < 768) { const int r = q / 12, cq = q - r * 12; goff[i] = (int)GP_QT + r * 192 + cq * 16; loff[i] = GS_QT + r * 208 + cq * 16; }
        else if (q < 1536) { const int p = q - 768, r = p >> 3, cq = p & 7; goff[i] = (int)GP_KST + r * 128 + cq * 16; loff[i] = GS_KST + r * 144 + cq * 16; }
        else if (q < 2048) { const int p = q - 1536, r = p >> 3, cq = p & 7; goff[i] = (int)GP_A + r * 128 + cq * 16; loff[i] = GS_A + r * 144 + cq * 16; }
        else { const int p = q - 2048, r = p >> 3, cq = p & 7; goff[i] = (int)GP_VT + (64 * s3 + r) * 128 + cq * 16; loff[i] = GS_VT + r * 144 + cq * 16; } }
    f32x4 S[6];
#pragma unroll
    for (int i = 0; i < 6; ++i) S[i] = (f32x4){0.f, 0.f, 0.f, 0.f};
    v4u rg[5]; v4u rd = (v4u){0u, 0u, 0u, 0u};
    { const unsigned char* gp = GPRE + (size_t)(bh * 32) * GP_ITEM;
#pragma unroll
      for (int i = 0; i < 5; ++i) rg[i] = *(const v4u*)(gp + goff[i]);
      if (tid < 24) rd = *(const v4u*)(gp + GP_DEC + tid * 16);
#pragma unroll
      for (int i = 0; i < 5; ++i) *(LAS v4u*)(lds + loff[i]) = rg[i];
      if (tid < 24) *(LAS v4u*)(lds + GS_DEC + tid * 16) = rd; }
    __syncthreads();
#pragma unroll 1
    for (int ch = 0; ch < 32; ++ch) {
        LAS unsigned char* cur = lds + (ch & 1) * GS_BUF; LAS unsigned char* nxt = lds + ((ch + 1) & 1) * GS_BUF;
        if (ch + 1 < 32) { const unsigned char* gp = GPRE + (size_t)(bh * 32 + ch + 1) * GP_ITEM;
#pragma unroll
            for (int i = 0; i < 5; ++i) rg[i] = *(const v4u*)(gp + goff[i]);
            if (tid < 24) rd = *(const v4u*)(gp + GP_DEC + tid * 16); }
        const size_t tokc = (size_t)(b * SEQ + ch * 64);
        bf16x8_t vb[2];
#pragma unroll
        for (int ks = 0; ks < 2; ++ks) vb[ks] = *(const LAS bf16x8_t*)(cur + GS_VT + (16 * jt + c) * 144 + (32 * ks + 8 * g) * 2);
        bf16x8_t sb[3];
#pragma unroll
        for (int ks = 0; ks < 3; ++ks) { v4u w; w.x = pk2(S[2 * ks][0], S[2 * ks][1]); w.y = pk2(S[2 * ks][2], S[2 * ks][3]); w.z = pk2(S[2 * ks + 1][0], S[2 * ks + 1][1]); w.w = pk2(S[2 * ks + 1][2], S[2 * ks + 1][3]);
            sb[ks] = __builtin_bit_cast(bf16x8_t, w); }
#pragma unroll
        for (int ti = 0; ti < 2; ++ti) { const int it = 2 * th + ti;
            f32x4 acc = (f32x4){0.f, 0.f, 0.f, 0.f};
#pragma unroll
            for (int ks = 0; ks < 2; ++ks) { const bf16x8_t a = *(const LAS bf16x8_t*)(cur + GS_A + (16 * it + c) * 144 + (32 * ks + 8 * g) * 2);
                acc = __builtin_amdgcn_mfma_f32_16x16x32_bf16(a, vb[ks], acc, 0, 0, 0); }
#pragma unroll
            for (int ks = 0; ks < 3; ++ks) { const v2u lo = *(const LAS v2u*)(cur + GS_QT + (16 * it + c) * 208 + (32 * ks + 4 * g) * 2), hi = *(const LAS v2u*)(cur + GS_QT + (16 * it + c) * 208 + (32 * ks + 16 + 4 * g) * 2);
                const v4u w = (v4u){lo.x, lo.y, hi.x, hi.y};
                acc = __builtin_amdgcn_mfma_f32_16x16x32_bf16(__builtin_bit_cast(bf16x8_t, w), sb[ks], acc, 0, 0, 0); }
            float* op = GO + (tokc + 16 * it + 4 * g) * BRW + h * 192 + 64 * s3 + 16 * jt + c;
            op[0 * BRW] = acc[0]; op[1 * BRW] = acc[1]; op[2 * BRW] = acc[2]; op[3 * BRW] = acc[3]; }
#pragma unroll
        for (int i = 0; i < 6; ++i) { const f32x4 d4 = *(const LAS f32x4*)(cur + GS_DEC + (16 * i + 4 * g) * 4);
            S[i] = S[i] * d4;
#pragma unroll
            for (int ks = 0; ks < 2; ++ks) { const bf16x8_t a = *(const LAS bf16x8_t*)(cur + GS_KST + (16 * i + c) * 144 + (32 * ks + 8 * g) * 2);
                S[i] = __builtin_amdgcn_mfma_f32_16x16x32_bf16(a, vb[ks], S[i], 0, 0, 0); } }
        if (ch + 1 < 32) {
#pragma unroll
            for (int i = 0; i < 5; ++i) *(LAS v4u*)(nxt + loff[i]) = rg[i];
            if (tid < 24) *(LAS v4u*)(nxt + GS_DEC + tid * 16) = rd; }
        __syncthreads();
    }
}
__device__ __forceinline__ void gla_norm_phase(const float* GO, const bf16* PROJ, const float* gnorm, bf16* YG, int gw, int NGW, int lane) {
    asm volatile("" : "+v"(lane));
    f32x4 gn[3];
#pragma unroll
    for (int j = 0; j < 3; ++j) gn[j] = *(const f32x4*)(gnorm + 12 * lane + 4 * j);
#pragma unroll 1
    for (int t0 = gw; t0 < NTOK; t0 += 4 * NGW) {
        f32x4 o[4][3]; v2u og[4][3];
#pragma unroll
        for (int q = 0; q < 4; ++q) { const int tq = t0 + q * NGW; const size_t t = (size_t)(tq < NTOK ? tq : t0);
#pragma unroll
            for (int j = 0; j < 3; ++j) { o[q][j] = *(const f32x4*)(GO + t * BRW + 12 * lane + 4 * j); og[q][j] = *(const v2u*)(PROJ + t * NPROJ + C_OG + 12 * lane + 4 * j); } }
#pragma unroll
        for (int q = 0; q < 4; ++q) { const int tq = t0 + q * NGW; if (tq >= NTOK) break; const size_t t = (size_t)tq;
            float ss = 0.f;
#pragma unroll
            for (int j = 0; j < 3; ++j) ss += (o[q][j].x * o[q][j].x + o[q][j].y * o[q][j].y) + (o[q][j].z * o[q][j].z + o[q][j].w * o[q][j].w);
            ss += __shfl_xor(ss, 1); ss += __shfl_xor(ss, 2); ss += __shfl_xor(ss, 4); ss += __shfl_xor(ss, 8);
            const float rstd = 1.0f / sqrtf(ss * (1.0f / 192.0f) + EPS);
#pragma unroll
            for (int j = 0; j < 3; ++j) { const float g0 = bflo(og[q][j].x), g1 = bfhi(og[q][j].x), g2 = bflo(og[q][j].y), g3 = bfhi(og[q][j].y);
                const float y0 = o[q][j].x * rstd * gn[j].x * (g0 / (1.0f + __expf(-g0))), y1 = o[q][j].y * rstd * gn[j].y * (g1 / (1.0f + __expf(-g1)));
                const float y2 = o[q][j].z * rstd * gn[j].z * (g2 / (1.0f + __expf(-g2))), y3 = o[q][j].w * rstd * gn[j].w * (g3 / (1.0f + __expf(-g3)));
                v2u w; w.x = pk2(y0, y1); w.y = pk2(y2, y3);
                *(v2u*)(YG + pg8::blk_off((int)t, 12 * lane + 4 * j, BRW)) = w; } }
    }
}

__global__ void __launch_bounds__(NWAVES * 64, 2) mega_fwd(Args A) {
    extern __shared__ __attribute__((aligned(16))) unsigned char lds_raw[];
    LAS unsigned char* lds = (LAS unsigned char*)lds_raw;
    const int tid = threadIdx.x;
    const int G = gridDim.x, bx = blockIdx.x;
    unsigned char* ws = A.ws;
    for (int u = tid; u < (LDS_BYTES - LDSCTL_OFF) / 4; u += NWAVES * 64) ((LAS unsigned*)(lds + LDSCTL_OFF))[u] = 0u;
    __syncthreads();
    XcdBarrier bar = xcd_barrier_post((unsigned*)(ws + WS_CTL) + CW_BAR, (volatile LAS unsigned*)(lds + MISC_OFF) + 8);

    float* X = (float*)(ws + WS_X); bf16* H = (bf16*)(ws + WS_H); bf16* ACT = (bf16*)(ws + WS_ACT); bf16* PROJ = (bf16*)(ws + WS_PROJ);
    bf16* Y = (bf16*)(ws + WS_Y); float* MACC = (float*)(ws + WS_MACC); bf16* MB = (bf16*)(ws + WS_MB); float* GO = (float*)(ws + WS_GO);
    const float* COS = (const float*)(ws + WS_ROPE); const float* SIN = COS + (size_t)NTOK * 32;

    { int t_ = threadIdx.x; asm volatile("" : "+v"(t_)); const int w_ = __builtin_amdgcn_readfirstlane(t_ >> 6); p0_prologue(A, lds, bx * NWAVES + w_, G * NWAVES, w_, t_ & 63); }
    conv_until(A, lds, TL_WO1, 0);
    xcd_barrier(bar);

#pragma unroll 1
    for (int step = 0; step < 3 * DEPTH; ++step) {
        const int l = step / 3, kind = step - 3 * l;
        unsigned char* wl = ws + WS_W + (size_t)l * LW_END;
        const unsigned long long* ssq = (const unsigned long long*)(ws + WS_CTL + CTL_SSQ) + (size_t)step * NTOK; unsigned long long* ssq_next = (unsigned long long*)(ws + WS_CTL + CTL_SSQ) + (size_t)(step + 1) * NTOK;
        if (kind != 1) {
            { pg8::Gemm g{H, (const bf16*)(wl + (kind == 0 ? LW_WI1 : LW_WI2)), NTOK, NWI, DM}; pg8::StaticOrder S; S.init(NTOK, NWI, G, bx);
              pg8::EpiSwiglu E{ACT, DFF, ssq};
              pg8::gemm_phase<pg8::EpiSwiglu, pg8::StaticOrder, true, true>(lds + RING_OFF, g, S, E); }
            { const int rem1 = ((NTOK / 256) * (NWI / 256)) % G;
              conv_until(A, lds, l * TL_LAYER + (kind == 0 ? TL_WIN : TL_LAYER), (rem1 != 0 && bx >= rem1) ? 3 : 0); }
            xcd_barrier(bar);
        } else {
            const int nunits = (NTOK / 256) * (NPROJ / 256), nfull = nunits / G, rem = nunits - nfull * G;
#pragma unroll 1
            for (int part = 0; part < 2; ++part) {
                pg8::Gemm g{H, (const bf16*)(wl + LW_WIN), NTOK, NPROJ, DM}; pg8::RangeOrder S; S.init(NTOK, NPROJ, G, bx); S.i0 = part ? nfull : 0; S.n = part ? 1 : nfull;
                pg8::EpiProj E{PROJ, NPROJ, (const float*)A.in[7] + (size_t)l * 6144, GATE_TILE0, ssq};
                pg8::gemm_phase<pg8::EpiProj, pg8::RangeOrder, true, true>(lds + RING_OFF, g, S, E);
                if (part == 0) xcd_barrier(bar);
            }
            if (bx >= rem) { const int mb = bx - rem, ms = G - rem;
                for (int u = mb; u < 512; u += ms) pool_unit(lds, PROJ, (const bf16*)(ws + WS_WPT) + (size_t)l * 4 * 192 * 192, Y + (size_t)NTOK * BRW, u);
                for (int it = mb; it < 512; it += ms) gla_pre_item(lds, PROJ, (const float*)A.in[11] + (size_t)l * 16 * 384, (const float*)A.in[12] + l * 384, ws + WS_GPRE, it); }
            xcd_barrier(bar);
            if (G > 96) { if (bx < 48) gla_scan_unit(lds, ws + WS_GPRE, GO, bx);
                          else for (int u = bx - 48; u < 256; u += G - 48) att_unit(lds, PROJ, COS, SIN, (const float*)A.in[8] + l * 12, Y, u); }
            else { for (int u = bx; u < 48; u += G) gla_scan_unit(lds, ws + WS_GPRE, GO, u);
                   for (int u = bx; u < 256; u += G) att_unit(lds, PROJ, COS, SIN, (const float*)A.in[8] + l * 12, Y, u); }
            conv_until(A, lds, l * TL_LAYER + TL_WI2, (G > 96 && bx >= 48) ? 2 : 0);
            xcd_barrier(bar);
            { int t_ = threadIdx.x; asm volatile("" : "+v"(t_)); gla_norm_phase(GO, PROJ, (const float*)A.in[13] + l * 768, Y + (size_t)2 * NTOK * BRW, bx * NWAVES + __builtin_amdgcn_readfirstlane(t_ >> 6), G * NWAVES, t_ & 63); }
            xcd_barrier(bar);
            { pg8::Gemm g{Y, (const bf16*)(wl + LW_WBR), NTOK, DM, BRW, (size_t)NTOK * BRW * 2, (size_t)DM * BRW * 2}; pg8::SegOrder S; S.init(NTOK, DM, G, bx); S.nseg = 3;
              pg8::EpiMergeSeg E{PROJ + C_GATE, NPROJ, DM, MB, DM};
              pg8::gemm_phase<pg8::EpiMergeSeg, pg8::SegOrder, true, true>(lds + RING_OFF, g, S, E); }
            xcd_barrier(bar);
        }
        { const bf16* Ap = (kind == 1) ? (const bf16*)MB : (const bf16*)ACT; const int Kd = (kind == 1) ? DM : DFF;
          const bf16* Bp = (const bf16*)(wl + (kind == 0 ? LW_WO1 : (kind == 1 ? LW_WOUT : LW_WO2)));
          pg8::Gemm g{Ap, Bp, NTOK, DM, Kd}; pg8::StaticOrder S; S.init(NTOK, DM, G, bx);
          pg8::EpiResid E{H, ssq_next, DM, kind == 1 ? 1.0f : 0.5f};
          pg8::gemm_phase<pg8::EpiResid, pg8::StaticOrder, true, true>(lds + RING_OFF, g, S, E); }
        conv_until(A, lds, l * TL_LAYER + (kind == 0 ? TL_BRA : (kind == 1 ? TL_WO2 : TL_LAYER + TL_WO1)), 0);
        xcd_barrier(bar);
    }
    { int t_ = threadIdx.x; asm volatile("" : "+v"(t_)); final_phase(H, (const unsigned long long*)(ws + WS_CTL + CTL_SSQ) + (size_t)12 * NTOK, (const float*)A.in[21], A.out, bx * NWAVES + __builtin_amdgcn_readfirstlane(t_ >> 6), G * NWAVES, t_ & 63); }
}

extern "C" void kernel_launch(void* const* d_in, const int* in_sizes, int n_in, void* d_out, int out_size, void* d_ws, size_t ws_size, hipStream_t stream) {
    static int grid = 0;
    if (grid == 0) {
        if (n_in != 22 || in_sizes[0] != NTOK * DM || out_size != NTOK * DM || ws_size < WS_END) {
            fprintf(stderr, "kernel_launch: unexpected shapes (n_in %d, in0 %d, out %d, ws %zu < %zu); nothing launched\n", n_in, n_in > 0 ? in_sizes[0] : -1, out_size, ws_size, (size_t)WS_END); grid = -1; return; }
        int dev = 0, cus = 0, per_cu = 0;
        if (hipGetDevice(&dev) != hipSuccess || hipDeviceGetAttribute(&cus, hipDeviceAttributeMultiprocessorCount, dev) != hipSuccess) { grid = -1; return; }
        if (hipFuncSetAttribute((const void*)mega_fwd, hipFuncAttributeMaxDynamicSharedMemorySize, LDS_BYTES) != hipSuccess) { fprintf(stderr, "kernel_launch: hipFuncSetAttribute failed\n"); grid = -1; return; }
        if (hipOccupancyMaxActiveBlocksPerMultiprocessor(&per_cu, (const void*)mega_fwd, NWAVES * 64, LDS_BYTES) != hipSuccess || per_cu < 1) { fprintf(stderr, "kernel_launch: occupancy query says %d\n", per_cu); (void)hipGetLastError(); grid = -1; return; }
        grid = cus;
    }
    if (grid < 0) return;
    if (hipMemsetAsync((char*)d_ws + WS_CTL, 0, CTL_ZERO_BYTES, stream) != hipSuccess) return;
    Args a{};
    for (int i = 0; i < 22; ++i) a.in[i] = d_in[i];
    a.out = (float*)d_out; a.ws = (unsigned char*)d_ws;
    hipLaunchKernelGGL(mega_fwd, dim3(grid), dim3(NWAVES * 64), LDS_BYTES, stream, a);
}
```

```cpp
#include <hip/hip_runtime.h>
#include <cstdio>
#include <cstdint>
#include <cmath>
namespace pg8 {
#define PG8_LAS __attribute__((address_space(3)))
typedef unsigned short bf16_t;
typedef short bf16x8 __attribute__((ext_vector_type(8)));
typedef float f32x4 __attribute__((ext_vector_type(4)));
typedef unsigned u32x4 __attribute__((ext_vector_type(4)));
constexpr int BM = 256, BK = 64, HALF = 128, HTB = HALF * BK * 2  , STAGE_BYTES = 8 * HTB, NXCD = 8, WGM = 8;

__host__ __device__ __forceinline__ int lds_byte(int r, int c) { const int st = (r >> 4) * 2 + (c >> 5), rr = r & 15, cc = c & 31, ob = rr * 64 + cc * 2; return st * 1024 + (ob ^ (((ob >> 9) & 1) << 5)); }
__host__ __device__ __forceinline__ void stage_rc(int b, int& R, int& C) { const int st = b / 1024, sb = b % 1024, swz = sb ^ (((sb >> 9) & 1) << 5); R = (st >> 1) * 16 + swz / 64; C = (st & 1) * 32 + (swz % 64) / 2; }
__host__ __device__ __forceinline__ int perm32(int rho) { const int n = rho >> 4, i = rho & 15; return 8 * (i >> 2) + 4 * n + (i & 3); }

__host__ __device__ __forceinline__ size_t blk_off(int r, int c, int C) { return ((size_t)(r >> 6) * (size_t)(C >> 6) + (size_t)(c >> 6)) * 4096 + (size_t)(r & 63) * 64 + (size_t)(c & 63); }
struct Unit { int pm, pn, seg; };
struct Gemm { const bf16_t* A; const bf16_t* Bt; int M, N, K; size_t segA = 0, segB = 0; };

struct StaticOrder {
    int nM, nN, nwg, G, c;
    __host__ __device__ void init(int M, int N, int G_, int c_) { nM = M / BM; nN = N / BM; nwg = nM * nN; G = G_; c = c_; }
    __host__ __device__ bool next(int i, Unit& u) const {
        const long L = (long)i * G + c; if (L >= nwg) return false;
        int wgid = (int)L; { const int q = nwg / NXCD, r = nwg % NXCD, xcd = wgid % NXCD, off = wgid / NXCD; wgid = (xcd < r ? xcd * (q + 1) : r * (q + 1) + (xcd - r) * q) + off; }
        const int nig = WGM * nN, gid = wgid / nig, fm = gid * WGM, gsz = (nM - fm) < WGM ? (nM - fm) : WGM;
        u.pm = fm + ((wgid % nig) % gsz); u.pn = (wgid % nig) / gsz; u.seg = 0; return true;
    }
    __device__ __forceinline__ void a_ready(const Unit&) const {}
    __device__ __forceinline__ void done(const Unit&) const {}
};
struct RangeOrder : StaticOrder { int i0, n;
    __host__ __device__ bool next(int i, Unit& u) const { if (i >= n) return false; return StaticOrder::next(i + i0, u); } };
struct SegOrder : StaticOrder { int nseg;
    __host__ __device__ bool next(int i, Unit& u) const { const int t = i / nseg; if (!StaticOrder::next(t, u)) return false; u.seg = i - t * nseg; return true; } };
__device__ __forceinline__ unsigned cvt_pk_bf16(float lo, float hi) { unsigned r; asm volatile("v_cvt_pk_bf16_f32 %0, %1, %2" : "=v"(r) : "v"(lo), "v"(hi)); return r; }
typedef float f32x2 __attribute__((ext_vector_type(2)));
__device__ __forceinline__ float bf_lo(unsigned w) { return __uint_as_float(w << 16); }
__device__ __forceinline__ float bf_hi(unsigned w) { return __uint_as_float(w & 0xffff0000u); }
__device__ __forceinline__ float sigmoid_f(float v) { return __builtin_amdgcn_rcpf(1.0f + __builtin_amdgcn_exp2f(v * -1.4426950408889634f)); }
__device__ __forceinline__ float rstd_of(unsigned long long q) {
    const float f = (float)(unsigned)(q >> 32) * 4294967296.0f + (float)(unsigned)q; return __builtin_amdgcn_rsqf(f * (1.0f / 1048576.0f / 2048.0f) + 1e-6f); }
#define PG8_LOAD_RSTD(rs, ssq, row0) float rs[2][4]; { unsigned long long q_[2][4]; _Pragma("unroll") for (int ai = 0; ai < 2; ++ai) _Pragma("unroll") for (int m = 0; m < 4; ++m) q_[ai][m] = (ssq)[(row0) + ai * HALF + m * 16]; \
    _Pragma("unroll") for (int ai = 0; ai < 2; ++ai) _Pragma("unroll") for (int m = 0; m < 4; ++m) rs[ai][m] = rstd_of(q_[ai][m]); }
struct EpiSwiglu {
    static constexpr bool PERM = true, AFTER_DRAIN = false, SEGMENTED = false;
    bf16_t* O; int ldo; const unsigned long long* ssq;
    __device__ __forceinline__ void operator()(const f32x4 (&acc)[2][2][4][2], const Unit& u, int wr, int wc, int fr, int fq) const {
        const int row0 = u.pm * BM + wr * 64 + fr, hid0 = u.pn * HALF + wc * 32 + 8 * fq;
        PG8_LOAD_RSTD(rsv, ssq, row0)
#pragma unroll
        for (int ai = 0; ai < 2; ++ai)
#pragma unroll
            for (int m = 0; m < 4; ++m) { const int row = row0 + ai * HALF + m * 16; bf16_t* rowp = O + blk_off(row, hid0, ldo);
                const float rs = rsv[ai][m];
                f32x4 v0, v1;
#pragma unroll
                for (int j = 0; j < 4; ++j) { const float a0 = acc[ai][0][m][0][j] * rs, a1 = acc[ai][0][m][1][j] * rs;
                    v0[j] = a0 * sigmoid_f(a0) * (acc[ai][1][m][0][j] * rs); v1[j] = a1 * sigmoid_f(a1) * (acc[ai][1][m][1][j] * rs); }
                u32x4 w; w.x = cvt_pk_bf16(v0[0], v0[1]); w.y = cvt_pk_bf16(v0[2], v0[3]); w.z = cvt_pk_bf16(v1[0], v1[1]); w.w = cvt_pk_bf16(v1[2], v1[3]);
                *(u32x4*)rowp = w; }
    }
};
struct EpiResid {
    static constexpr bool PERM = true, AFTER_DRAIN = false, SEGMENTED = false;
    bf16_t* xb; unsigned long long* ssq_next; int ldc; float scale;
    __device__ __forceinline__ void operator()(const f32x4 (&acc)[2][2][4][2], const Unit& u, int wr, int wc, int fr, int fq) const {
        const int row0 = u.pm * BM + wr * 64 + fr, col0 = u.pn * BM + wc * 32 + 8 * fq;
#pragma unroll
        for (int ai = 0; ai < 2; ++ai) {
            u32x4 t[4][2];
#pragma unroll
            for (int m = 0; m < 4; ++m)
#pragma unroll
                for (int bj = 0; bj < 2; ++bj) t[m][bj] = *(const u32x4*)(xb + blk_off(row0 + ai * HALF + m * 16, col0 + bj * HALF, ldc));
#pragma unroll
            for (int m = 0; m < 4; ++m) { const int row = row0 + ai * HALF + m * 16; float ss = 0.f;
#pragma unroll
                for (int bj = 0; bj < 2; ++bj) { const u32x4 x = t[m][bj];
                    f32x4 v0 = (f32x4){bf_lo(x.x), bf_hi(x.x), bf_lo(x.y), bf_hi(x.y)} + acc[ai][bj][m][0] * scale, v1 = (f32x4){bf_lo(x.z), bf_hi(x.z), bf_lo(x.w), bf_hi(x.w)} + acc[ai][bj][m][1] * scale;
                    u32x4 w; w.x = cvt_pk_bf16(v0[0], v0[1]); w.y = cvt_pk_bf16(v0[2], v0[3]); w.z = cvt_pk_bf16(v1[0], v1[1]); w.w = cvt_pk_bf16(v1[2], v1[3]);
                    *(u32x4*)(xb + blk_off(row, col0 + bj * HALF, ldc)) = w;
                    ss += (v0[0] * v0[0] + v0[1] * v0[1]) + (v0[2] * v0[2] + v0[3] * v0[3]) + (v1[0] * v1[0] + v1[1] * v1[1]) + (v1[2] * v1[2] + v1[3] * v1[3]); }
                ss += __shfl_xor(ss, 16); ss += __shfl_xor(ss, 32);
                if (fq == 0) atomicAdd(ssq_next + row, (unsigned long long)(ss * 1048576.0f + 0.5f)); } }
    }
};
struct EpiProj {
    static constexpr bool PERM = true, AFTER_DRAIN = false, SEGMENTED = false;
    bf16_t* O; int ldo; const float* bias; int gate_tile0; const unsigned long long* ssq;
    __device__ __forceinline__ void operator()(const f32x4 (&acc)[2][2][4][2], const Unit& u, int wr, int wc, int fr, int fq) const {
        const int row0 = u.pm * BM + wr * 64 + fr, col0 = u.pn * BM + wc * 32 + 8 * fq;
        const bool gate = u.pn >= gate_tile0;
        PG8_LOAD_RSTD(rsv, ssq, row0)
        f32x4 bv[2][2];
#pragma unroll
        for (int bj = 0; bj < 2; ++bj)
#pragma unroll
            for (int n = 0; n < 2; ++n) bv[bj][n] = gate ? *(const f32x4*)(bias + (col0 - gate_tile0 * BM) + bj * HALF + 4 * n) : (f32x4){0.f, 0.f, 0.f, 0.f};
#pragma unroll
        for (int ai = 0; ai < 2; ++ai)
#pragma unroll
            for (int m = 0; m < 4; ++m) { const int row = row0 + ai * HALF + m * 16; bf16_t* rowp = O + (size_t)row * ldo + col0;
                const float rs = rsv[ai][m];
#pragma unroll
                for (int bj = 0; bj < 2; ++bj) { f32x4 v0 = acc[ai][bj][m][0] * rs + bv[bj][0], v1 = acc[ai][bj][m][1] * rs + bv[bj][1];
                    if (gate) {
#pragma unroll
                        for (int j = 0; j < 4; ++j) { v0[j] = sigmoid_f(v0[j]); v1[j] = sigmoid_f(v1[j]); } }
                    u32x4 w; w.x = cvt_pk_bf16(v0[0], v0[1]); w.y = cvt_pk_bf16(v0[2], v0[3]); w.z = cvt_pk_bf16(v1[0], v1[1]); w.w = cvt_pk_bf16(v1[2], v1[3]);
                    *(u32x4*)(rowp + bj * HALF) = w; } }
    }
};
struct EpiMergeSeg {
    static constexpr bool PERM = true, AFTER_DRAIN = false, SEGMENTED = true;
    const bf16_t* gate; int ldg; int gseg; bf16_t* outb; int ldc;
    __device__ __forceinline__ bool run(f32x4 (&acc)[2][2][4][2], const Unit& u, int wr, int wc, int fr, int fq) const {
        const int row0 = u.pm * BM + wr * 64 + fr, col0 = u.pn * BM + wc * 32 + 8 * fq;
        const bf16_t* gs = gate + (size_t)u.seg * gseg; const bool last = u.seg == 2;
#pragma unroll
        for (int ai = 0; ai < 2; ++ai) {
            u32x4 ga[4][2], gb[4][2];
#pragma unroll
            for (int m = 0; m < 4; ++m)
#pragma unroll
                for (int bj = 0; bj < 2; ++bj) { const size_t p = (size_t)(row0 + ai * HALF + m * 16) * ldg + col0 + bj * HALF;
                    ga[m][bj] = *(const u32x4*)(gs + p); gb[m][bj] = last ? ga[m][bj] : *(const u32x4*)(gs + gseg + p); }
#pragma unroll
            for (int m = 0; m < 4; ++m)
#pragma unroll
                for (int bj = 0; bj < 2; ++bj) { const u32x4 a = ga[m][bj], b = gb[m][bj];
                    float f[8] = {bf_lo(a.x), bf_hi(a.x), bf_lo(a.y), bf_hi(a.y), bf_lo(a.z), bf_hi(a.z), bf_lo(a.w), bf_hi(a.w)};
                    if (!last) { const float d[8] = {bf_lo(b.x), bf_hi(b.x), bf_lo(b.y), bf_hi(b.y), bf_lo(b.z), bf_hi(b.z), bf_lo(b.w), bf_hi(b.w)};
#pragma unroll
                        for (int j = 0; j < 8; ++j) f[j] *= __builtin_amdgcn_rcpf(fmaxf(d[j], 1e-20f)); }
                    f32x4 v0 = acc[ai][bj][m][0], v1 = acc[ai][bj][m][1];
                    v0[0] *= f[0]; v0[1] *= f[1]; v0[2] *= f[2]; v0[3] *= f[3]; v1[0] *= f[4]; v1[1] *= f[5]; v1[2] *= f[6]; v1[3] *= f[7];
                    acc[ai][bj][m][0] = v0; acc[ai][bj][m][1] = v1;
                    if (last) { u32x4 w; w.x = cvt_pk_bf16(v0[0], v0[1]); w.y = cvt_pk_bf16(v0[2], v0[3]); w.z = cvt_pk_bf16(v1[0], v1[1]); w.w = cvt_pk_bf16(v1[2], v1[3]);
                        *(u32x4*)(outb + blk_off(row0 + ai * HALF + m * 16, col0 + bj * HALF, ldc)) = w; } } }
        return last;
    }
};

template <class Epi, class Sched, bool ALIGN_EPI = false, bool SP2 = false>
__device__ __forceinline__ void gemm_phase(PG8_LAS unsigned char* lds, const Gemm g, const Sched& S, const Epi& E) {
    int tid_o = threadIdx.x; asm volatile("" : "+v"(tid_o));
    const int tid = tid_o, wid = __builtin_amdgcn_readfirstlane(tid >> 6), lane = tid & 63, wr = wid >> 2, wc = wid & 3, fr = lane & 15, fq = lane >> 4;
    const int K = g.K, nt = K / BK;
    unsigned voffA[2], voffB[2];
#pragma unroll
    for (int i = 0; i < 2; ++i) { int R, C; stage_rc(tid * 16 + i * 8192, R, C); const int Rb = Epi::PERM ? ((R & ~31) + perm32(R & 31)) : R;
        voffA[i] = (unsigned)((R >> 6) * (K >> 6) * 4096 + (R & 63) * 64 + C) * 2u; voffB[i] = (unsigned)((Rb >> 6) * (K >> 6) * 4096 + (Rb & 63) * 64 + C) * 2u; }
    const size_t kstep = (size_t)8192;
    const size_t hstep = (size_t)2 * (K >> 6) * 8192;
    const size_t tstep = 2 * hstep;
    const unsigned ldsw = (unsigned)wid * 1024u;
    const int aoff = lds_byte(wr * 64 + fr, fq * 8), boff = lds_byte(wc * 32 + fr, fq * 8);
#define PG8_SA(b, h) (((b) * 2 + (h)) * HTB)
#define PG8_SB(b, h) ((4 + (b) * 2 + (h)) * HTB)
#define PG8_STAGE(bufoff, gbase, voff) do { _Pragma("unroll") for (int _i = 0; _i < 2; ++_i) \
        __builtin_amdgcn_global_load_lds((const unsigned*)((const char*)(gbase) + (voff)[_i]), (PG8_LAS unsigned*)(lds + (bufoff) + ldsw + _i * 8192), 16, 0, 0); } while (0)
#define PG8_LDA(dst, b, h) do { _Pragma("unroll") for (int m = 0; m < 4; ++m) _Pragma("unroll") for (int k = 0; k < 2; ++k) dst[m][k] = *(const PG8_LAS bf16x8*)(lds + PG8_SA(b, h) + aoff + m * 2048 + k * 1024); } while (0)
#define PG8_LDB(dst, b, h) do { _Pragma("unroll") for (int n = 0; n < 2; ++n) _Pragma("unroll") for (int k = 0; k < 2; ++k) dst[n][k] = *(const PG8_LAS bf16x8*)(lds + PG8_SB(b, h) + boff + n * 2048 + k * 1024); } while (0)
#define PG8_MMA(ai, bj, At, Bt) do { __builtin_amdgcn_s_setprio(1); _Pragma("unroll") for (int m = 0; m < 4; ++m) _Pragma("unroll") for (int n = 0; n < 2; ++n) _Pragma("unroll") for (int k = 0; k < 2; ++k) \
        acc[ai][bj][m][n] = __builtin_amdgcn_mfma_f32_16x16x32_bf16(Bt[n][k], At[m][k], acc[ai][bj][m][n], 0, 0, 0); __builtin_amdgcn_s_setprio(0); } while (0)
#define PG8_WAIT_V(n) asm volatile("s_waitcnt vmcnt(" #n ")" ::: "memory")
#define PG8_WAIT_L(n) asm volatile("s_waitcnt lgkmcnt(" #n ")" ::: "memory")
#define PG8_BAR __builtin_amdgcn_s_barrier()
#define PG8_SCHED __builtin_amdgcn_sched_barrier(0)
    Unit cur, nxt; int ui = 0;
    if (!S.next(0, cur)) return;
    f32x4 acc[2][2][4][2];
#pragma unroll
    for (int a = 0; a < 2; ++a)
#pragma unroll
        for (int b = 0; b < 2; ++b)
#pragma unroll
            for (int m = 0; m < 4; ++m)
#pragma unroll
                for (int n = 0; n < 2; ++n) acc[a][b][m][n] = (f32x4){0.f, 0.f, 0.f, 0.f};
    bf16x8 At[4][2], B0[2][2], B1[2][2];
    const char* cA = (const char*)g.A + (size_t)cur.pm * tstep + (size_t)cur.seg * g.segA; const char* cB = (const char*)g.Bt + (size_t)cur.pn * tstep + (size_t)cur.seg * g.segB;
    S.a_ready(cur);
    if constexpr (SP2) {
        PG8_STAGE(PG8_SB(0, 0), cB, voffB); PG8_STAGE(PG8_SB(0, 1), cB + hstep, voffB); PG8_STAGE(PG8_SA(0, 0), cA, voffA); PG8_STAGE(PG8_SA(0, 1), cA + hstep, voffA);
        if (wr == 1) PG8_BAR;
        PG8_WAIT_V(2); PG8_BAR;
        PG8_STAGE(PG8_SB(1, 0), cB + kstep, voffB); PG8_STAGE(PG8_SA(1, 0), cA + kstep, voffA); PG8_STAGE(PG8_SB(1, 1), cB + hstep + kstep, voffB);
        PG8_WAIT_V(6); PG8_BAR;
    } else {
        PG8_STAGE(PG8_SB(0, 0), cB, voffB); PG8_STAGE(PG8_SA(0, 0), cA, voffA); PG8_STAGE(PG8_SB(0, 1), cB + hstep, voffB); PG8_STAGE(PG8_SA(0, 1), cA + hstep, voffA);
        if (wr == 1) PG8_BAR;
        PG8_WAIT_V(4); PG8_BAR;
        PG8_STAGE(PG8_SB(1, 0), cB + kstep, voffB); PG8_STAGE(PG8_SA(1, 0), cA + kstep, voffA); PG8_STAGE(PG8_SB(1, 1), cB + hstep + kstep, voffB);
        PG8_WAIT_V(6); PG8_BAR;
    }
    for (;;) {
        const bool has_next = S.next(ui + 1, nxt);
        const char* nA = has_next ? (const char*)g.A + (size_t)nxt.pm * tstep + (size_t)nxt.seg * g.segA : cA; const char* nB = has_next ? (const char*)g.Bt + (size_t)nxt.pn * tstep + (size_t)nxt.seg * g.segB : cB;
        for (int t = 0; t < nt; t += 2) {
            const bool last = (t == nt - 2);
            const char* a1 = cA + (size_t)(t + 1) * kstep;
            const char* a2 = last ? nA : cA + (size_t)(t + 2) * kstep; const char* b2 = last ? nB : cB + (size_t)(t + 2) * kstep;
            const char* a3 = a2 + kstep; const char* b3 = b2 + kstep;
            if (last && has_next) S.a_ready(nxt);
            if constexpr (SP2) {
            PG8_LDB(B0, 0, 0); PG8_LDB(B1, 0, 1); PG8_SCHED; PG8_LDA(At, 0, 0); PG8_STAGE(PG8_SA(1, 1), a1 + hstep, voffA);
            PG8_WAIT_V(8); PG8_WAIT_L(0); PG8_BAR; PG8_MMA(0, 0, At, B0); PG8_MMA(0, 1, At, B1); PG8_BAR; PG8_SCHED;
            PG8_LDA(At, 0, 1); PG8_STAGE(PG8_SB(0, 0), b2, voffB); PG8_STAGE(PG8_SB(0, 1), b2 + hstep, voffB); PG8_STAGE(PG8_SA(0, 0), a2, voffA);
            PG8_WAIT_V(8); PG8_WAIT_L(0); PG8_BAR; PG8_MMA(1, 0, At, B0); PG8_MMA(1, 1, At, B1); PG8_BAR; PG8_SCHED;
            PG8_LDB(B0, 1, 0); PG8_LDB(B1, 1, 1); PG8_SCHED; PG8_LDA(At, 1, 0); PG8_STAGE(PG8_SA(0, 1), a2 + hstep, voffA);
            PG8_WAIT_V(8); PG8_WAIT_L(0); PG8_BAR; PG8_MMA(0, 0, At, B0); PG8_MMA(0, 1, At, B1); PG8_BAR; PG8_SCHED;
            PG8_LDA(At, 1, 1); PG8_STAGE(PG8_SB(1, 0), b3, voffB); PG8_STAGE(PG8_SB(1, 1), b3 + hstep, voffB); PG8_STAGE(PG8_SA(1, 0), a3, voffA);
            PG8_WAIT_V(8); PG8_WAIT_L(0); PG8_BAR; PG8_MMA(1, 0, At, B0); PG8_MMA(1, 1, At, B1); PG8_BAR; PG8_SCHED;
            } else {
            PG8_LDB(B0, 0, 0); PG8_SCHED; PG8_LDA(At, 0, 0); PG8_STAGE(PG8_SA(1, 1), a1 + hstep, voffA);
            PG8_WAIT_L(8); PG8_BAR; PG8_WAIT_L(0); PG8_MMA(0, 0, At, B0); PG8_BAR; PG8_SCHED;
            PG8_LDB(B1, 0, 1); PG8_STAGE(PG8_SB(0, 0), b2, voffB);
            PG8_BAR; PG8_WAIT_L(0); PG8_MMA(0, 1, At, B1); PG8_BAR;
            PG8_LDA(At, 0, 1); PG8_STAGE(PG8_SA(0, 0), a2, voffA);
            PG8_BAR; PG8_WAIT_L(0); PG8_MMA(1, 0, At, B0); PG8_BAR; PG8_SCHED;
            PG8_STAGE(PG8_SB(0, 1), b2 + hstep, voffB);
            PG8_WAIT_V(6); PG8_BAR; PG8_MMA(1, 1, At, B1); PG8_BAR;
            PG8_LDB(B0, 1, 0); PG8_SCHED; PG8_LDA(At, 1, 0); PG8_STAGE(PG8_SA(0, 1), a2 + hstep, voffA);
            PG8_WAIT_L(8); PG8_BAR; PG8_WAIT_L(0); PG8_MMA(0, 0, At, B0); PG8_BAR; PG8_SCHED;
            PG8_LDB(B1, 1, 1); PG8_STAGE(PG8_SB(1, 0), b3, voffB);
            PG8_BAR; PG8_WAIT_L(0); PG8_MMA(0, 1, At, B1); PG8_BAR;
            PG8_LDA(At, 1, 1); PG8_STAGE(PG8_SA(1, 0), a3, voffA);
            PG8_BAR; PG8_WAIT_L(0); PG8_MMA(1, 0, At, B0); PG8_BAR; PG8_SCHED;
            PG8_STAGE(PG8_SB(1, 1), b3 + hstep, voffB);
            PG8_WAIT_V(6); PG8_BAR; PG8_MMA(1, 1, At, B1); PG8_BAR;
            }
        }
        if constexpr (ALIGN_EPI) { if (wr == 0) PG8_BAR; }
        bool zero_acc = true;
        if constexpr (Epi::SEGMENTED) { zero_acc = E.run(acc, cur, wr, wc, fr, fq); S.done(cur); }
        else if constexpr (!Epi::AFTER_DRAIN) { E(acc, cur, wr, wc, fr, fq); S.done(cur); }
        if (!has_next) break;
        if (zero_acc) {
#pragma unroll
        for (int a = 0; a < 2; ++a)
#pragma unroll
            for (int b = 0; b < 2; ++b)
#pragma unroll
                for (int m = 0; m < 4; ++m)
#pragma unroll
                    for (int n = 0; n < 2; ++n) acc[a][b][m][n] = (f32x4){0.f, 0.f, 0.f, 0.f};
        }
        cur = nxt; cA = nA; cB = nB; ++ui;
        if constexpr (ALIGN_EPI) { if (wr == 1) PG8_BAR; }
    }
    PG8_WAIT_V(0);
    if constexpr (!ALIGN_EPI) { if (wr == 0) PG8_BAR; }
    PG8_BAR;
    if constexpr (Epi::AFTER_DRAIN) { E.fused(acc, cur, wr, wc, fr, fq, lds, wid, lane); S.done(cur); }
#undef PG8_SA
#undef PG8_SB
#undef PG8_STAGE
#undef PG8_LDA
#undef PG8_LDB
#undef PG8_MMA
#undef PG8_WAIT_V
#undef PG8_WAIT_L
#undef PG8_BAR
#undef PG8_SCHED
}
}

constexpr int NWAVES = 8;
constexpr int NB = 4, SEQ = 2048, NTOK = NB * SEQ, DM = 2048, DEPTH = 4;
constexpr int DFF = 5632, NWI = 2 * DFF;
constexpr int NPROJ_SRC = 10512, NPROJ = 10752;
constexpr int C_QA = 0, C_KA = 768, C_VA = 1024, C_PU = 1280, C_QG = 2048, C_KG = 2432, C_VG = 2816, C_OG = 3584, C_LR = 4352, C_GATE = 4608;
constexpr int GATE_TILE0 = C_GATE / 256;
constexpr int BRW = 768;
constexpr float EPS = 1e-6f;

constexpr size_t MiB = 1u << 20;
constexpr size_t WS_CTL = 0, CTL_ZERO_BYTES = 1 * MiB;
constexpr size_t SZ_WI = (size_t)NWI * DM * 2, SZ_WO = (size_t)DM * DFF * 2, SZ_WIN = (size_t)NPROJ * DM * 2, SZ_WBR = (size_t)3 * DM * BRW * 2, SZ_WOUT = (size_t)DM * DM * 2;
constexpr size_t LW_WI1 = 0, LW_WO1 = LW_WI1 + SZ_WI, LW_WIN = LW_WO1 + SZ_WO, LW_WBR = LW_WIN + SZ_WIN, LW_WOUT = LW_WBR + SZ_WBR, LW_WI2 = LW_WOUT + SZ_WOUT, LW_WO2 = LW_WI2 + SZ_WI, LW_END = LW_WO2 + SZ_WO;
constexpr size_t WS_W = 2 * MiB;
constexpr size_t WS_X = ((WS_W + DEPTH * LW_END + MiB - 1) / MiB) * MiB;
constexpr size_t WS_H = WS_X + (size_t)NTOK * DM * 4;
constexpr size_t WS_ACT = WS_H + (size_t)NTOK * DM * 2;
constexpr size_t WS_PROJ = WS_ACT + (size_t)NTOK * DFF * 2;
constexpr size_t WS_Y = WS_PROJ + (size_t)NTOK * NPROJ * 2;
constexpr size_t WS_MACC = WS_Y + (size_t)3 * NTOK * BRW * 2;
constexpr size_t WS_MB = WS_MACC + (size_t)NTOK * DM * 4;
constexpr size_t WS_GO = WS_MB + (size_t)NTOK * DM * 2;
constexpr size_t WS_ROPE = WS_GO + (size_t)NTOK * BRW * 4;
constexpr size_t WS_GPRE = WS_ROPE + (size_t)2 * NTOK * 32 * 4;
constexpr size_t WS_WPT = WS_GPRE + (size_t)512 * 57856;
constexpr size_t WS_END = WS_WPT + (size_t)DEPTH * 4 * 192 * 192 * 2;
constexpr int CW_BAR = 4096;
constexpr size_t CTL_SSQ = 65536; static_assert(CTL_SSQ + (size_t)13 * 8192 * 8 <= CTL_ZERO_BYTES, "SSQ inside the zeroed CTL region");

constexpr int RING_OFF = 0, RING_BYTES = 131072;
constexpr int LDSCTL_OFF = RING_BYTES, MISC_OFF = LDSCTL_OFF + 320;
constexpr int LDS_BYTES = 147456;

#define GAS __attribute__((address_space(1)))
#define LAS __attribute__((address_space(3)))
typedef unsigned short bf16;
typedef unsigned v4u __attribute__((ext_vector_type(4)));
typedef float f32x4 __attribute__((ext_vector_type(4)));
#define LDS_WAIT() asm volatile("s_waitcnt lgkmcnt(0)" ::: "memory")
__device__ __forceinline__ unsigned f2bf(float f) { unsigned u = __builtin_bit_cast(unsigned, f); return (u + 0x7fffu + ((u >> 16) & 1u)) >> 16; }
__device__ __forceinline__ unsigned pk2(float lo, float hi) { return f2bf(lo) | (f2bf(hi) << 16); }
__device__ __forceinline__ float bf2f(bf16 b) { return __uint_as_float(((unsigned)b) << 16); }
__device__ __forceinline__ float bflo(unsigned w) { return __uint_as_float(w << 16); }
__device__ __forceinline__ float bfhi(unsigned w) { return __uint_as_float(w & 0xffff0000u); }
__device__ __forceinline__ float wave_sum(float v) {
#pragma unroll
    for (int o = 1; o < 64; o <<= 1) v += __shfl_xor(v, o);
    return v;
}

#define XB_TMO      128
#define XB_XCNT(j)  (256  + 64 * (j))
#define XB_XSUB(j)  (1280 + 64 * (j))
#define XB_XGEN(j)  (2304 + 64 * (j))
#define XB_TOP      3328
#define XB_TOPGEN   3392
#define XCD_BAR_WORDS 3456
#define XB_SPIN_CAP (1u << 18)

__device__ __forceinline__ unsigned xb_ld(unsigned* p)              { return __hip_atomic_load(p, __ATOMIC_RELAXED, __HIP_MEMORY_SCOPE_AGENT); }
__device__ __forceinline__ unsigned xb_add(unsigned* p, unsigned v) { return __hip_atomic_fetch_add(p, v, __ATOMIC_RELAXED, __HIP_MEMORY_SCOPE_AGENT); }
__device__ __forceinline__ unsigned xb_xcc_id() { return (unsigned)__builtin_amdgcn_s_getreg((3 << 11) | 20) & 0xFu; }
#define XB_SPIN(cond, bar) do { unsigned _sp = 0; while (cond) { __builtin_amdgcn_s_sleep(1); \
    if ((++_sp & 255u) == 0u) { if (xb_ld(&(bar)[XB_TMO])) break; if (_sp > XB_SPIN_CAP) { atomicAdd(&(bar)[XB_TMO], 1u); break; } } } } while (0)

struct XcdBarrier {
    unsigned* bar; unsigned x;
    volatile LAS unsigned* st;
};

__device__ __forceinline__ XcdBarrier xcd_barrier_post(unsigned* bar, volatile LAS unsigned* st) {
    XcdBarrier b; b.bar = bar; b.x = xb_xcc_id(); b.st = st;
    if (threadIdx.x == 0) (void)xb_add(&bar[XB_XCNT(b.x)], 1u);
    return b;
}
__device__ __forceinline__ void xcd_barrier_complete(unsigned* bar, unsigned x, unsigned& nloc, unsigned& nx) {
    const unsigned G = gridDim.x * gridDim.y * gridDim.z;
    unsigned sum, cnt, mine, sp = 0u;
    for (;;) {
        sum = 0u; cnt = 0u; mine = 0u;
#pragma unroll
        for (unsigned j = 0; j < 16; ++j) { const unsigned c = xb_ld(&bar[XB_XCNT(j)]); sum += c; cnt += (c > 0u) ? 1u : 0u; mine = (j == x) ? c : mine; }
        if (sum == G) break;
        __builtin_amdgcn_s_sleep(1);
        if ((++sp & 255u) == 0u) { if (xb_ld(&bar[XB_TMO])) break; if (sp > XB_SPIN_CAP) { atomicAdd(&bar[XB_TMO], 1u); break; } }
    }
    nloc = mine > 0u ? mine : 1u; nx = cnt > 0u ? cnt : 1u;
}

__device__ __forceinline__ void xcd_barrier(const XcdBarrier& b) {
    asm volatile("s_waitcnt vmcnt(0)" ::: "memory");
    __syncthreads();
    if (threadIdx.x == 0) {
        unsigned* bar = b.bar; const unsigned bx_ = xb_xcc_id();
        __builtin_amdgcn_s_waitcnt(0);
        unsigned nloc = b.st[0], nx = b.st[1];
        if (nloc == 0u) { xcd_barrier_complete(bar, bx_, nloc, nx); b.st[0] = nloc; b.st[1] = nx; }
        const unsigned old = xb_add(&bar[XB_XSUB(bx_)], 1u);
        const unsigned gen = old / nloc;
        if (old + 1u == (gen + 1u) * nloc) {
            __builtin_amdgcn_fence(__ATOMIC_RELEASE, "agent");
            asm volatile("s_waitcnt vmcnt(0)" ::: "memory");
            const unsigned og = xb_add(&bar[XB_TOP], 1u);
            const unsigned tg = og / nx;
            if (og + 1u == (tg + 1u) * nx) xb_add(&bar[XB_TOPGEN], 1u);
            else XB_SPIN(xb_ld(&bar[XB_TOPGEN]) == tg, bar);
            __builtin_amdgcn_fence(__ATOMIC_ACQUIRE, "agent");
            xb_add(&bar[XB_XGEN(bx_)], 1u);
            asm volatile("s_waitcnt vmcnt(0)" ::: "memory");
        } else {
            XB_SPIN(xb_ld(&bar[XB_XGEN(bx_)]) == gen, bar);
            __builtin_amdgcn_fence(__ATOMIC_ACQUIRE, "agent");
            asm volatile("s_waitcnt vmcnt(0)" ::: "memory");
        }
    }
    __syncthreads();
}


template <int MAP> __device__ __forceinline__ int map_row(int n) {
    if (MAP == 1) { const int isb = n >= DFF ? 1 : 0; const int h = n - isb * DFF; return (h >> 7) * 256 + isb * 128 + (h & 127); }
    if (MAP == 2) return n < 4368 ? n : n + 240;
    return n;
}
struct TrJob { const float* W; bf16* WT; const float* gain; int K, N, map; };
__device__ __forceinline__ int map_row_rt(int map, int n) { return map == 1 ? map_row<1>(n) : (map == 2 ? map_row<2>(n) : n); }
__device__ __forceinline__ void tr_load(const TrJob& jb, int tile, int tid, f32x4 (&v)[8][2], int& k0, int& n0) {
    const int nblk = (jb.N + 127) / 128, kt = tile / nblk, nt = tile - kt * nblk; k0 = 256 * kt; n0 = 128 * nt;
    const int c4 = (tid & 15) + 16 * ((tid >> 6) & 1), rp = ((tid >> 4) & 3) + 4 * (tid >> 7);
    int col = n0 + 4 * c4; col = col < jb.N - 4 ? col : jb.N - 4;
    const float* wp = jb.W + (size_t)(k0 + 2 * rp) * jb.N + col;
#pragma unroll
    for (int i = 0; i < 8; ++i) { v[i][0] = *(const f32x4*)(wp + (size_t)(32 * i) * jb.N); v[i][1] = *(const f32x4*)(wp + (size_t)(32 * i + 1) * jb.N); }
    if (jb.gain) {
#pragma unroll
        for (int i = 0; i < 8; ++i) { const float ga = jb.gain[k0 + 32 * i + 2 * rp], gb = jb.gain[k0 + 32 * i + 2 * rp + 1]; v[i][0] = v[i][0] * ga; v[i][1] = v[i][1] * gb; } }
}
__device__ __forceinline__ void tr_to_lds(LAS unsigned* T, int tid, const f32x4 (&v)[8][2]) {
    const int c4 = (tid & 15) + 16 * ((tid >> 6) & 1), rp = ((tid >> 4) & 3) + 4 * (tid >> 7);
#pragma unroll
    for (int i = 0; i < 8; ++i)
#pragma unroll
        for (int j = 0; j < 4; ++j) T[(4 * c4 + j) * 132 + 16 * i + rp] = pk2(v[i][0][j], v[i][1][j]);
}
__device__ __forceinline__ void tr_store(const TrJob& jb, const LAS unsigned* T, int tid, int k0, int n0) {
    const int w = tid >> 6, lane = tid & 63, c = 8 * (w >> 1) + (lane & 7), nb = 64 * (w & 1) + (lane >> 3);
#pragma unroll
    for (int j = 0; j < 8; ++j) { const int n = nb + 8 * j; const v4u o = *(const LAS v4u*)(T + n * 132 + 4 * c);
        if (n0 + n < jb.N) *(v4u*)(jb.WT + pg8::blk_off(map_row_rt(jb.map, n0 + n), k0 + 8 * c, jb.K)) = o; }
}

struct Args { const void* in[22]; float* out; unsigned char* ws; };

constexpr int TL_WI1 = 0, TL_WO1 = 704, TL_WIN = 1056, TL_BRA = 1720, TL_BRP = 1768, TL_BRG = 1816, TL_WOUT = 1864, TL_WI2 = 1992, TL_WO2 = 2696, TL_LAYER = 3048, TL_ALL = DEPTH * TL_LAYER;
constexpr int CW_CLAIM = 8192;
__device__ __forceinline__ void conv_job(const Args& A, int T, TrJob& jb, int& t) {
    const int l = T / TL_LAYER, r = T - l * TL_LAYER;
    unsigned char* wl = A.ws + WS_W + (size_t)l * LW_END;
    if (r < TL_WO1)       { jb = TrJob{(const float*)A.in[3] + (size_t)l * DM * NWI, (bf16*)(wl + LW_WI1), (const float*)A.in[2] + (size_t)l * DM, DM, NWI, 1}; t = r; }
    else if (r < TL_WIN)  { jb = TrJob{(const float*)A.in[4] + (size_t)l * DFF * DM, (bf16*)(wl + LW_WO1), nullptr, DFF, DM, 0}; t = r - TL_WO1; }
    else if (r < TL_BRA)  { jb = TrJob{(const float*)A.in[6] + (size_t)l * DM * NPROJ_SRC, (bf16*)(wl + LW_WIN), (const float*)A.in[5] + (size_t)l * DM, DM, NPROJ_SRC, 2}; t = r - TL_WIN; }
    else if (r < TL_BRP)  { jb = TrJob{(const float*)A.in[14] + (size_t)l * BRW * DM, (bf16*)(wl + LW_WBR), nullptr, BRW, DM, 0}; t = r - TL_BRA; }
    else if (r < TL_BRG)  { jb = TrJob{(const float*)A.in[15] + (size_t)l * BRW * DM, (bf16*)(wl + LW_WBR) + (size_t)DM * BRW, nullptr, BRW, DM, 0}; t = r - TL_BRP; }
    else if (r < TL_WOUT) { jb = TrJob{(const float*)A.in[16] + (size_t)l * BRW * DM, (bf16*)(wl + LW_WBR) + (size_t)2 * DM * BRW, nullptr, BRW, DM, 0}; t = r - TL_BRG; }
    else if (r < TL_WI2)  { jb = TrJob{(const float*)A.in[17] + (size_t)l * DM * DM, (bf16*)(wl + LW_WOUT), nullptr, DM, DM, 0}; t = r - TL_WOUT; }
    else if (r < TL_WO2)  { jb = TrJob{(const float*)A.in[19] + (size_t)l * DM * NWI, (bf16*)(wl + LW_WI2), (const float*)A.in[18] + (size_t)l * DM, DM, NWI, 1}; t = r - TL_WI2; }
    else                  { jb = TrJob{(const float*)A.in[20] + (size_t)l * DFF * DM, (bf16*)(wl + LW_WO2), nullptr, DFF, DM, 0}; t = r - TL_WO2; }
}
__device__ __forceinline__ void conv_claim(unsigned* ctr, volatile LAS unsigned* slot, int limit, int extra) {
    unsigned T = 0xffffffffu; const unsigned cur = __hip_atomic_load(ctr, __ATOMIC_RELAXED, __HIP_MEMORY_SCOPE_AGENT);
    const bool need = (int)cur < limit, opt = !need && extra > 0 && (int)cur < TL_ALL;
    if (need || opt) T = __hip_atomic_fetch_add(ctr, 1u, __ATOMIC_RELAXED, __HIP_MEMORY_SCOPE_AGENT);
    if (T != 0xffffffffu && (int)T >= TL_ALL) T = 0xffffffffu;
    slot[0] = T; slot[1] = need ? 0u : 1u;
}
__device__ __forceinline__ void conv_until(const Args& A, LAS unsigned char* lds, int limit, int extra) {
    unsigned* ctr = (unsigned*)(A.ws + WS_CTL) + CW_CLAIM; volatile LAS unsigned* slot = (volatile LAS unsigned*)(lds + MISC_OFF) + 16;
    LAS unsigned* Tl = (LAS unsigned*)(lds + RING_OFF);
    if (limit > TL_ALL) limit = TL_ALL;
    int tid = threadIdx.x; asm volatile("" : "+v"(tid));
    if (tid == 0) conv_claim(ctr, slot, limit, extra);
    __syncthreads();
    unsigned T = slot[0]; if (slot[1]) --extra;
    __syncthreads();
    if (T == 0xffffffffu) return;
    f32x4 v[8][2]; TrJob jb; int t, k0, n0;
    conv_job(A, (int)T, jb, t); tr_load(jb, t, tid, v, k0, n0);
#pragma unroll 1
    for (;;) {
        tr_to_lds(Tl, tid, v);
        if (tid == 0) conv_claim(ctr, slot, limit, extra);
        __syncthreads();
        const unsigned Tn = slot[0]; if (slot[1]) --extra;
        const TrJob cj = jb; const int ck0 = k0, cn0 = n0;
        if (Tn != 0xffffffffu) { conv_job(A, (int)Tn, jb, t); tr_load(jb, t, tid, v, k0, n0); }
        tr_store(cj, Tl, tid, ck0, cn0);
        __syncthreads();
        if (Tn == 0xffffffffu) break;
    }
}

__device__ __forceinline__ void p0_prologue(const Args& A, LAS unsigned char* lds, int gw, int NGW, int wave, int lane) {
    for (int i = gw * 64 + lane; i < DEPTH * 240 * DM / 8; i += NGW * 64) { const int l = i / (240 * DM / 8), j = i - l * (240 * DM / 8);
        *(v4u*)((bf16*)(A.ws + WS_W + (size_t)l * LW_END + LW_WIN) + pg8::blk_off(4368 + (j >> 8), 8 * (j & 255), DM)) = (v4u){0u, 0u, 0u, 0u}; }
    { const float* x = (const float*)A.in[0]; bf16* XB = (bf16*)(A.ws + WS_H); unsigned long long* ssq0 = (unsigned long long*)(A.ws + WS_CTL + CTL_SSQ);
      for (int r = gw; r < NTOK; r += NGW) { const f32x4* xr = (const f32x4*)(x + (size_t)r * DM); float sq = 0.f;
#pragma unroll
          for (int j = 0; j < 4; ++j) { const f32x4 a = xr[j * 128 + lane * 2], b = xr[j * 128 + lane * 2 + 1];
              sq += (a.x * a.x + a.y * a.y) + (a.z * a.z + a.w * a.w) + (b.x * b.x + b.y * b.y) + (b.z * b.z + b.w * b.w);
              v4u o; o.x = pk2(a.x, a.y); o.y = pk2(a.z, a.w); o.z = pk2(b.x, b.y); o.w = pk2(b.z, b.w);
              *(v4u*)(XB + pg8::blk_off(r, j * 512 + lane * 8, DM)) = o; }
          sq = wave_sum(sq); if (lane == 0) ssq0[r] = (unsigned long long)(sq * 1048576.0f + 0.5f); } }
    { const float* wp = (const float*)A.in[9]; const float* ps = (const float*)A.in[10]; bf16* wpt = (bf16*)(A.ws + WS_WPT);
      for (int i = gw * 64 + lane; i < DEPTH * 4 * 192 * 192; i += NGW * 64) { const int cc = i % 192, d = (i / 192) % 192, lg = i / (192 * 192);
          wpt[i] = (bf16)f2bf(wp[((size_t)lg * 192 + cc) * 192 + d] * ps[lg * 192 + d]); } }
    const int* pos = (const int*)A.in[1];
    float* cs = (float*)(A.ws + WS_ROPE); float* sn = cs + (size_t)NTOK * 32;
    for (int i = gw * 64 + lane; i < NTOK * 32; i += NGW * 64) { const int t = i >> 5, f = i & 31;
        const double inv = exp(-(double)f * (9.210340371976184 / 32.0));
        const double ang = (double)pos[t] * inv; cs[i] = (float)cos(ang); sn[i] = (float)sin(ang); }
}

__device__ __forceinline__ void rmsnorm_phase(const float* X, const float* g, bf16* H, int gw, int NGW, int lane) {
    asm volatile("" : "+v"(lane));
    for (int r = gw; r < NTOK; r += NGW) {
        const f32x4* xr = (const f32x4*)(X + (size_t)r * DM);
        f32x4 v[8]; float s = 0.f;
#pragma unroll
        for (int j = 0; j < 4; ++j) { v[2 * j] = xr[j * 128 + lane * 2]; v[2 * j + 1] = xr[j * 128 + lane * 2 + 1]; }
#pragma unroll
        for (int j = 0; j < 8; ++j) s += (v[j].x * v[j].x + v[j].y * v[j].y) + (v[j].z * v[j].z + v[j].w * v[j].w);
        const float rstd = 1.0f / sqrtf(wave_sum(s) * (1.0f / DM) + EPS);
#pragma unroll
        for (int j = 0; j < 4; ++j) { const f32x4 g0 = ((const f32x4*)g)[j * 128 + lane * 2], g1 = ((const f32x4*)g)[j * 128 + lane * 2 + 1];
            const f32x4 a = v[2 * j] * rstd * g0, b = v[2 * j + 1] * rstd * g1;
            v4u o; o.x = pk2(a.x, a.y); o.y = pk2(a.z, a.w); o.z = pk2(b.x, b.y); o.w = pk2(b.z, b.w);
            *(v4u*)(H + (size_t)r * DM + j * 512 + lane * 8) = o; }
    }
}
__device__ __forceinline__ void final_phase(const bf16* XB, const unsigned long long* ssq, const float* g, float* out, int gw, int NGW, int lane) {
    asm volatile("" : "+v"(lane));
    for (int r = gw; r < NTOK; r += NGW) {
        const float rstd = pg8::rstd_of(ssq[r]);
#pragma unroll
        for (int j = 0; j < 4; ++j) { const int c0 = j * 512 + lane * 8; const v4u x = *(const v4u*)(XB + pg8::blk_off(r, c0, DM));
            const f32x4 g0 = *(const f32x4*)(g + c0), g1 = *(const f32x4*)(g + c0 + 4);
            *(f32x4*)(out + (size_t)r * DM + c0) = (f32x4){bflo(x.x), bfhi(x.x), bflo(x.y), bfhi(x.y)} * rstd * g0;
            *(f32x4*)(out + (size_t)r * DM + c0 + 4) = (f32x4){bflo(x.z), bfhi(x.z), bflo(x.w), bfhi(x.w)} * rstd * g1; }
    }
}

typedef short bf16x8_t __attribute__((ext_vector_type(8)));
typedef unsigned v2u __attribute__((ext_vector_type(2)));
__device__ __forceinline__ void att_unit(LAS unsigned char* lds, const bf16* PROJ, const float* COS, const float* SIN, const float* sinks, bf16* YA, int u) {
    int tid = threadIdx.x; asm volatile("" : "+v"(tid));
    const int b = u >> 6, kvh = (u >> 4) & 3, blk = u & 15;
    LAS bf16* Ks = (LAS bf16*)lds;
    LAS bf16* VT = Ks + 256 * 72;
    const int tok0 = b * SEQ + 128 * (blk - 1);
    const int kk0 = blk == 0 ? 128 : 0;
    for (int idx = tid; idx < 256 * 4; idx += 512) { const int kk = idx >> 2, c4 = idx & 3;
        v4u w1 = (v4u){0u, 0u, 0u, 0u}, w2 = w1;
        if (kk >= kk0) { const size_t t = (size_t)(tok0 + kk);
            const v4u lo = *(const v4u*)(PROJ + t * NPROJ + C_KA + kvh * 64 + 8 * c4), hi = *(const v4u*)(PROJ + t * NPROJ + C_KA + kvh * 64 + 32 + 8 * c4);
            const f32x4 c0 = *(const f32x4*)(COS + t * 32 + 8 * c4), c1 = *(const f32x4*)(COS + t * 32 + 8 * c4 + 4), s0 = *(const f32x4*)(SIN + t * 32 + 8 * c4), s1 = *(const f32x4*)(SIN + t * 32 + 8 * c4 + 4);
            const float x1[8] = {bflo(lo.x), bfhi(lo.x), bflo(lo.y), bfhi(lo.y), bflo(lo.z), bfhi(lo.z), bflo(lo.w), bfhi(lo.w)};
            const float x2[8] = {bflo(hi.x), bfhi(hi.x), bflo(hi.y), bfhi(hi.y), bflo(hi.z), bfhi(hi.z), bflo(hi.w), bfhi(hi.w)};
            const float cc[8] = {c0.x, c0.y, c0.z, c0.w, c1.x, c1.y, c1.z, c1.w}, ss[8] = {s0.x, s0.y, s0.z, s0.w, s1.x, s1.y, s1.z, s1.w};
            float q1[8], q2[8];
#pragma unroll
            for (int j = 0; j < 8; ++j) { q1[j] = x1[j] * cc[j] - x2[j] * ss[j]; q2[j] = x2[j] * cc[j] + x1[j] * ss[j]; }
            w1.x = pk2(q1[0], q1[1]); w1.y = pk2(q1[2], q1[3]); w1.z = pk2(q1[4], q1[5]); w1.w = pk2(q1[6], q1[7]);
            w2.x = pk2(q2[0], q2[1]); w2.y = pk2(q2[2], q2[3]); w2.z = pk2(q2[4], q2[5]); w2.w = pk2(q2[6], q2[7]); }
        *(LAS v4u*)(Ks + kk * 72 + 8 * c4) = w1; *(LAS v4u*)(Ks + kk * 72 + 32 + 8 * c4) = w2; }
    for (int idx = tid; idx < 256 * 8; idx += 512) { const int ch = idx >> 8, kk = idx & 255;
        v4u w = (v4u){0u, 0u, 0u, 0u};
        if (kk >= kk0) w = *(const v4u*)(PROJ + (size_t)(tok0 + kk) * NPROJ + C_VA + kvh * 64 + ch * 8);
        LAS bf16* vp = VT + (ch * 8) * 264 + kk;
        vp[0 * 264] = (bf16)(w.x & 0xffffu); vp[1 * 264] = (bf16)(w.x >> 16); vp[2 * 264] = (bf16)(w.y & 0xffffu); vp[3 * 264] = (bf16)(w.y >> 16);
        vp[4 * 264] = (bf16)(w.z & 0xffffu); vp[5 * 264] = (bf16)(w.z >> 16); vp[6 * 264] = (bf16)(w.w & 0xffffu); vp[7 * 264] = (bf16)(w.w >> 16); }
    const int wave = __builtin_amdgcn_readfirstlane(tid >> 6), lane = tid & 63, g = lane >> 4, c = lane & 15;
    v4u qlo, qhi, nlo, nhi; f32x4 qc0, qc1, qs0, qs1, nc0, nc1, ns0, ns1;
#define ATT_LOADQ(LO, HI, C0, C1, S0, S1, ti_) do { const int id_ = 3 * wave + (ti_), hq_ = kvh * 3 + (id_ >> 3); const size_t t_ = (size_t)(b * SEQ + 128 * blk + 16 * (id_ & 7) + c); \
        LO = *(const v4u*)(PROJ + t_ * NPROJ + C_QA + hq_ * 64 + 8 * g); HI = *(const v4u*)(PROJ + t_ * NPROJ + C_QA + hq_ * 64 + 32 + 8 * g); \
        C0 = *(const f32x4*)(COS + t_ * 32 + 8 * g); C1 = *(const f32x4*)(COS + t_ * 32 + 8 * g + 4); S0 = *(const f32x4*)(SIN + t_ * 32 + 8 * g); S1 = *(const f32x4*)(SIN + t_ * 32 + 8 * g + 4); } while (0)
    ATT_LOADQ(qlo, qhi, qc0, qc1, qs0, qs1, 0);
    __syncthreads();
#pragma unroll 1
    for (int ti = 0; ti < 3; ++ti) {
        const int id = 3 * wave + ti, gq = id >> 3, qt = id & 7, hq = kvh * 3 + gq, qi = 16 * qt + c, kb0 = qt >> 1;
        const size_t t = (size_t)(b * SEQ + 128 * blk + qi);
        if (ti + 1 < 3) ATT_LOADQ(nlo, nhi, nc0, nc1, ns0, ns1, ti + 1);
        bf16x8_t qb[2];
        { const float x1[8] = {bflo(qlo.x), bfhi(qlo.x), bflo(qlo.y), bfhi(qlo.y), bflo(qlo.z), bfhi(qlo.z), bflo(qlo.w), bfhi(qlo.w)};
          const float x2[8] = {bflo(qhi.x), bfhi(qhi.x), bflo(qhi.y), bfhi(qhi.y), bflo(qhi.z), bfhi(qhi.z), bflo(qhi.w), bfhi(qhi.w)};
          const float cc[8] = {qc0.x, qc0.y, qc0.z, qc0.w, qc1.x, qc1.y, qc1.z, qc1.w}, ss[8] = {qs0.x, qs0.y, qs0.z, qs0.w, qs1.x, qs1.y, qs1.z, qs1.w};
          float q1[8], q2[8];
#pragma unroll
          for (int j = 0; j < 8; ++j) { q1[j] = (x1[j] * cc[j] - x2[j] * ss[j]) * 0.125f; q2[j] = (x2[j] * cc[j] + x1[j] * ss[j]) * 0.125f; }
          v4u w1, w2; w1.x = pk2(q1[0], q1[1]); w1.y = pk2(q1[2], q1[3]); w1.z = pk2(q1[4], q1[5]); w1.w = pk2(q1[6], q1[7]);
          w2.x = pk2(q2[0], q2[1]); w2.y = pk2(q2[2], q2[3]); w2.z = pk2(q2[4], q2[5]); w2.w = pk2(q2[6], q2[7]);
          qb[0] = __builtin_bit_cast(bf16x8_t, w1); qb[1] = __builtin_bit_cast(bf16x8_t, w2); }
        bf16x8_t kf[10][2];
#pragma unroll
        for (int kt = 0; kt < 10; ++kt)
#pragma unroll
            for (int ks = 0; ks < 2; ++ks) kf[kt][ks] = *(const LAS bf16x8_t*)(Ks + (32 * kb0 + 16 * kt + c) * 72 + 32 * ks + 8 * g);
        __builtin_amdgcn_sched_barrier(0);
        f32x4 st[10];
#pragma unroll
        for (int kt = 0; kt < 10; ++kt) { f32x4 acc = (f32x4){0.f, 0.f, 0.f, 0.f};
#pragma unroll
            for (int ks = 0; ks < 2; ++ks) acc = __builtin_amdgcn_mfma_f32_16x16x32_bf16(kf[kt][ks], qb[ks], acc, 0, 0, 0);
            st[kt] = acc; }
        v2u vlo[5][4], vhi[5][4];
#pragma unroll
        for (int ks = 0; ks < 5; ++ks)
#pragma unroll
            for (int dt = 0; dt < 4; ++dt) { const LAS bf16* vr = VT + (16 * dt + c) * 264 + 32 * (kb0 + ks) + 4 * g; vlo[ks][dt] = *(const LAS v2u*)vr; vhi[ks][dt] = *(const LAS v2u*)(vr + 16); }
        const float sink = sinks[hq];
        float m = sink;
#pragma unroll
        for (int kt = 0; kt < 10; ++kt)
#pragma unroll
            for (int r = 0; r < 4; ++r) { const int kk = 32 * kb0 + 16 * kt + 4 * g + r; const bool ok = (kk >= qi + 1) && (kk <= qi + 128) && (kk >= kk0);
                st[kt][r] = ok ? st[kt][r] : -1e30f; m = fmaxf(m, st[kt][r]); }
        m = fmaxf(m, __shfl_xor(m, 16)); m = fmaxf(m, __shfl_xor(m, 32));
        float l = 0.f;
#pragma unroll
        for (int kt = 0; kt < 10; ++kt)
#pragma unroll
            for (int r = 0; r < 4; ++r) { const float p = (st[kt][r] > -1e29f) ? __expf(st[kt][r] - m) : 0.f; st[kt][r] = p; l += p; }
        l += __shfl_xor(l, 16); l += __shfl_xor(l, 32);
        l += __expf(sink - m);
        f32x4 o[4];
#pragma unroll
        for (int dt = 0; dt < 4; ++dt) o[dt] = (f32x4){0.f, 0.f, 0.f, 0.f};
#pragma unroll
        for (int ks = 0; ks < 5; ++ks) { v4u pw; pw.x = pk2(st[2 * ks][0], st[2 * ks][1]); pw.y = pk2(st[2 * ks][2], st[2 * ks][3]); pw.z = pk2(st[2 * ks + 1][0], st[2 * ks + 1][1]); pw.w = pk2(st[2 * ks + 1][2], st[2 * ks + 1][3]);
            const bf16x8_t pb = __builtin_bit_cast(bf16x8_t, pw);
#pragma unroll
            for (int dt = 0; dt < 4; ++dt) { const v4u aw = (v4u){vlo[ks][dt].x, vlo[ks][dt].y, vhi[ks][dt].x, vhi[ks][dt].y};
                o[dt] = __builtin_amdgcn_mfma_f32_16x16x32_bf16(__builtin_bit_cast(bf16x8_t, aw), pb, o[dt], 0, 0, 0); } }
        const float inv = 1.0f / l;
#pragma unroll
        for (int dt = 0; dt < 4; ++dt) { v2u w; w.x = pk2(o[dt][0] * inv, o[dt][1] * inv); w.y = pk2(o[dt][2] * inv, o[dt][3] * inv);
            *(v2u*)(YA + pg8::blk_off((int)t, hq * 64 + 16 * dt + 4 * g, BRW)) = w; }
        qlo = nlo; qhi = nhi; qc0 = nc0; qc1 = nc1; qs0 = ns0; qs1 = ns1;
    }
#undef ATT_LOADQ
    __syncthreads();
}

__device__ __forceinline__ void pool_units(LAS unsigned char* lds, const bf16* PROJ, const bf16* WPT, bf16* YP, int first, int stride, int nunits) {
    int tid = threadIdx.x; asm volatile("" : "+v"(tid));
    if (first >= nunits) return;
    const int gp = first & 3, w = 2 << gp;
    const int wave = __builtin_amdgcn_readfirstlane(tid >> 6), lane = tid & 63, g = lane >> 4, c = lane & 15, mt = wave & 3, nh = wave >> 2;
    LAS float* U = (LAS float*)lds;
    LAS bf16* DA = (LAS bf16*)(U + 79 * 192);
    bf16x8_t wf[6][6];
    { const bf16* wbase = WPT + (size_t)gp * 192 * 192;
#pragma unroll
      for (int ni = 0; ni < 6; ++ni)
#pragma unroll
          for (int ks = 0; ks < 6; ++ks) wf[ni][ks] = *(const bf16x8_t*)(wbase + (size_t)(16 * (6 * nh + ni) + c) * 192 + 32 * ks + 8 * g); }
#pragma unroll 1
    for (int u = first; u < nunits; u += stride) {
        const int tile = u >> 2, t0 = tile * 64, s0 = t0 & (SEQ - 1);
        for (int idx = tid; idx < 79 * 24; idx += 512) { const int rr = idx / 24, cq = idx - rr * 24; const int srel = s0 - 15 + rr;
            v4u x = (v4u){0u, 0u, 0u, 0u}; if (srel >= 0) x = *(const v4u*)(PROJ + (size_t)(t0 - 15 + rr) * NPROJ + C_PU + gp * 192 + cq * 8);
            *(LAS f32x4*)(U + rr * 192 + cq * 8) = (f32x4){bflo(x.x), bfhi(x.x), bflo(x.y), bfhi(x.y)}; *(LAS f32x4*)(U + rr * 192 + cq * 8 + 4) = (f32x4){bflo(x.z), bfhi(x.z), bflo(x.w), bfhi(x.w)}; }
        __syncthreads();
        for (int idx = tid; idx < 8 * 192; idx += 512) { const int run = idx / 192, cc = idx - run * 192, tokb = 8 * run;
            int sq = s0 + tokb; int cnt = (sq + 1) < w ? (sq + 1) : w;
            float sum = 0.f; for (int j = 0; j < cnt; ++j) sum += U[(15 + tokb - j) * 192 + cc];
            DA[tokb * 200 + cc] = (bf16)f2bf(sum / (float)cnt - U[(15 + tokb) * 192 + cc]);
#pragma unroll
            for (int i = 1; i < 8; ++i) { const int tok = tokb + i; sq = s0 + tok; const float ut = U[(15 + tok) * 192 + cc];
                sum += ut; if (sq >= w) sum -= U[(15 + tok - w) * 192 + cc];
                cnt = (sq + 1) < w ? (sq + 1) : w;
                DA[tok * 200 + cc] = (bf16)f2bf(sum / (float)cnt - ut); } }
        __syncthreads();
        {
            bf16x8_t db[6];
#pragma unroll
            for (int ks = 0; ks < 6; ++ks) db[ks] = *(const LAS bf16x8_t*)(DA + (16 * mt + c) * 200 + 32 * ks + 8 * g);
#pragma unroll
            for (int ni = 0; ni < 6; ++ni) { const int nt = 6 * nh + ni;
                f32x4 acc = (f32x4){0.f, 0.f, 0.f, 0.f};
#pragma unroll
                for (int ks = 0; ks < 6; ++ks) acc = __builtin_amdgcn_mfma_f32_16x16x32_bf16(wf[ni][ks], db[ks], acc, 0, 0, 0);
                v2u wv; wv.x = pk2(acc[0], acc[1]); wv.y = pk2(acc[2], acc[3]);
                *(v2u*)(YP + pg8::blk_off(t0 + 16 * mt + c, gp * 192 + 16 * nt + 4 * g, BRW)) = wv; }
        }
        __syncthreads();
    }
}

constexpr size_t GP_QT = 0, GP_KST = 12288, GP_A = 24576, GP_VT = 32768, GP_DEC = 57344, GP_ITEM = 57856;
__device__ __forceinline__ void gla_pre_items(LAS unsigned char* lds, const bf16* PROJ, const float* A2, const float* ba, unsigned char* GPRE, int first, int stride, int nitems) {
    int tid = threadIdx.x; asm volatile("" : "+v"(tid));
    if (first >= nitems) return;
    LAS float* LRs = (LAS float*)lds;
    LAS float* A2s = LRs + 64 * 16;
    LAS float* Bs = A2s + 16 * 96;
    LAS bf16* QTs = (LAS bf16*)(Bs + 64 * 96);
    LAS bf16* KTs = QTs + 64 * 104;
    LAS bf16* KSTs = KTs + 64 * 104;
    LAS bf16* VTs = KSTs + 96 * 72;
    v4u rlr = (v4u){0u, 0u, 0u, 0u}, rqk[3], rv[3]; float ra2[3];
#define PRE_LOAD(it_) do { const int bh_ = (it_) >> 5, h_ = bh_ & 3; const size_t tk_ = (size_t)((bh_ >> 2) * SEQ + ((it_) & 31) * 64); \
        if (tid < 128) rlr = *(const v4u*)(PROJ + (tk_ + (tid >> 1)) * NPROJ + C_LR + (tid & 1) * 8); \
        _Pragma("unroll") for (int i_ = 0; i_ < 3; ++i_) { const int idx_ = tid + 512 * i_, t_ = idx_ / 24, cq_ = idx_ - t_ * 24; \
            rqk[i_] = *(const v4u*)(PROJ + (tk_ + t_) * NPROJ + (cq_ < 12 ? C_QG + h_ * 96 + cq_ * 8 : C_KG + h_ * 96 + (cq_ - 12) * 8)); \
            rv[i_] = *(const v4u*)(PROJ + (tk_ + t_) * NPROJ + C_VG + h_ * 192 + cq_ * 8); \
            const int r_ = idx_ / 96, d_ = idx_ - r_ * 96; ra2[i_] = A2[r_ * 384 + h_ * 96 + d_]; } } while (0)
    PRE_LOAD(first);
#pragma unroll 1
    for (int item = first; item < nitems; item += stride) {
    const int bh = item >> 5, ch = item & 31, b = bh >> 2, h = bh & 3;
    unsigned char* gp = GPRE + (size_t)item * GP_ITEM;
    if (tid < 128) { const int t = tid >> 1, hq = tid & 1; const v4u w = rlr;
        *(LAS f32x4*)(LRs + t * 16 + hq * 8) = (f32x4){bflo(w.x), bfhi(w.x), bflo(w.y), bfhi(w.y)}; *(LAS f32x4*)(LRs + t * 16 + hq * 8 + 4) = (f32x4){bflo(w.z), bfhi(w.z), bflo(w.w), bfhi(w.w)}; }
#pragma unroll
    for (int i = 0; i < 3; ++i) { const int idx = tid + 512 * i, t = idx / 24, cq = idx - t * 24;
        if (cq < 12) *(LAS v4u*)(QTs + t * 104 + cq * 8) = rqk[i]; else *(LAS v4u*)(KTs + t * 104 + (cq - 12) * 8) = rqk[i];
        A2s[idx] = ra2[i];
        const v4u w = rv[i]; LAS bf16* vp = VTs + (cq * 8) * 72 + t;
        vp[0 * 72] = (bf16)(w.x & 0xffffu); vp[1 * 72] = (bf16)(w.x >> 16); vp[2 * 72] = (bf16)(w.y & 0xffffu); vp[3 * 72] = (bf16)(w.y >> 16);
        vp[4 * 72] = (bf16)(w.z & 0xffffu); vp[5 * 72] = (bf16)(w.z >> 16); vp[6 * 72] = (bf16)(w.w & 0xffffu); vp[7 * 72] = (bf16)(w.w >> 16); }
    if (item + stride < nitems) PRE_LOAD(item + stride);
    __syncthreads();
    {
        const int wv = __builtin_amdgcn_readfirstlane(tid >> 6), ln = tid & 63, g = ln >> 4, c = ln & 15;
#pragma unroll
        for (int rep3 = 0; rep3 < 3; ++rep3) { const int id = wv + 8 * rep3, tt = id / 6, dd = id - tt * 6;
            f32x4 z = (f32x4){0.f, 0.f, 0.f, 0.f};
#pragma unroll
            for (int ks = 0; ks < 4; ++ks) z = __builtin_amdgcn_mfma_f32_16x16x4f32(LRs[(16 * tt + c) * 16 + 4 * ks + g], A2s[(4 * ks + g) * 96 + 16 * dd + c], z, 0, 0, 0);
            const float bb = ba[h * 96 + 16 * dd + c];
#pragma unroll
            for (int r = 0; r < 4; ++r) { const float zz = z[r] + bb; const float ls = fminf(zz, 0.f) - __logf(1.0f + __expf(-fabsf(zz)));
                Bs[(16 * tt + 4 * g + r) * 96 + 16 * dd + c] = ls * (1.0f / 16.0f); } }
    }
    __syncthreads();
    if (tid < 96) { float gv[64];
#pragma unroll
        for (int t = 0; t < 64; ++t) gv[t] = Bs[t * 96 + tid];
        float run = 0.f;
#pragma unroll
        for (int t = 0; t < 64; ++t) { run += gv[t]; Bs[t * 96 + tid] = run; } }
    __syncthreads();
    const float qscale = 0.10206207261596575f;
    for (int idx = tid; idx < 64 * 96; idx += 512) { const int t = idx / 96, d = idx - t * 96;
        const float bb = Bs[idx], bl = Bs[63 * 96 + d];
        const float q = bf2f(QTs[t * 104 + d]), k = bf2f(KTs[t * 104 + d]);
        QTs[t * 104 + d] = (bf16)f2bf(q * qscale * __expf(bb)); KTs[t * 104 + d] = (bf16)f2bf(k * __expf(-bb)); KSTs[d * 72 + t] = (bf16)f2bf(k * __expf(bl - bb)); }
    if (tid < 96) ((float*)(gp + GP_DEC))[tid] = __expf(Bs[63 * 96 + tid]);
    __syncthreads();
    for (int idx = tid; idx < 64 * 12; idx += 512) { const int r = idx / 12, cq = idx - r * 12; *(v4u*)(gp + GP_QT + r * 192 + cq * 16) = *(const LAS v4u*)(QTs + r * 104 + cq * 8); }
    for (int idx = tid; idx < 96 * 8; idx += 512) { const int r = idx >> 3, cq = idx & 7; *(v4u*)(gp + GP_KST + r * 128 + cq * 16) = *(const LAS v4u*)(KSTs + r * 72 + cq * 8); }
    for (int idx = tid; idx < 192 * 8; idx += 512) { const int r = idx >> 3, cq = idx & 7; *(v4u*)(gp + GP_VT + r * 128 + cq * 16) = *(const LAS v4u*)(VTs + r * 72 + cq * 8); }
    {
        const int wave = __builtin_amdgcn_readfirstlane(tid >> 6), lane = tid & 63, g = lane >> 4, c = lane & 15;
#pragma unroll
        for (int rep = 0; rep < 2; ++rep) { const int id = wave + 8 * rep, it = id >> 2, jt = id & 3;
            f32x4 acc = (f32x4){0.f, 0.f, 0.f, 0.f};
            if (jt <= it) {
#pragma unroll
                for (int ks = 0; ks < 3; ++ks) { const bf16x8_t a = *(const LAS bf16x8_t*)(KTs + (16 * jt + c) * 104 + 32 * ks + 8 * g), bq = *(const LAS bf16x8_t*)(QTs + (16 * it + c) * 104 + 32 * ks + 8 * g);
                    acc = __builtin_amdgcn_mfma_f32_16x16x32_bf16(a, bq, acc, 0, 0, 0); } }
            const int i = 16 * it + c, j0 = 16 * jt + 4 * g;
            v2u w; w.x = pk2(j0 + 0 <= i ? acc[0] : 0.f, j0 + 1 <= i ? acc[1] : 0.f); w.y = pk2(j0 + 2 <= i ? acc[2] : 0.f, j0 + 3 <= i ? acc[3] : 0.f);
            *(v2u*)(gp + GP_A + i * 128 + j0 * 2) = w; }
    }
    __syncthreads();
    }
#undef PRE_LOAD
}
constexpr int GS_QT = 0, GS_KST = 13312, GS_A = 27136, GS_VT = 36352, GS_DEC = 45568, GS_BUF = 46080;
__device__ __forceinline__ void gla_scan_unit(LAS unsigned char* lds, const unsigned char* GPRE, float* GO, int u) {
    int tid = threadIdx.x; asm volatile("" : "+v"(tid));
    const int bh = u / 3, s3 = u - 3 * bh, b = bh >> 2, h = bh & 3;
    const int wave = __builtin_amdgcn_readfirstlane(tid >> 6), lane = tid & 63, g = lane >> 4, c = lane & 15, th = wave >> 2, jt = wave & 3;
    int goff[5], loff[5];
#pragma unroll
    for (int i = 0; i < 5; ++i) { const int q = tid + 512 * i;
        if (q < 768) { const int r = q / 12, cq = q - r * 12; goff[i] = (int)GP_QT + r * 192 + cq * 16; loff[i] = GS_QT + r * 208 + cq * 16; }
        else if (q < 1536) { const int p = q - 768, r = p >> 3, cq = p & 7; goff[i] = (int)GP_KST + r * 128 + cq * 16; loff[i] = GS_KST + r * 144 + cq * 16; }
        else if (q < 2048) { const int p = q - 1536, r = p >> 3, cq = p & 7; goff[i] = (int)GP_A + r * 128 + cq * 16; loff[i] = GS_A + r * 144 + cq * 16; }
        else { const int p = q - 2048, r = p >> 3, cq = p & 7; goff[i] = (int)GP_VT + (64 * s3 + r) * 128 + cq * 16; loff[i] = GS_VT + r * 144 + cq * 16; } }
    f32x4 S[6];
#pragma unroll
    for (int i = 0; i < 6; ++i) S[i] = (f32x4){0.f, 0.f, 0.f, 0.f};
    v4u rg[5]; v4u rd = (v4u){0u, 0u, 0u, 0u};
    { const unsigned char* gp = GPRE + (size_t)(bh * 32) * GP_ITEM;
#pragma unroll
      for (int i = 0; i < 5; ++i) rg[i] = *(const v4u*)(gp + goff[i]);
      if (tid < 24) rd = *(const v4u*)(gp + GP_DEC + tid * 16);
#pragma unroll
      for (int i = 0; i < 5; ++i) *(LAS v4u*)(lds + loff[i]) = rg[i];
      if (tid < 24) *(LAS v4u*)(lds + GS_DEC + tid * 16) = rd; }
    __syncthreads();
#pragma unroll 1
    for (int ch = 0; ch < 32; ++ch) {
        LAS unsigned char* cur = lds + (ch & 1) * GS_BUF; LAS unsigned char* nxt = lds + ((ch + 1) & 1) * GS_BUF;
        if (ch + 1 < 32) { const unsigned char* gp = GPRE + (size_t)(bh * 32 + ch + 1) * GP_ITEM;
#pragma unroll
            for (int i = 0; i < 5; ++i) rg[i] = *(const v4u*)(gp + goff[i]);
            if (tid < 24) rd = *(const v4u*)(gp + GP_DEC + tid * 16); }
        const size_t tokc = (size_t)(b * SEQ + ch * 64);
        bf16x8_t vb[2];
#pragma unroll
        for (int ks = 0; ks < 2; ++ks) vb[ks] = *(const LAS bf16x8_t*)(cur + GS_VT + (16 * jt + c) * 144 + (32 * ks + 8 * g) * 2);
        bf16x8_t sb[3];
#pragma unroll
        for (int ks = 0; ks < 3; ++ks) { v4u w; w.x = pk2(S[2 * ks][0], S[2 * ks][1]); w.y = pk2(S[2 * ks][2], S[2 * ks][3]); w.z = pk2(S[2 * ks + 1][0], S[2 * ks + 1][1]); w.w = pk2(S[2 * ks + 1][2], S[2 * ks + 1][3]);
            sb[ks] = __builtin_bit_cast(bf16x8_t, w); }
#pragma unroll
        for (int ti = 0; ti < 2; ++ti) { const int it = 2 * th + ti;
            f32x4 acc = (f32x4){0.f, 0.f, 0.f, 0.f};
#pragma unroll
            for (int ks = 0; ks < 2; ++ks) { const bf16x8_t a = *(const LAS bf16x8_t*)(cur + GS_A + (16 * it + c) * 144 + (32 * ks + 8 * g) * 2);
                acc = __builtin_amdgcn_mfma_f32_16x16x32_bf16(a, vb[ks], acc, 0, 0, 0); }
#pragma unroll
            for (int ks = 0; ks < 3; ++ks) { const v2u lo = *(const LAS v2u*)(cur + GS_QT + (16 * it + c) * 208 + (32 * ks + 4 * g) * 2), hi = *(const LAS v2u*)(cur + GS_QT + (16 * it + c) * 208 + (32 * ks + 16 + 4 * g) * 2);
                const v4u w = (v4u){lo.x, lo.y, hi.x, hi.y};
                acc = __builtin_amdgcn_mfma_f32_16x16x32_bf16(__builtin_bit_cast(bf16x8_t, w), sb[ks], acc, 0, 0, 0); }
            float* op = GO + (tokc + 16 * it + 4 * g) * BRW + h * 192 + 64 * s3 + 16 * jt + c;
            op[0 * BRW] = acc[0]; op[1 * BRW] = acc[1]; op[2 * BRW] = acc[2]; op[3 * BRW] = acc[3]; }
#pragma unroll
        for (int i = 0; i < 6; ++i) { const f32x4 d4 = *(const LAS f32x4*)(cur + GS_DEC + (16 * i + 4 * g) * 4);
            S[i] = S[i] * d4;
#pragma unroll
            for (int ks = 0; ks < 2; ++ks) { const bf16x8_t a = *(const LAS bf16x8_t*)(cur + GS_KST + (16 * i + c) * 144 + (32 * ks + 8 * g) * 2);
                S[i] = __builtin_amdgcn_mfma_f32_16x16x32_bf16(a, vb[ks], S[i], 0, 0, 0); } }
        if (ch + 1 < 32) {
#pragma unroll
            for (int i = 0; i < 5; ++i) *(LAS v4u*)(nxt + loff[i]) = rg[i];
            if (tid < 24) *(LAS v4u*)(nxt + GS_DEC + tid * 16) = rd; }
        __syncthreads();
    }
}
__device__ __forceinline__ void gla_norm_phase(const float* GO, const bf16* PROJ, const float* gnorm, bf16* YG, int gw, int NGW, int lane) {
    asm volatile("" : "+v"(lane));
    f32x4 gn[3];
#pragma unroll
    for (int j = 0; j < 3; ++j) gn[j] = *(const f32x4*)(gnorm + 12 * lane + 4 * j);
#pragma unroll 1
    for (int t0 = gw; t0 < NTOK; t0 += 4 * NGW) {
        f32x4 o[4][3]; v2u og[4][3];
#pragma unroll
        for (int q = 0; q < 4; ++q) { const int tq = t0 + q * NGW; const size_t t = (size_t)(tq < NTOK ? tq : t0);
#pragma unroll
            for (int j = 0; j < 3; ++j) { o[q][j] = *(const f32x4*)(GO + t * BRW + 12 * lane + 4 * j); og[q][j] = *(const v2u*)(PROJ + t * NPROJ + C_OG + 12 * lane + 4 * j); } }
#pragma unroll
        for (int q = 0; q < 4; ++q) { const int tq = t0 + q * NGW; if (tq >= NTOK) break; const size_t t = (size_t)tq;
            float ss = 0.f;
#pragma unroll
            for (int j = 0; j < 3; ++j) ss += (o[q][j].x * o[q][j].x + o[q][j].y * o[q][j].y) + (o[q][j].z * o[q][j].z + o[q][j].w * o[q][j].w);
            ss += __shfl_xor(ss, 1); ss += __shfl_xor(ss, 2); ss += __shfl_xor(ss, 4); ss += __shfl_xor(ss, 8);
            const float rstd = 1.0f / sqrtf(ss * (1.0f / 192.0f) + EPS);
#pragma unroll
            for (int j = 0; j < 3; ++j) { const float g0 = bflo(og[q][j].x), g1 = bfhi(og[q][j].x), g2 = bflo(og[q][j].y), g3 = bfhi(og[q][j].y);
                const float y0 = o[q][j].x * rstd * gn[j].x * (g0 / (1.0f + __expf(-g0))), y1 = o[q][j].y * rstd * gn[j].y * (g1 / (1.0f + __expf(-g1)));
                const float y2 = o[q][j].z * rstd * gn[j].z * (g2 / (1.0f + __expf(-g2))), y3 = o[q][j].w * rstd * gn[j].w * (g3 / (1.0f + __expf(-g3)));
                v2u w; w.x = pk2(y0, y1); w.y = pk2(y2, y3);
                *(v2u*)(YG + pg8::blk_off((int)t, 12 * lane + 4 * j, BRW)) = w; } }
    }
}

__global__ void __launch_bounds__(NWAVES * 64, 2) mega_fwd(Args A) {
    extern __shared__ __attribute__((aligned(16))) unsigned char lds_raw[];
    LAS unsigned char* lds = (LAS unsigned char*)lds_raw;
    const int tid = threadIdx.x;
    const int G = gridDim.x, bx = blockIdx.x;
    unsigned char* ws = A.ws;
    for (int u = tid; u < (LDS_BYTES - LDSCTL_OFF) / 4; u += NWAVES * 64) ((LAS unsigned*)(lds + LDSCTL_OFF))[u] = 0u;
    __syncthreads();
    XcdBarrier bar = xcd_barrier_post((unsigned*)(ws + WS_CTL) + CW_BAR, (volatile LAS unsigned*)(lds + MISC_OFF) + 8);

    float* X = (float*)(ws + WS_X); bf16* H = (bf16*)(ws + WS_H); bf16* ACT = (bf16*)(ws + WS_ACT); bf16* PROJ = (bf16*)(ws + WS_PROJ);
    bf16* Y = (bf16*)(ws + WS_Y); float* MACC = (float*)(ws + WS_MACC); bf16* MB = (bf16*)(ws + WS_MB); float* GO = (float*)(ws + WS_GO);
    const float* COS = (const float*)(ws + WS_ROPE); const float* SIN = COS + (size_t)NTOK * 32;

    { int t_ = threadIdx.x; asm volatile("" : "+v"(t_)); const int w_ = __builtin_amdgcn_readfirstlane(t_ >> 6); p0_prologue(A, lds, bx * NWAVES + w_, G * NWAVES, w_, t_ & 63); }
    conv_until(A, lds, TL_WO1, 0);
    xcd_barrier(bar);

#pragma unroll 1
    for (int step = 0; step < 3 * DEPTH; ++step) {
        const int l = step / 3, kind = step - 3 * l;
        unsigned char* wl = ws + WS_W + (size_t)l * LW_END;
        const unsigned long long* ssq = (const unsigned long long*)(ws + WS_CTL + CTL_SSQ) + (size_t)step * NTOK; unsigned long long* ssq_next = (unsigned long long*)(ws + WS_CTL + CTL_SSQ) + (size_t)(step + 1) * NTOK;
        if (kind != 1) {
            { pg8::Gemm g{H, (const bf16*)(wl + (kind == 0 ? LW_WI1 : LW_WI2)), NTOK, NWI, DM}; pg8::StaticOrder S; S.init(NTOK, NWI, G, bx);
              pg8::EpiSwiglu E{ACT, DFF, ssq};
              pg8::gemm_phase<pg8::EpiSwiglu, pg8::StaticOrder, true, true>(lds + RING_OFF, g, S, E); }
            { const int rem1 = ((NTOK / 256) * (NWI / 256)) % G;
              conv_until(A, lds, l * TL_LAYER + (kind == 0 ? TL_WIN : TL_LAYER), (rem1 != 0 && bx >= rem1) ? 3 : 0); }
            xcd_barrier(bar);
        } else {
            const int nunits = (NTOK / 256) * (NPROJ / 256), nfull = nunits / G, rem = nunits - nfull * G;
#pragma unroll 1
            for (int part = 0; part < 2; ++part) {
                pg8::Gemm g{H, (const bf16*)(wl + LW_WIN), NTOK, NPROJ, DM}; pg8::RangeOrder S; S.init(NTOK, NPROJ, G, bx); S.i0 = part ? nfull : 0; S.n = part ? 1 : nfull;
                pg8::EpiProj E{PROJ, NPROJ, (const float*)A.in[7] + (size_t)l * 6144, GATE_TILE0, ssq};
                pg8::gemm_phase<pg8::EpiProj, pg8::RangeOrder, true, true>(lds + RING_OFF, g, S, E);
                if (part == 0) xcd_barrier(bar);
            }
            if (bx >= rem) { const int mb = bx - rem, ms = G - rem;
                if ((ms & 3) == 0) pool_units(lds, PROJ, (const bf16*)(ws + WS_WPT) + (size_t)l * 4 * 192 * 192, Y + (size_t)NTOK * BRW, mb, ms, 512);
                else for (int u = mb; u < 512; u += ms) pool_units(lds, PROJ, (const bf16*)(ws + WS_WPT) + (size_t)l * 4 * 192 * 192, Y + (size_t)NTOK * BRW, u, 512, 512);
                gla_pre_items(lds, PROJ, (const float*)A.in[11] + (size_t)l * 16 * 384, (const float*)A.in[12] + l * 384, ws + WS_GPRE, mb, ms, 512); }
            xcd_barrier(bar);
            if (G > 96) { if (bx < 48) gla_scan_unit(lds, ws + WS_GPRE, GO, bx);
                          else for (int u = bx - 48; u < 256; u += G - 48) att_unit(lds, PROJ, COS, SIN, (const float*)A.in[8] + l * 12, Y, u); }
            else { for (int u = bx; u < 48; u += G) gla_scan_unit(lds, ws + WS_GPRE, GO, u);
                   for (int u = bx; u < 256; u += G) att_unit(lds, PROJ, COS, SIN, (const float*)A.in[8] + l * 12, Y, u); }
            conv_until(A, lds, l * TL_LAYER + TL_WI2, (G > 96 && bx >= 48) ? 2 : 0);
            xcd_barrier(bar);
            { int t_ = threadIdx.x; asm volatile("" : "+v"(t_)); gla_norm_phase(GO, PROJ, (const float*)A.in[13] + l * 768, Y + (size_t)2 * NTOK * BRW, bx * NWAVES + __builtin_amdgcn_readfirstlane(t_ >> 6), G * NWAVES, t_ & 63); }
            xcd_barrier(bar);
            { pg8::Gemm g{Y, (const bf16*)(wl + LW_WBR), NTOK, DM, BRW, (size_t)NTOK * BRW * 2, (size_t)DM * BRW * 2}; pg8::SegOrder S; S.init(NTOK, DM, G, bx); S.nseg = 3;
              pg8::EpiMergeSeg E{PROJ + C_GATE, NPROJ, DM, MB, DM};
              pg8::gemm_phase<pg8::EpiMergeSeg, pg8::SegOrder, true, true>(lds + RING_OFF, g, S, E); }
            xcd_barrier(bar);
        }
        { const bf16* Ap = (kind == 1) ? (const bf16*)MB : (const bf16*)ACT; const int Kd = (kind == 1) ? DM : DFF;
          const bf16* Bp = (const bf16*)(wl + (kind == 0 ? LW_WO1 : (kind == 1 ? LW_WOUT : LW_WO2)));
          pg8::Gemm g{Ap, Bp, NTOK, DM, Kd}; pg8::StaticOrder S; S.init(NTOK, DM, G, bx);
          pg8::EpiResid E{H, ssq_next, DM, kind == 1 ? 1.0f : 0.5f};
          pg8::gemm_phase<pg8::EpiResid, pg8::StaticOrder, true, true>(lds + RING_OFF, g, S, E); }
        conv_until(A, lds, l * TL_LAYER + (kind == 0 ? TL_BRA : (kind == 1 ? TL_WO2 : TL_LAYER + TL_WO1)), 0);
        xcd_barrier(bar);
    }
    { int t_ = threadIdx.x; asm volatile("" : "+v"(t_)); final_phase(H, (const unsigned long long*)(ws + WS_CTL + CTL_SSQ) + (size_t)12 * NTOK, (const float*)A.in[21], A.out, bx * NWAVES + __builtin_amdgcn_readfirstlane(t_ >> 6), G * NWAVES, t_ & 63); }
}

extern "C" void kernel_launch(void* const* d_in, const int* in_sizes, int n_in, void* d_out, int out_size, void* d_ws, size_t ws_size, hipStream_t stream) {
    static int grid = 0;
    if (grid == 0) {
        if (n_in != 22 || in_sizes[0] != NTOK * DM || out_size != NTOK * DM || ws_size < WS_END) {
            fprintf(stderr, "kernel_launch: unexpected shapes (n_in %d, in0 %d, out %d, ws %zu < %zu); nothing launched\n", n_in, n_in > 0 ? in_sizes[0] : -1, out_size, ws_size, (size_t)WS_END); grid = -1; return; }
        int dev = 0, cus = 0, per_cu = 0;
        if (hipGetDevice(&dev) != hipSuccess || hipDeviceGetAttribute(&cus, hipDeviceAttributeMultiprocessorCount, dev) != hipSuccess) { grid = -1; return; }
        if (hipFuncSetAttribute((const void*)mega_fwd, hipFuncAttributeMaxDynamicSharedMemorySize, LDS_BYTES) != hipSuccess) { fprintf(stderr, "kernel_launch: hipFuncSetAttribute failed\n"); grid = -1; return; }
        if (hipOccupancyMaxActiveBlocksPerMultiprocessor(&per_cu, (const void*)mega_fwd, NWAVES * 64, LDS_BYTES) != hipSuccess || per_cu < 1) { fprintf(stderr, "kernel_launch: occupancy query says %d\n", per_cu); (void)hipGetLastError(); grid = -1; return; }
        grid = cus;
    }
    if (grid < 0) return;
    if (hipMemsetAsync((char*)d_ws + WS_CTL, 0, CTL_ZERO_BYTES, stream) != hipSuccess) return;
    Args a{};
    for (int i = 0; i < 22; ++i) a.in[i] = d_in[i];
    a.out = (float*)d_out; a.ws = (unsigned char*)d_ws;
    hipLaunchKernelGGL(mega_fwd, dim3(grid), dim3(NWAVES * 64), LDS_BYTES, stream, a);
}
```

```cpp
#include <hip/hip_runtime.h>
#include <cstdio>
#include <cstdint>
#include <cmath>
namespace pg8 {
#define PG8_LAS __attribute__((address_space(3)))
typedef unsigned short bf16_t;
typedef short bf16x8 __attribute__((ext_vector_type(8)));
typedef float f32x4 __attribute__((ext_vector_type(4)));
typedef unsigned u32x4 __attribute__((ext_vector_type(4)));
typedef int i32x4 __attribute__((ext_vector_type(4)));
typedef int i32x8 __attribute__((ext_vector_type(8)));
constexpr int BM = 256, BK = 64, HALF = 128, HTB = HALF * BK * 2  , STAGE_BYTES = 8 * HTB, NXCD = 8, WGM = 8;

__host__ __device__ __forceinline__ int lds_byte(int r, int c) { const int st = (r >> 4) * 2 + (c >> 5), rr = r & 15, cc = c & 31, ob = rr * 64 + cc * 2; return st * 1024 + (ob ^ (((ob >> 9) & 1) << 5)); }
__host__ __device__ __forceinline__ void stage_rc(int b, int& R, int& C) { const int st = b / 1024, sb = b % 1024, swz = sb ^ (((sb >> 9) & 1) << 5); R = (st >> 1) * 16 + swz / 64; C = (st & 1) * 32 + (swz % 64) / 2; }
__host__ __device__ __forceinline__ int perm32(int rho) { const int n = rho >> 4, i = rho & 15; return 8 * (i >> 2) + 4 * n + (i & 3); }

__host__ __device__ __forceinline__ size_t blk_off(int r, int c, int C) { return ((size_t)(r >> 6) * (size_t)(C >> 6) + (size_t)(c >> 6)) * 4096 + (size_t)(r & 63) * 64 + (size_t)(c & 63); }
__host__ __device__ __forceinline__ size_t blk8_off(int r, int c, int Cb) { return ((size_t)(r >> 6) * (size_t)(Cb >> 7) + (size_t)(c >> 7)) * 8192 + (size_t)(r & 63) * 128 + (size_t)(c & 127); }
__device__ __forceinline__ unsigned cvt_pk4_fp8(float a, float b, float c, float d) {
    a = __builtin_amdgcn_fmed3f(a, -448.f, 448.f); b = __builtin_amdgcn_fmed3f(b, -448.f, 448.f); c = __builtin_amdgcn_fmed3f(c, -448.f, 448.f); d = __builtin_amdgcn_fmed3f(d, -448.f, 448.f);
    int p = __builtin_amdgcn_cvt_pk_fp8_f32(a, b, 0, false); p = __builtin_amdgcn_cvt_pk_fp8_f32(c, d, p, true); return (unsigned)p; }
struct Unit { int pm, pn, seg; };
struct Gemm { const bf16_t* A; const bf16_t* Bt; int M, N, K; size_t segA = 0, segB = 0; };

struct StaticOrder {
    int nM, nN, nwg, G, c;
    __host__ __device__ void init(int M, int N, int G_, int c_) { nM = M / BM; nN = N / BM; nwg = nM * nN; G = G_; c = c_; }
    __host__ __device__ bool next(int i, Unit& u) const {
        const long L = (long)i * G + c; if (L >= nwg) return false;
        int wgid = (int)L; { const int q = nwg / NXCD, r = nwg % NXCD, xcd = wgid % NXCD, off = wgid / NXCD; wgid = (xcd < r ? xcd * (q + 1) : r * (q + 1) + (xcd - r) * q) + off; }
        const int nig = WGM * nN, gid = wgid / nig, fm = gid * WGM, gsz = (nM - fm) < WGM ? (nM - fm) : WGM;
        u.pm = fm + ((wgid % nig) % gsz); u.pn = (wgid % nig) / gsz; u.seg = 0; return true;
    }
    __device__ __forceinline__ void a_ready(const Unit&) const {}
    __device__ __forceinline__ void done(const Unit&) const {}
};
struct RangeOrder : StaticOrder { int i0, n;
    __host__ __device__ bool next(int i, Unit& u) const { if (i >= n) return false; return StaticOrder::next(i + i0, u); } };
struct SegOrder : StaticOrder { int nseg;
    __host__ __device__ bool next(int i, Unit& u) const { const int t = i / nseg; if (!StaticOrder::next(t, u)) return false; u.seg = i - t * nseg; return true; } };
__device__ __forceinline__ unsigned cvt_pk_bf16(float lo, float hi) { unsigned r; asm volatile("v_cvt_pk_bf16_f32 %0, %1, %2" : "=v"(r) : "v"(lo), "v"(hi)); return r; }
typedef float f32x2 __attribute__((ext_vector_type(2)));
__device__ __forceinline__ float bf_lo(unsigned w) { return __uint_as_float(w << 16); }
__device__ __forceinline__ float bf_hi(unsigned w) { return __uint_as_float(w & 0xffff0000u); }
__device__ __forceinline__ float sigmoid_f(float v) { return __builtin_amdgcn_rcpf(1.0f + __builtin_amdgcn_exp2f(v * -1.4426950408889634f)); }
__device__ __forceinline__ float rstd_of(unsigned long long q) {
    const float f = (float)(unsigned)(q >> 32) * 4294967296.0f + (float)(unsigned)q; return __builtin_amdgcn_rsqf(f * (1.0f / 1048576.0f / 2048.0f) + 1e-6f); }
#define PG8_LOAD_RSTD(rs, ssq, row0) float rs[2][4]; { unsigned long long q_[2][4]; _Pragma("unroll") for (int ai = 0; ai < 2; ++ai) _Pragma("unroll") for (int m = 0; m < 4; ++m) q_[ai][m] = (ssq)[(row0) + ai * HALF + m * 16]; \
    _Pragma("unroll") for (int ai = 0; ai < 2; ++ai) _Pragma("unroll") for (int m = 0; m < 4; ++m) rs[ai][m] = rstd_of(q_[ai][m]); }
struct EpiSwiglu {
    static constexpr bool PERM = true, AFTER_DRAIN = false, SEGMENTED = false;
    bf16_t* O; int ldo; const unsigned long long* ssq;
    __device__ __forceinline__ void operator()(const f32x4 (&acc)[2][2][4][2], const Unit& u, int wr, int wc, int fr, int fq) const {
        const int row0 = u.pm * BM + wr * 64 + fr, hid0 = u.pn * HALF + wc * 32 + 8 * fq;
        PG8_LOAD_RSTD(rsv, ssq, row0)
#pragma unroll
        for (int ai = 0; ai < 2; ++ai)
#pragma unroll
            for (int m = 0; m < 4; ++m) { const int row = row0 + ai * HALF + m * 16; bf16_t* rowp = O + blk_off(row, hid0, ldo);
                const float rs = rsv[ai][m];
                f32x4 v0, v1;
#pragma unroll
                for (int j = 0; j < 4; ++j) { const float a0 = acc[ai][0][m][0][j] * rs, a1 = acc[ai][0][m][1][j] * rs;
                    v0[j] = a0 * sigmoid_f(a0) * (acc[ai][1][m][0][j] * rs); v1[j] = a1 * sigmoid_f(a1) * (acc[ai][1][m][1][j] * rs); }
                u32x4 w; w.x = cvt_pk_bf16(v0[0], v0[1]); w.y = cvt_pk_bf16(v0[2], v0[3]); w.z = cvt_pk_bf16(v1[0], v1[1]); w.w = cvt_pk_bf16(v1[2], v1[3]);
                *(u32x4*)rowp = w; }
    }
};
struct EpiResid {
    static constexpr bool PERM = true, AFTER_DRAIN = false, SEGMENTED = false;
    bf16_t* xb; unsigned long long* ssq_next; int ldc; float scale; unsigned char* x8;
    __device__ __forceinline__ void operator()(const f32x4 (&acc)[2][2][4][2], const Unit& u, int wr, int wc, int fr, int fq) const {
        const int row0 = u.pm * BM + wr * 64 + fr, col0 = u.pn * BM + wc * 32 + 8 * fq;
#pragma unroll
        for (int ai = 0; ai < 2; ++ai) {
            u32x4 t[4][2];
#pragma unroll
            for (int m = 0; m < 4; ++m)
#pragma unroll
                for (int bj = 0; bj < 2; ++bj) t[m][bj] = *(const u32x4*)(xb + blk_off(row0 + ai * HALF + m * 16, col0 + bj * HALF, ldc));
#pragma unroll
            for (int m = 0; m < 4; ++m) { const int row = row0 + ai * HALF + m * 16; float ss = 0.f;
#pragma unroll
                for (int bj = 0; bj < 2; ++bj) { const u32x4 x = t[m][bj];
                    f32x4 v0 = (f32x4){bf_lo(x.x), bf_hi(x.x), bf_lo(x.y), bf_hi(x.y)} + acc[ai][bj][m][0] * scale, v1 = (f32x4){bf_lo(x.z), bf_hi(x.z), bf_lo(x.w), bf_hi(x.w)} + acc[ai][bj][m][1] * scale;
                    u32x4 w; w.x = cvt_pk_bf16(v0[0], v0[1]); w.y = cvt_pk_bf16(v0[2], v0[3]); w.z = cvt_pk_bf16(v1[0], v1[1]); w.w = cvt_pk_bf16(v1[2], v1[3]);
                    *(u32x4*)(xb + blk_off(row, col0 + bj * HALF, ldc)) = w;
                    if (x8) { typedef unsigned v2u_ __attribute__((ext_vector_type(2))); v2u_ q; q.x = cvt_pk4_fp8(v0[0] * 8.f, v0[1] * 8.f, v0[2] * 8.f, v0[3] * 8.f); q.y = cvt_pk4_fp8(v1[0] * 8.f, v1[1] * 8.f, v1[2] * 8.f, v1[3] * 8.f);
                        *(v2u_*)(x8 + blk8_off(row, col0 + bj * HALF, ldc)) = q; }
                    ss += (v0[0] * v0[0] + v0[1] * v0[1]) + (v0[2] * v0[2] + v0[3] * v0[3]) + (v1[0] * v1[0] + v1[1] * v1[1]) + (v1[2] * v1[2] + v1[3] * v1[3]); }
                ss += __shfl_xor(ss, 16); ss += __shfl_xor(ss, 32);
                if (fq == 0) atomicAdd(ssq_next + row, (unsigned long long)(ss * 1048576.0f + 0.5f)); } }
    }
};
struct EpiProj {
    static constexpr bool PERM = true, AFTER_DRAIN = false, SEGMENTED = false;
    bf16_t* O; int ldo; const float* bias; int gate_tile0; const unsigned long long* ssq; float dsc;
    __device__ __forceinline__ void operator()(const f32x4 (&acc)[2][2][4][2], const Unit& u, int wr, int wc, int fr, int fq) const {
        const int row0 = u.pm * BM + wr * 64 + fr, col0 = u.pn * BM + wc * 32 + 8 * fq;
        const bool gate = u.pn >= gate_tile0;
        PG8_LOAD_RSTD(rsv, ssq, row0)
        f32x4 bv[2][2];
#pragma unroll
        for (int bj = 0; bj < 2; ++bj)
#pragma unroll
            for (int n = 0; n < 2; ++n) bv[bj][n] = gate ? *(const f32x4*)(bias + (col0 - gate_tile0 * BM) + bj * HALF + 4 * n) : (f32x4){0.f, 0.f, 0.f, 0.f};
#pragma unroll
        for (int ai = 0; ai < 2; ++ai)
#pragma unroll
            for (int m = 0; m < 4; ++m) { const int row = row0 + ai * HALF + m * 16; bf16_t* rowp = O + (size_t)row * ldo + col0;
                const float rs = rsv[ai][m] * dsc;
#pragma unroll
                for (int bj = 0; bj < 2; ++bj) { f32x4 v0 = acc[ai][bj][m][0] * rs + bv[bj][0], v1 = acc[ai][bj][m][1] * rs + bv[bj][1];
                    if (gate) {
#pragma unroll
                        for (int j = 0; j < 4; ++j) { v0[j] = sigmoid_f(v0[j]); v1[j] = sigmoid_f(v1[j]); } }
                    u32x4 w; w.x = cvt_pk_bf16(v0[0], v0[1]); w.y = cvt_pk_bf16(v0[2], v0[3]); w.z = cvt_pk_bf16(v1[0], v1[1]); w.w = cvt_pk_bf16(v1[2], v1[3]);
                    *(u32x4*)(rowp + bj * HALF) = w; } }
    }
};
struct EpiMergeSeg {
    static constexpr bool PERM = true, AFTER_DRAIN = false, SEGMENTED = true;
    const bf16_t* gate; int ldg; int gseg; bf16_t* outb; int ldc;
    __device__ __forceinline__ bool run(f32x4 (&acc)[2][2][4][2], const Unit& u, int wr, int wc, int fr, int fq) const {
        const int row0 = u.pm * BM + wr * 64 + fr, col0 = u.pn * BM + wc * 32 + 8 * fq;
        const bf16_t* gs = gate + (size_t)u.seg * gseg; const bool last = u.seg == 2;
#pragma unroll
        for (int ai = 0; ai < 2; ++ai) {
            u32x4 ga[4][2], gb[4][2];
#pragma unroll
            for (int m = 0; m < 4; ++m)
#pragma unroll
                for (int bj = 0; bj < 2; ++bj) { const size_t p = (size_t)(row0 + ai * HALF + m * 16) * ldg + col0 + bj * HALF;
                    ga[m][bj] = *(const u32x4*)(gs + p); gb[m][bj] = last ? ga[m][bj] : *(const u32x4*)(gs + gseg + p); }
#pragma unroll
            for (int m = 0; m < 4; ++m)
#pragma unroll
                for (int bj = 0; bj < 2; ++bj) { const u32x4 a = ga[m][bj], b = gb[m][bj];
                    float f[8] = {bf_lo(a.x), bf_hi(a.x), bf_lo(a.y), bf_hi(a.y), bf_lo(a.z), bf_hi(a.z), bf_lo(a.w), bf_hi(a.w)};
                    if (!last) { const float d[8] = {bf_lo(b.x), bf_hi(b.x), bf_lo(b.y), bf_hi(b.y), bf_lo(b.z), bf_hi(b.z), bf_lo(b.w), bf_hi(b.w)};
#pragma unroll
                        for (int j = 0; j < 8; ++j) f[j] *= __builtin_amdgcn_rcpf(fmaxf(d[j], 1e-20f)); }
                    f32x4 v0 = acc[ai][bj][m][0], v1 = acc[ai][bj][m][1];
                    v0[0] *= f[0]; v0[1] *= f[1]; v0[2] *= f[2]; v0[3] *= f[3]; v1[0] *= f[4]; v1[1] *= f[5]; v1[2] *= f[6]; v1[3] *= f[7];
                    acc[ai][bj][m][0] = v0; acc[ai][bj][m][1] = v1;
                    if (last) { u32x4 w; w.x = cvt_pk_bf16(v0[0], v0[1]); w.y = cvt_pk_bf16(v0[2], v0[3]); w.z = cvt_pk_bf16(v1[0], v1[1]); w.w = cvt_pk_bf16(v1[2], v1[3]);
                        *(u32x4*)(outb + blk_off(row0 + ai * HALF + m * 16, col0 + bj * HALF, ldc)) = w; } } }
        return last;
    }
};

template <class Epi, class Sched, bool ALIGN_EPI = false, bool SP2 = false, bool F8 = false>
__device__ __forceinline__ void gemm_phase(PG8_LAS unsigned char* lds, const Gemm g, const Sched& S, const Epi& E) {
    int tid_o = threadIdx.x; asm volatile("" : "+v"(tid_o));
    const int tid = tid_o, wid = __builtin_amdgcn_readfirstlane(tid >> 6), lane = tid & 63, wr = wid >> 2, wc = wid & 3, fr = lane & 15, fq = lane >> 4;
    const int K = g.K, nt = K / BK;
    unsigned voffA[2], voffB[2];
#pragma unroll
    for (int i = 0; i < 2; ++i) { int R, C; stage_rc(tid * 16 + i * 8192, R, C); const int Rb = Epi::PERM ? ((R & ~31) + perm32(R & 31)) : R;
        voffA[i] = (unsigned)((R >> 6) * (K >> 6) * 4096 + (R & 63) * 64 + C) * 2u; voffB[i] = (unsigned)((Rb >> 6) * (K >> 6) * 4096 + (Rb & 63) * 64 + C) * 2u; }
    const size_t kstep = (size_t)8192;
    const size_t hstep = (size_t)2 * (K >> 6) * 8192;
    const size_t tstep = 2 * hstep;
    const unsigned ldsu = (unsigned)(size_t)lds;
    const unsigned ldsw = (unsigned)wid * 1024u;
    const int aoff = lds_byte(wr * 64 + fr, fq * 8), boff = lds_byte(wc * 32 + fr, fq * 8);
#define PG8_SA(b, h) (((b) * 2 + (h)) * HTB)
#define PG8_SB(b, h) ((4 + (b) * 2 + (h)) * HTB)
#define PG8_STAGE(bufoff, gbase, voff) do { _Pragma("unroll") for (int _i = 0; _i < 2; ++_i) { \
        if constexpr (F8) { const unsigned m0v_ = ldsu + (unsigned)(bufoff) + ldsw + (unsigned)_i * 8192u; const char* gb_ = (const char*)(gbase); \
            asm volatile("s_mov_b32 m0, %0\n\ts_nop 0\n\tglobal_load_lds_dwordx4 %1, %2" :: "s"(m0v_), "v"((voff)[_i]), "s"(gb_) : "memory", "m0"); } \
        else __builtin_amdgcn_global_load_lds((const unsigned*)((const char*)(gbase) + (voff)[_i]), (PG8_LAS unsigned*)(lds + (bufoff) + ldsw + _i * 8192), 16, 0, 0); } } while (0)
#define PG8_LDA(dst, b, h) do { if constexpr (F8) { _Pragma("unroll") for (int m = 0; m < 4; ++m) { dst##8[m].lo = *(const PG8_LAS i32x4*)(lds + PG8_SA(b, h) + aoff + m * 2048); dst##8[m].hi = *(const PG8_LAS i32x4*)(lds + PG8_SA(b, h) + aoff + m * 2048 + 1024); } } \
    else { _Pragma("unroll") for (int m = 0; m < 4; ++m) _Pragma("unroll") for (int k = 0; k < 2; ++k) dst[m][k] = *(const PG8_LAS bf16x8*)(lds + PG8_SA(b, h) + aoff + m * 2048 + k * 1024); } } while (0)
#define PG8_LDB(dst, b, h) do { if constexpr (F8) { _Pragma("unroll") for (int n = 0; n < 2; ++n) { dst##8[n].lo = *(const PG8_LAS i32x4*)(lds + PG8_SB(b, h) + boff + n * 2048); dst##8[n].hi = *(const PG8_LAS i32x4*)(lds + PG8_SB(b, h) + boff + n * 2048 + 1024); } } \
    else { _Pragma("unroll") for (int n = 0; n < 2; ++n) _Pragma("unroll") for (int k = 0; k < 2; ++k) dst[n][k] = *(const PG8_LAS bf16x8*)(lds + PG8_SB(b, h) + boff + n * 2048 + k * 1024); } } while (0)
#define PG8_MMA(ai, bj, At, Bt) do { __builtin_amdgcn_s_setprio(1); if constexpr (F8) { _Pragma("unroll") for (int m = 0; m < 4; ++m) _Pragma("unroll") for (int n = 0; n < 2; ++n) \
        acc[ai][bj][m][n] = __builtin_amdgcn_mfma_scale_f32_16x16x128_f8f6f4(Bt##8[n], At##8[m], acc[ai][bj][m][n], 0, 0, 0, 0x7f7f7f7f, 0, 0x7f7f7f7f); } \
    else { _Pragma("unroll") for (int m = 0; m < 4; ++m) _Pragma("unroll") for (int n = 0; n < 2; ++n) _Pragma("unroll") for (int k = 0; k < 2; ++k) \
        acc[ai][bj][m][n] = __builtin_amdgcn_mfma_f32_16x16x32_bf16(Bt[n][k], At[m][k], acc[ai][bj][m][n], 0, 0, 0); } __builtin_amdgcn_s_setprio(0); } while (0)
#define PG8_WAIT_V(n) asm volatile("s_waitcnt vmcnt(" #n ")" ::: "memory")
#define PG8_WAIT_L(n) asm volatile("s_waitcnt lgkmcnt(" #n ")" ::: "memory")
#define PG8_BAR __builtin_amdgcn_s_barrier()
#define PG8_SCHED __builtin_amdgcn_sched_barrier(0)
    Unit cur, nxt; int ui = 0;
    if (!S.next(0, cur)) return;
    f32x4 acc[2][2][4][2];
#pragma unroll
    for (int a = 0; a < 2; ++a)
#pragma unroll
        for (int b = 0; b < 2; ++b)
#pragma unroll
            for (int m = 0; m < 4; ++m)
#pragma unroll
                for (int n = 0; n < 2; ++n) acc[a][b][m][n] = (f32x4){0.f, 0.f, 0.f, 0.f};
    bf16x8 At[4][2], B0[2][2], B1[2][2]; i32x8 At8[4], B08[2], B18[2];
    const char* cA = (const char*)g.A + (size_t)cur.pm * tstep + (size_t)cur.seg * g.segA; const char* cB = (const char*)g.Bt + (size_t)cur.pn * tstep + (size_t)cur.seg * g.segB;
    S.a_ready(cur);
    if constexpr (SP2) {
        PG8_STAGE(PG8_SB(0, 0), cB, voffB); PG8_STAGE(PG8_SB(0, 1), cB + hstep, voffB); PG8_STAGE(PG8_SA(0, 0), cA, voffA); PG8_STAGE(PG8_SA(0, 1), cA + hstep, voffA);
        if (wr == 1) PG8_BAR;
        PG8_WAIT_V(2); PG8_BAR;
        PG8_STAGE(PG8_SB(1, 0), cB + kstep, voffB); PG8_STAGE(PG8_SA(1, 0), cA + kstep, voffA); PG8_STAGE(PG8_SB(1, 1), cB + hstep + kstep, voffB);
        PG8_WAIT_V(6); PG8_BAR;
    } else {
        PG8_STAGE(PG8_SB(0, 0), cB, voffB); PG8_STAGE(PG8_SA(0, 0), cA, voffA); PG8_STAGE(PG8_SB(0, 1), cB + hstep, voffB); PG8_STAGE(PG8_SA(0, 1), cA + hstep, voffA);
        if (wr == 1) PG8_BAR;
        PG8_WAIT_V(4); PG8_BAR;
        PG8_STAGE(PG8_SB(1, 0), cB + kstep, voffB); PG8_STAGE(PG8_SA(1, 0), cA + kstep, voffA); PG8_STAGE(PG8_SB(1, 1), cB + hstep + kstep, voffB);
        PG8_WAIT_V(6); PG8_BAR;
    }
    for (;;) {
        const bool has_next = S.next(ui + 1, nxt);
        const char* nA = has_next ? (const char*)g.A + (size_t)nxt.pm * tstep + (size_t)nxt.seg * g.segA : cA; const char* nB = has_next ? (const char*)g.Bt + (size_t)nxt.pn * tstep + (size_t)nxt.seg * g.segB : cB;
        for (int t = 0; t < nt; t += 2) {
            const bool last = (t == nt - 2);
            const char* a1 = cA + (size_t)(t + 1) * kstep;
            const char* a2 = last ? nA : cA + (size_t)(t + 2) * kstep; const char* b2 = last ? nB : cB + (size_t)(t + 2) * kstep;
            const char* a3 = a2 + kstep; const char* b3 = b2 + kstep;
            if (last && has_next) S.a_ready(nxt);
            if constexpr (SP2) {
            PG8_LDB(B0, 0, 0); PG8_LDB(B1, 0, 1); PG8_SCHED; PG8_LDA(At, 0, 0); PG8_STAGE(PG8_SA(1, 1), a1 + hstep, voffA);
            PG8_WAIT_V(8); PG8_WAIT_L(0); PG8_BAR; PG8_MMA(0, 0, At, B0); PG8_MMA(0, 1, At, B1); PG8_BAR; PG8_SCHED;
            PG8_LDA(At, 0, 1); PG8_STAGE(PG8_SB(0, 0), b2, voffB); PG8_STAGE(PG8_SB(0, 1), b2 + hstep, voffB); PG8_STAGE(PG8_SA(0, 0), a2, voffA);
            PG8_WAIT_V(8); PG8_WAIT_L(0); PG8_BAR; PG8_MMA(1, 0, At, B0); PG8_MMA(1, 1, At, B1); PG8_BAR; PG8_SCHED;
            PG8_LDB(B0, 1, 0); PG8_LDB(B1, 1, 1); PG8_SCHED; PG8_LDA(At, 1, 0); PG8_STAGE(PG8_SA(0, 1), a2 + hstep, voffA);
            PG8_WAIT_V(8); PG8_WAIT_L(0); PG8_BAR; PG8_MMA(0, 0, At, B0); PG8_MMA(0, 1, At, B1); PG8_BAR; PG8_SCHED;
            PG8_LDA(At, 1, 1); PG8_STAGE(PG8_SB(1, 0), b3, voffB); PG8_STAGE(PG8_SB(1, 1), b3 + hstep, voffB); PG8_STAGE(PG8_SA(1, 0), a3, voffA);
            PG8_WAIT_V(8); PG8_WAIT_L(0); PG8_BAR; PG8_MMA(1, 0, At, B0); PG8_MMA(1, 1, At, B1); PG8_BAR; PG8_SCHED;
            } else {
            PG8_LDB(B0, 0, 0); PG8_SCHED; PG8_LDA(At, 0, 0); PG8_STAGE(PG8_SA(1, 1), a1 + hstep, voffA);
            PG8_WAIT_L(8); PG8_BAR; PG8_WAIT_L(0); PG8_MMA(0, 0, At, B0); PG8_BAR; PG8_SCHED;
            PG8_LDB(B1, 0, 1); PG8_STAGE(PG8_SB(0, 0), b2, voffB);
            PG8_BAR; PG8_WAIT_L(0); PG8_MMA(0, 1, At, B1); PG8_BAR;
            PG8_LDA(At, 0, 1); PG8_STAGE(PG8_SA(0, 0), a2, voffA);
            PG8_BAR; PG8_WAIT_L(0); PG8_MMA(1, 0, At, B0); PG8_BAR; PG8_SCHED;
            PG8_STAGE(PG8_SB(0, 1), b2 + hstep, voffB);
            PG8_WAIT_V(6); PG8_BAR; PG8_MMA(1, 1, At, B1); PG8_BAR;
            PG8_LDB(B0, 1, 0); PG8_SCHED; PG8_LDA(At, 1, 0); PG8_STAGE(PG8_SA(0, 1), a2 + hstep, voffA);
            PG8_WAIT_L(8); PG8_BAR; PG8_WAIT_L(0); PG8_MMA(0, 0, At, B0); PG8_BAR; PG8_SCHED;
            PG8_LDB(B1, 1, 1); PG8_STAGE(PG8_SB(1, 0), b3, voffB);
            PG8_BAR; PG8_WAIT_L(0); PG8_MMA(0, 1, At, B1); PG8_BAR;
            PG8_LDA(At, 1, 1); PG8_STAGE(PG8_SA(1, 0), a3, voffA);
            PG8_BAR; PG8_WAIT_L(0); PG8_MMA(1, 0, At, B0); PG8_BAR; PG8_SCHED;
            PG8_STAGE(PG8_SB(1, 1), b3 + hstep, voffB);
            PG8_WAIT_V(6); PG8_BAR; PG8_MMA(1, 1, At, B1); PG8_BAR;
            }
        }
        if constexpr (ALIGN_EPI) { if (wr == 0) PG8_BAR; }
        bool zero_acc = true;
        if constexpr (Epi::SEGMENTED) { zero_acc = E.run(acc, cur, wr, wc, fr, fq); S.done(cur); }
        else if constexpr (!Epi::AFTER_DRAIN) {
            if constexpr (F8) { int t2 = threadIdx.x; asm volatile("" : "+v"(t2));
                const int w2 = __builtin_amdgcn_readfirstlane(t2 >> 6); E(acc, cur, w2 >> 2, w2 & 3, t2 & 15, (t2 & 63) >> 4); }
            else E(acc, cur, wr, wc, fr, fq);
            S.done(cur); }
        if (!has_next) break;
        if (zero_acc) {
#pragma unroll
        for (int a = 0; a < 2; ++a)
#pragma unroll
            for (int b = 0; b < 2; ++b)
#pragma unroll
                for (int m = 0; m < 4; ++m)
#pragma unroll
                    for (int n = 0; n < 2; ++n) acc[a][b][m][n] = (f32x4){0.f, 0.f, 0.f, 0.f};
        }
        cur = nxt; cA = nA; cB = nB; ++ui;
        if constexpr (ALIGN_EPI) { if (wr == 1) PG8_BAR; }
    }
    PG8_WAIT_V(0);
    if constexpr (!ALIGN_EPI) { if (wr == 0) PG8_BAR; }
    PG8_BAR;
    if constexpr (Epi::AFTER_DRAIN) { E.fused(acc, cur, wr, wc, fr, fq, lds, wid, lane); S.done(cur); }
#undef PG8_SA
#undef PG8_SB
#undef PG8_STAGE
#undef PG8_LDA
#undef PG8_LDB
#undef PG8_MMA
#undef PG8_WAIT_V
#undef PG8_WAIT_L
#undef PG8_BAR
#undef PG8_SCHED
}
}

constexpr int NWAVES = 8;
constexpr int NB = 4, SEQ = 2048, NTOK = NB * SEQ, DM = 2048, DEPTH = 4;
constexpr int DFF = 5632, NWI = 2 * DFF;
constexpr int NPROJ_SRC = 10512, NPROJ = 10752;
constexpr int C_QA = 0, C_KA = 768, C_VA = 1024, C_PU = 1280, C_QG = 2048, C_KG = 2432, C_VG = 2816, C_OG = 3584, C_LR = 4352, C_GATE = 4608;
constexpr int GATE_TILE0 = C_GATE / 256;
constexpr int BRW = 768;
constexpr float EPS = 1e-6f;

constexpr size_t MiB = 1u << 20;
constexpr size_t WS_CTL = 0, CTL_ZERO_BYTES = 1 * MiB;
constexpr size_t SZ_WI = (size_t)NWI * DM * 2, SZ_WO = (size_t)DM * DFF * 2, SZ_WIN = (size_t)NPROJ * DM * 2, SZ_WBR = (size_t)3 * DM * BRW * 2, SZ_WOUT = (size_t)DM * DM * 2;
constexpr size_t LW_WI1 = 0, LW_WO1 = LW_WI1 + SZ_WI, LW_WIN = LW_WO1 + SZ_WO, LW_WBR = LW_WIN + SZ_WIN, LW_WOUT = LW_WBR + SZ_WBR, LW_WI2 = LW_WOUT + SZ_WOUT, LW_WO2 = LW_WI2 + SZ_WI, LW_END = LW_WO2 + SZ_WO;
constexpr size_t WS_W = 2 * MiB;
constexpr size_t WS_X = ((WS_W + DEPTH * LW_END + MiB - 1) / MiB) * MiB;
constexpr size_t WS_H = WS_X + (size_t)NTOK * DM * 4;
constexpr size_t WS_ACT = WS_H + (size_t)NTOK * DM * 2;
constexpr size_t WS_PROJ = WS_ACT + (size_t)NTOK * DFF * 2;
constexpr size_t WS_Y = WS_PROJ + (size_t)NTOK * NPROJ * 2;
constexpr size_t WS_MACC = WS_Y + (size_t)3 * NTOK * BRW * 2;
constexpr size_t WS_MB = WS_MACC + (size_t)NTOK * DM * 4;
constexpr size_t WS_GO = WS_MB + (size_t)NTOK * DM * 2;
constexpr size_t WS_ROPE = WS_GO + (size_t)NTOK * BRW * 4;
constexpr size_t WS_GPRE = WS_ROPE + (size_t)2 * NTOK * 32 * 4;
constexpr size_t WS_WPT = WS_GPRE + (size_t)512 * 57856;
constexpr size_t WS_END = WS_WPT + (size_t)DEPTH * 4 * 192 * 192 * 2;
constexpr int CW_BAR = 4096;
constexpr size_t CTL_SSQ = 65536; static_assert(CTL_SSQ + (size_t)13 * 8192 * 8 <= CTL_ZERO_BYTES, "SSQ inside the zeroed CTL region");

constexpr int RING_OFF = 0, RING_BYTES = 131072;
constexpr int LDSCTL_OFF = RING_BYTES, MISC_OFF = LDSCTL_OFF + 320;
constexpr int LDS_BYTES = 147456;

#define GAS __attribute__((address_space(1)))
#define LAS __attribute__((address_space(3)))
typedef unsigned short bf16;
typedef unsigned v4u __attribute__((ext_vector_type(4)));
typedef float f32x4 __attribute__((ext_vector_type(4)));
#define LDS_WAIT() asm volatile("s_waitcnt lgkmcnt(0)" ::: "memory")
__device__ __forceinline__ unsigned f2bf(float f) { unsigned u = __builtin_bit_cast(unsigned, f); return (u + 0x7fffu + ((u >> 16) & 1u)) >> 16; }
__device__ __forceinline__ unsigned pk2(float lo, float hi) { return f2bf(lo) | (f2bf(hi) << 16); }
__device__ __forceinline__ float bf2f(bf16 b) { return __uint_as_float(((unsigned)b) << 16); }
__device__ __forceinline__ float bflo(unsigned w) { return __uint_as_float(w << 16); }
__device__ __forceinline__ float bfhi(unsigned w) { return __uint_as_float(w & 0xffff0000u); }
__device__ __forceinline__ float wave_sum(float v) {
#pragma unroll
    for (int o = 1; o < 64; o <<= 1) v += __shfl_xor(v, o);
    return v;
}

#define XB_TMO      128
#define XB_XCNT(j)  (256  + 64 * (j))
#define XB_XSUB(j)  (1280 + 64 * (j))
#define XB_XGEN(j)  (2304 + 64 * (j))
#define XB_TOP      3328
#define XB_TOPGEN   3392
#define XCD_BAR_WORDS 3456
#define XB_SPIN_CAP (1u << 18)

__device__ __forceinline__ unsigned xb_ld(unsigned* p)              { return __hip_atomic_load(p, __ATOMIC_RELAXED, __HIP_MEMORY_SCOPE_AGENT); }
__device__ __forceinline__ unsigned xb_add(unsigned* p, unsigned v) { return __hip_atomic_fetch_add(p, v, __ATOMIC_RELAXED, __HIP_MEMORY_SCOPE_AGENT); }
__device__ __forceinline__ unsigned xb_xcc_id() { return (unsigned)__builtin_amdgcn_s_getreg((3 << 11) | 20) & 0xFu; }
#define XB_SPIN(cond, bar) do { unsigned _sp = 0; while (cond) { __builtin_amdgcn_s_sleep(1); \
    if ((++_sp & 255u) == 0u) { if (xb_ld(&(bar)[XB_TMO])) break; if (_sp > XB_SPIN_CAP) { atomicAdd(&(bar)[XB_TMO], 1u); break; } } } } while (0)

struct XcdBarrier {
    unsigned* bar; unsigned x;
    volatile LAS unsigned* st;
};

__device__ __forceinline__ XcdBarrier xcd_barrier_post(unsigned* bar, volatile LAS unsigned* st) {
    XcdBarrier b; b.bar = bar; b.x = xb_xcc_id(); b.st = st;
    if (threadIdx.x == 0) (void)xb_add(&bar[XB_XCNT(b.x)], 1u);
    return b;
}
__device__ __forceinline__ void xcd_barrier_complete(unsigned* bar, unsigned x, unsigned& nloc, unsigned& nx) {
    const unsigned G = gridDim.x * gridDim.y * gridDim.z;
    unsigned sum, cnt, mine, sp = 0u;
    for (;;) {
        sum = 0u; cnt = 0u; mine = 0u;
#pragma unroll
        for (unsigned j = 0; j < 16; ++j) { const unsigned c = xb_ld(&bar[XB_XCNT(j)]); sum += c; cnt += (c > 0u) ? 1u : 0u; mine = (j == x) ? c : mine; }
        if (sum == G) break;
        __builtin_amdgcn_s_sleep(1);
        if ((++sp & 255u) == 0u) { if (xb_ld(&bar[XB_TMO])) break; if (sp > XB_SPIN_CAP) { atomicAdd(&bar[XB_TMO], 1u); break; } }
    }
    nloc = mine > 0u ? mine : 1u; nx = cnt > 0u ? cnt : 1u;
}

__device__ __forceinline__ void xcd_barrier(const XcdBarrier& b) {
    asm volatile("s_waitcnt vmcnt(0)" ::: "memory");
    __syncthreads();
    if (threadIdx.x == 0) {
        unsigned* bar = b.bar; const unsigned bx_ = xb_xcc_id();
        __builtin_amdgcn_s_waitcnt(0);
        unsigned nloc = b.st[0], nx = b.st[1];
        if (nloc == 0u) { xcd_barrier_complete(bar, bx_, nloc, nx); b.st[0] = nloc; b.st[1] = nx; }
        const unsigned old = xb_add(&bar[XB_XSUB(bx_)], 1u);
        const unsigned gen = old / nloc;
        if (old + 1u == (gen + 1u) * nloc) {
            __builtin_amdgcn_fence(__ATOMIC_RELEASE, "agent");
            asm volatile("s_waitcnt vmcnt(0)" ::: "memory");
            const unsigned og = xb_add(&bar[XB_TOP], 1u);
            const unsigned tg = og / nx;
            if (og + 1u == (tg + 1u) * nx) xb_add(&bar[XB_TOPGEN], 1u);
            else XB_SPIN(xb_ld(&bar[XB_TOPGEN]) == tg, bar);
            __builtin_amdgcn_fence(__ATOMIC_ACQUIRE, "agent");
            xb_add(&bar[XB_XGEN(bx_)], 1u);
            asm volatile("s_waitcnt vmcnt(0)" ::: "memory");
        } else {
            XB_SPIN(xb_ld(&bar[XB_XGEN(bx_)]) == gen, bar);
            __builtin_amdgcn_fence(__ATOMIC_ACQUIRE, "agent");
            asm volatile("s_waitcnt vmcnt(0)" ::: "memory");
        }
    }
    __syncthreads();
}


template <int MAP> __device__ __forceinline__ int map_row(int n) {
    if (MAP == 1) { const int isb = n >= DFF ? 1 : 0; const int h = n - isb * DFF; return (h >> 7) * 256 + isb * 128 + (h & 127); }
    if (MAP == 2) return n < 4368 ? n : n + 240;
    return n;
}
struct TrJob { const float* W; bf16* WT; const float* gain; int K, N, map; };
constexpr int GATE_SRC0 = 4368;
constexpr size_t WIN8_OFF = (size_t)C_GATE * DM * 2;
__device__ __forceinline__ int map_row_rt(int map, int n) { return map == 1 ? map_row<1>(n) : (map == 2 ? map_row<2>(n) : n); }
__device__ __forceinline__ void tr_load(const TrJob& jb, int tile, int tid, f32x4 (&v)[8][2], int& k0, int& n0) {
    const int nblk = (jb.N + 127) / 128, kt = tile / nblk, nt = tile - kt * nblk; k0 = 256 * kt; n0 = 128 * nt;
    const int c4 = (tid & 15) + 16 * ((tid >> 6) & 1), rp = ((tid >> 4) & 3) + 4 * (tid >> 7);
    int col = n0 + 4 * c4; col = col < jb.N - 4 ? col : jb.N - 4;
    const float* wp = jb.W + (size_t)(k0 + 2 * rp) * jb.N + col;
#pragma unroll
    for (int i = 0; i < 8; ++i) { v[i][0] = *(const f32x4*)(wp + (size_t)(32 * i) * jb.N); v[i][1] = *(const f32x4*)(wp + (size_t)(32 * i + 1) * jb.N); }
    if (jb.gain) {
#pragma unroll
        for (int i = 0; i < 8; ++i) { const float ga = jb.gain[k0 + 32 * i + 2 * rp], gb = jb.gain[k0 + 32 * i + 2 * rp + 1]; v[i][0] = v[i][0] * ga; v[i][1] = v[i][1] * gb; } }
}
__device__ __forceinline__ void tr_to_lds(LAS unsigned* T, int tid, const f32x4 (&v)[8][2]) {
    const int c4 = (tid & 15) + 16 * ((tid >> 6) & 1), rp = ((tid >> 4) & 3) + 4 * (tid >> 7);
#pragma unroll
    for (int i = 0; i < 8; ++i)
#pragma unroll
        for (int j = 0; j < 4; ++j) T[(4 * c4 + j) * 132 + 16 * i + rp] = pk2(v[i][0][j], v[i][1][j]);
}
__device__ __forceinline__ void tr_store(const TrJob& jb, const LAS unsigned* T, int tid, int k0, int n0) {
    const int w = tid >> 6, lane = tid & 63, c = 8 * (w >> 1) + (lane & 7), nb = 64 * (w & 1) + (lane >> 3);
#pragma unroll
    for (int j = 0; j < 8; ++j) { const int n = nb + 8 * j; const v4u o = *(const LAS v4u*)(T + n * 132 + 4 * c);
        if (n0 + n < jb.N) {
            if (jb.map == 2 && n0 + n >= GATE_SRC0) {
                typedef unsigned v2u_ __attribute__((ext_vector_type(2))); v2u_ q;
                q.x = pg8::cvt_pk4_fp8(bflo(o.x) * 256.f, bfhi(o.x) * 256.f, bflo(o.y) * 256.f, bfhi(o.y) * 256.f); q.y = pg8::cvt_pk4_fp8(bflo(o.z) * 256.f, bfhi(o.z) * 256.f, bflo(o.w) * 256.f, bfhi(o.w) * 256.f);
                *(v2u_*)((unsigned char*)jb.WT + WIN8_OFF + pg8::blk8_off(n0 + n - GATE_SRC0, k0 + 8 * c, jb.K)) = q; }
            else *(v4u*)(jb.WT + pg8::blk_off(map_row_rt(jb.map, n0 + n), k0 + 8 * c, jb.K)) = o; } }
}

struct Args { const void* in[22]; float* out; unsigned char* ws; };

constexpr int TL_WI1 = 0, TL_WO1 = 704, TL_WIN = 1056, TL_BRA = 1720, TL_BRP = 1768, TL_BRG = 1816, TL_WOUT = 1864, TL_WI2 = 1992, TL_WO2 = 2696, TL_LAYER = 3048, TL_ALL = DEPTH * TL_LAYER;
constexpr int CW_CLAIM = 8192;
__device__ __forceinline__ void conv_job(const Args& A, int T, TrJob& jb, int& t) {
    const int l = T / TL_LAYER, r = T - l * TL_LAYER;
    unsigned char* wl = A.ws + WS_W + (size_t)l * LW_END;
    if (r < TL_WO1)       { jb = TrJob{(const float*)A.in[3] + (size_t)l * DM * NWI, (bf16*)(wl + LW_WI1), (const float*)A.in[2] + (size_t)l * DM, DM, NWI, 1}; t = r; }
    else if (r < TL_WIN)  { jb = TrJob{(const float*)A.in[4] + (size_t)l * DFF * DM, (bf16*)(wl + LW_WO1), nullptr, DFF, DM, 0}; t = r - TL_WO1; }
    else if (r < TL_BRA)  { jb = TrJob{(const float*)A.in[6] + (size_t)l * DM * NPROJ_SRC, (bf16*)(wl + LW_WIN), (const float*)A.in[5] + (size_t)l * DM, DM, NPROJ_SRC, 2}; t = r - TL_WIN; }
    else if (r < TL_BRP)  { jb = TrJob{(const float*)A.in[14] + (size_t)l * BRW * DM, (bf16*)(wl + LW_WBR), nullptr, BRW, DM, 0}; t = r - TL_BRA; }
    else if (r < TL_BRG)  { jb = TrJob{(const float*)A.in[15] + (size_t)l * BRW * DM, (bf16*)(wl + LW_WBR) + (size_t)DM * BRW, nullptr, BRW, DM, 0}; t = r - TL_BRP; }
    else if (r < TL_WOUT) { jb = TrJob{(const float*)A.in[16] + (size_t)l * BRW * DM, (bf16*)(wl + LW_WBR) + (size_t)2 * DM * BRW, nullptr, BRW, DM, 0}; t = r - TL_BRG; }
    else if (r < TL_WI2)  { jb = TrJob{(const float*)A.in[17] + (size_t)l * DM * DM, (bf16*)(wl + LW_WOUT), nullptr, DM, DM, 0}; t = r - TL_WOUT; }
    else if (r < TL_WO2)  { jb = TrJob{(const float*)A.in[19] + (size_t)l * DM * NWI, (bf16*)(wl + LW_WI2), (const float*)A.in[18] + (size_t)l * DM, DM, NWI, 1}; t = r - TL_WI2; }
    else                  { jb = TrJob{(const float*)A.in[20] + (size_t)l * DFF * DM, (bf16*)(wl + LW_WO2), nullptr, DFF, DM, 0}; t = r - TL_WO2; }
}
__device__ __forceinline__ unsigned conv_claim(unsigned* ctr, volatile LAS unsigned* slot, int limit, int extra, unsigned known, bool peek) {
    if (peek) known = __hip_atomic_load(ctr, __ATOMIC_RELAXED, __HIP_MEMORY_SCOPE_AGENT);
    const bool need = (int)known < limit, opt = !need && extra > 0 && (int)known < TL_ALL;
    unsigned T = 0xffffffffu;
    if (need || opt) { T = __hip_atomic_fetch_add(ctr, 1u, __ATOMIC_RELAXED, __HIP_MEMORY_SCOPE_AGENT); known = T + 1u; if ((int)T >= TL_ALL) T = 0xffffffffu; }
    slot[0] = T; slot[1] = need ? 0u : 1u;
    return known;
}
__device__ __forceinline__ void conv_until(const Args& A, LAS unsigned char* lds, int limit, int extra) {
    unsigned* ctr = (unsigned*)(A.ws + WS_CTL) + CW_CLAIM; volatile LAS unsigned* slot = (volatile LAS unsigned*)(lds + MISC_OFF) + 16;
    LAS unsigned* Tl = (LAS unsigned*)(lds + RING_OFF);
    if (limit > TL_ALL) limit = TL_ALL;
    int tid = threadIdx.x; asm volatile("" : "+v"(tid));
    unsigned known = 0u;
    if (tid == 0) known = conv_claim(ctr, slot, limit, extra, 0u, true);
    __syncthreads();
    unsigned T = slot[0]; if (slot[1]) --extra;
    __syncthreads();
    if (T == 0xffffffffu) return;
    f32x4 v[8][2]; TrJob jb; int t, k0, n0;
    conv_job(A, (int)T, jb, t); tr_load(jb, t, tid, v, k0, n0);
#pragma unroll 1
    for (;;) {
        tr_to_lds(Tl, tid, v);
        if (tid == 0) known = conv_claim(ctr, slot, limit, extra, known, false);
        __syncthreads();
        const unsigned Tn = slot[0]; if (slot[1]) --extra;
        const TrJob cj = jb; const int ck0 = k0, cn0 = n0;
        if (Tn != 0xffffffffu) { conv_job(A, (int)Tn, jb, t); tr_load(jb, t, tid, v, k0, n0); }
        tr_store(cj, Tl, tid, ck0, cn0);
        __syncthreads();
        if (Tn == 0xffffffffu) break;
    }
}

__device__ __forceinline__ void p0_prologue(const Args& A, LAS unsigned char* lds, int gw, int NGW, int wave, int lane) {
    for (int i = gw * 64 + lane; i < DEPTH * 240 * DM / 8; i += NGW * 64) { const int l = i / (240 * DM / 8), j = i - l * (240 * DM / 8);
        *(v4u*)((bf16*)(A.ws + WS_W + (size_t)l * LW_END + LW_WIN) + pg8::blk_off(4368 + (j >> 8), 8 * (j & 255), DM)) = (v4u){0u, 0u, 0u, 0u}; }
    { const float* x = (const float*)A.in[0]; bf16* XB = (bf16*)(A.ws + WS_H); unsigned long long* ssq0 = (unsigned long long*)(A.ws + WS_CTL + CTL_SSQ);
      for (int r = gw; r < NTOK; r += NGW) { const f32x4* xr = (const f32x4*)(x + (size_t)r * DM); float sq = 0.f;
#pragma unroll
          for (int j = 0; j < 4; ++j) { const f32x4 a = xr[j * 128 + lane * 2], b = xr[j * 128 + lane * 2 + 1];
              sq += (a.x * a.x + a.y * a.y) + (a.z * a.z + a.w * a.w) + (b.x * b.x + b.y * b.y) + (b.z * b.z + b.w * b.w);
              v4u o; o.x = pk2(a.x, a.y); o.y = pk2(a.z, a.w); o.z = pk2(b.x, b.y); o.w = pk2(b.z, b.w);
              *(v4u*)(XB + pg8::blk_off(r, j * 512 + lane * 8, DM)) = o; }
          sq = wave_sum(sq); if (lane == 0) ssq0[r] = (unsigned long long)(sq * 1048576.0f + 0.5f); } }
    { const float* wp = (const float*)A.in[9]; const float* ps = (const float*)A.in[10]; bf16* wpt = (bf16*)(A.ws + WS_WPT);
      for (int i = gw * 64 + lane; i < DEPTH * 4 * 192 * 192; i += NGW * 64) { const int cc = i % 192, d = (i / 192) % 192, lg = i / (192 * 192);
          wpt[i] = (bf16)f2bf(wp[((size_t)lg * 192 + cc) * 192 + d] * ps[lg * 192 + d]); } }
    const int* pos = (const int*)A.in[1];
    float* cs = (float*)(A.ws + WS_ROPE); float* sn = cs + (size_t)NTOK * 32;
    for (int i = gw * 64 + lane; i < NTOK * 32; i += NGW * 64) { const int t = i >> 5, f = i & 31;
        const double inv = exp(-(double)f * (9.210340371976184 / 32.0));
        const double ang = (double)pos[t] * inv; cs[i] = (float)cos(ang); sn[i] = (float)sin(ang); }
}

__device__ __forceinline__ void rmsnorm_phase(const float* X, const float* g, bf16* H, int gw, int NGW, int lane) {
    asm volatile("" : "+v"(lane));
    for (int r = gw; r < NTOK; r += NGW) {
        const f32x4* xr = (const f32x4*)(X + (size_t)r * DM);
        f32x4 v[8]; float s = 0.f;
#pragma unroll
        for (int j = 0; j < 4; ++j) { v[2 * j] = xr[j * 128 + lane * 2]; v[2 * j + 1] = xr[j * 128 + lane * 2 + 1]; }
#pragma unroll
        for (int j = 0; j < 8; ++j) s += (v[j].x * v[j].x + v[j].y * v[j].y) + (v[j].z * v[j].z + v[j].w * v[j].w);
        const float rstd = 1.0f / sqrtf(wave_sum(s) * (1.0f / DM) + EPS);
#pragma unroll
        for (int j = 0; j < 4; ++j) { const f32x4 g0 = ((const f32x4*)g)[j * 128 + lane * 2], g1 = ((const f32x4*)g)[j * 128 + lane * 2 + 1];
            const f32x4 a = v[2 * j] * rstd * g0, b = v[2 * j + 1] * rstd * g1;
            v4u o; o.x = pk2(a.x, a.y); o.y = pk2(a.z, a.w); o.z = pk2(b.x, b.y); o.w = pk2(b.z, b.w);
            *(v4u*)(H + (size_t)r * DM + j * 512 + lane * 8) = o; }
    }
}
__device__ __forceinline__ void final_phase(const bf16* XB, const unsigned long long* ssq, const float* g, float* out, int gw, int NGW, int lane) {
    asm volatile("" : "+v"(lane));
    for (int r = gw; r < NTOK; r += NGW) {
        const float rstd = pg8::rstd_of(ssq[r]);
#pragma unroll
        for (int j = 0; j < 4; ++j) { const int c0 = j * 512 + lane * 8; const v4u x = *(const v4u*)(XB + pg8::blk_off(r, c0, DM));
            const f32x4 g0 = *(const f32x4*)(g + c0), g1 = *(const f32x4*)(g + c0 + 4);
            *(f32x4*)(out + (size_t)r * DM + c0) = (f32x4){bflo(x.x), bfhi(x.x), bflo(x.y), bfhi(x.y)} * rstd * g0;
            *(f32x4*)(out + (size_t)r * DM + c0 + 4) = (f32x4){bflo(x.z), bfhi(x.z), bflo(x.w), bfhi(x.w)} * rstd * g1; }
    }
}

typedef short bf16x8_t __attribute__((ext_vector_type(8)));
typedef unsigned v2u __attribute__((ext_vector_type(2)));
__device__ __forceinline__ void att_unit(LAS unsigned char* lds, const bf16* PROJ, const float* COS, const float* SIN, const float* sinks, bf16* YA, int u) {
    int tid = threadIdx.x; asm volatile("" : "+v"(tid));
    const int b = u >> 6, kvh = (u >> 4) & 3, blk = u & 15;
    LAS bf16* Ks = (LAS bf16*)lds;
    LAS bf16* VT = Ks + 256 * 72;
    const int tok0 = b * SEQ + 128 * (blk - 1);
    const int kk0 = blk == 0 ? 128 : 0;
    for (int idx = tid; idx < 256 * 4; idx += 512) { const int kk = idx >> 2, c4 = idx & 3;
        v4u w1 = (v4u){0u, 0u, 0u, 0u}, w2 = w1;
        if (kk >= kk0) { const size_t t = (size_t)(tok0 + kk);
            const v4u lo = *(const v4u*)(PROJ + t * NPROJ + C_KA + kvh * 64 + 8 * c4), hi = *(const v4u*)(PROJ + t * NPROJ + C_KA + kvh * 64 + 32 + 8 * c4);
            const f32x4 c0 = *(const f32x4*)(COS + t * 32 + 8 * c4), c1 = *(const f32x4*)(COS + t * 32 + 8 * c4 + 4), s0 = *(const f32x4*)(SIN + t * 32 + 8 * c4), s1 = *(const f32x4*)(SIN + t * 32 + 8 * c4 + 4);
            const float x1[8] = {bflo(lo.x), bfhi(lo.x), bflo(lo.y), bfhi(lo.y), bflo(lo.z), bfhi(lo.z), bflo(lo.w), bfhi(lo.w)};
            const float x2[8] = {bflo(hi.x), bfhi(hi.x), bflo(hi.y), bfhi(hi.y), bflo(hi.z), bfhi(hi.z), bflo(hi.w), bfhi(hi.w)};
            const float cc[8] = {c0.x, c0.y, c0.z, c0.w, c1.x, c1.y, c1.z, c1.w}, ss[8] = {s0.x, s0.y, s0.z, s0.w, s1.x, s1.y, s1.z, s1.w};
            float q1[8], q2[8];
#pragma unroll
            for (int j = 0; j < 8; ++j) { q1[j] = x1[j] * cc[j] - x2[j] * ss[j]; q2[j] = x2[j] * cc[j] + x1[j] * ss[j]; }
            w1.x = pk2(q1[0], q1[1]); w1.y = pk2(q1[2], q1[3]); w1.z = pk2(q1[4], q1[5]); w1.w = pk2(q1[6], q1[7]);
            w2.x = pk2(q2[0], q2[1]); w2.y = pk2(q2[2], q2[3]); w2.z = pk2(q2[4], q2[5]); w2.w = pk2(q2[6], q2[7]); }
        *(LAS v4u*)(Ks + kk * 72 + 8 * c4) = w1; *(LAS v4u*)(Ks + kk * 72 + 32 + 8 * c4) = w2; }
    for (int idx = tid; idx < 256 * 8; idx += 512) { const int ch = idx >> 8, kk = idx & 255;
        v4u w = (v4u){0u, 0u, 0u, 0u};
        if (kk >= kk0) w = *(const v4u*)(PROJ + (size_t)(tok0 + kk) * NPROJ + C_VA + kvh * 64 + ch * 8);
        LAS bf16* vp = VT + (ch * 8) * 264 + kk;
        vp[0 * 264] = (bf16)(w.x & 0xffffu); vp[1 * 264] = (bf16)(w.x >> 16); vp[2 * 264] = (bf16)(w.y & 0xffffu); vp[3 * 264] = (bf16)(w.y >> 16);
        vp[4 * 264] = (bf16)(w.z & 0xffffu); vp[5 * 264] = (bf16)(w.z >> 16); vp[6 * 264] = (bf16)(w.w & 0xffffu); vp[7 * 264] = (bf16)(w.w >> 16); }
    const int wave = __builtin_amdgcn_readfirstlane(tid >> 6), lane = tid & 63, g = lane >> 4, c = lane & 15;
    v4u qlo, qhi, nlo, nhi; f32x4 qc0, qc1, qs0, qs1, nc0, nc1, ns0, ns1;
#define ATT_LOADQ(LO, HI, C0, C1, S0, S1, ti_) do { const int id_ = 3 * wave + (ti_), hq_ = kvh * 3 + (id_ >> 3); const size_t t_ = (size_t)(b * SEQ + 128 * blk + 16 * (id_ & 7) + c); \
        LO = *(const v4u*)(PROJ + t_ * NPROJ + C_QA + hq_ * 64 + 8 * g); HI = *(const v4u*)(PROJ + t_ * NPROJ + C_QA + hq_ * 64 + 32 + 8 * g); \
        C0 = *(const f32x4*)(COS + t_ * 32 + 8 * g); C1 = *(const f32x4*)(COS + t_ * 32 + 8 * g + 4); S0 = *(const f32x4*)(SIN + t_ * 32 + 8 * g); S1 = *(const f32x4*)(SIN + t_ * 32 + 8 * g + 4); } while (0)
    ATT_LOADQ(qlo, qhi, qc0, qc1, qs0, qs1, 0);
    __syncthreads();
#pragma unroll 1
    for (int ti = 0; ti < 3; ++ti) {
        const int id = 3 * wave + ti, gq = id >> 3, qt = id & 7, hq = kvh * 3 + gq, qi = 16 * qt + c, kb0 = qt >> 1;
        const size_t t = (size_t)(b * SEQ + 128 * blk + qi);
        if (ti + 1 < 3) ATT_LOADQ(nlo, nhi, nc0, nc1, ns0, ns1, ti + 1);
        bf16x8_t qb[2];
        { const float x1[8] = {bflo(qlo.x), bfhi(qlo.x), bflo(qlo.y), bfhi(qlo.y), bflo(qlo.z), bfhi(qlo.z), bflo(qlo.w), bfhi(qlo.w)};
          const float x2[8] = {bflo(qhi.x), bfhi(qhi.x), bflo(qhi.y), bfhi(qhi.y), bflo(qhi.z), bfhi(qhi.z), bflo(qhi.w), bfhi(qhi.w)};
          const float cc[8] = {qc0.x, qc0.y, qc0.z, qc0.w, qc1.x, qc1.y, qc1.z, qc1.w}, ss[8] = {qs0.x, qs0.y, qs0.z, qs0.w, qs1.x, qs1.y, qs1.z, qs1.w};
          float q1[8], q2[8];
#pragma unroll
          for (int j = 0; j < 8; ++j) { q1[j] = (x1[j] * cc[j] - x2[j] * ss[j]) * 0.125f; q2[j] = (x2[j] * cc[j] + x1[j] * ss[j]) * 0.125f; }
          v4u w1, w2; w1.x = pk2(q1[0], q1[1]); w1.y = pk2(q1[2], q1[3]); w1.z = pk2(q1[4], q1[5]); w1.w = pk2(q1[6], q1[7]);
          w2.x = pk2(q2[0], q2[1]); w2.y = pk2(q2[2], q2[3]); w2.z = pk2(q2[4], q2[5]); w2.w = pk2(q2[6], q2[7]);
          qb[0] = __builtin_bit_cast(bf16x8_t, w1); qb[1] = __builtin_bit_cast(bf16x8_t, w2); }
        bf16x8_t kf[10][2];
#pragma unroll
        for (int kt = 0; kt < 10; ++kt)
#pragma unroll
            for (int ks = 0; ks < 2; ++ks) kf[kt][ks] = *(const LAS bf16x8_t*)(Ks + (32 * kb0 + 16 * kt + c) * 72 + 32 * ks + 8 * g);
        __builtin_amdgcn_sched_barrier(0);
        f32x4 st[10];
#pragma unroll
        for (int kt = 0; kt < 10; ++kt) { f32x4 acc = (f32x4){0.f, 0.f, 0.f, 0.f};
#pragma unroll
            for (int ks = 0; ks < 2; ++ks) acc = __builtin_amdgcn_mfma_f32_16x16x32_bf16(kf[kt][ks], qb[ks], acc, 0, 0, 0);
            st[kt] = acc; }
        v2u vlo[5][4], vhi[5][4];
#pragma unroll
        for (int ks = 0; ks < 5; ++ks)
#pragma unroll
            for (int dt = 0; dt < 4; ++dt) { const LAS bf16* vr = VT + (16 * dt + c) * 264 + 32 * (kb0 + ks) + 4 * g; vlo[ks][dt] = *(const LAS v2u*)vr; vhi[ks][dt] = *(const LAS v2u*)(vr + 16); }
        const float sink = sinks[hq];
        float m = sink;
#pragma unroll
        for (int kt = 0; kt < 10; ++kt)
#pragma unroll
            for (int r = 0; r < 4; ++r) { const int kk = 32 * kb0 + 16 * kt + 4 * g + r; const bool ok = (kk >= qi + 1) && (kk <= qi + 128) && (kk >= kk0);
                st[kt][r] = ok ? st[kt][r] : -1e30f; m = fmaxf(m, st[kt][r]); }
        m = fmaxf(m, __shfl_xor(m, 16)); m = fmaxf(m, __shfl_xor(m, 32));
        float l = 0.f;
#pragma unroll
        for (int kt = 0; kt < 10; ++kt)
#pragma unroll
            for (int r = 0; r < 4; ++r) { const float p = (st[kt][r] > -1e29f) ? __expf(st[kt][r] - m) : 0.f; st[kt][r] = p; l += p; }
        l += __shfl_xor(l, 16); l += __shfl_xor(l, 32);
        l += __expf(sink - m);
        f32x4 o[4];
#pragma unroll
        for (int dt = 0; dt < 4; ++dt) o[dt] = (f32x4){0.f, 0.f, 0.f, 0.f};
#pragma unroll
        for (int ks = 0; ks < 5; ++ks) { v4u pw; pw.x = pk2(st[2 * ks][0], st[2 * ks][1]); pw.y = pk2(st[2 * ks][2], st[2 * ks][3]); pw.z = pk2(st[2 * ks + 1][0], st[2 * ks + 1][1]); pw.w = pk2(st[2 * ks + 1][2], st[2 * ks + 1][3]);
            const bf16x8_t pb = __builtin_bit_cast(bf16x8_t, pw);
#pragma unroll
            for (int dt = 0; dt < 4; ++dt) { const v4u aw = (v4u){vlo[ks][dt].x, vlo[ks][dt].y, vhi[ks][dt].x, vhi[ks][dt].y};
                o[dt] = __builtin_amdgcn_mfma_f32_16x16x32_bf16(__builtin_bit_cast(bf16x8_t, aw), pb, o[dt], 0, 0, 0); } }
        const float inv = 1.0f / l;
#pragma unroll
        for (int dt = 0; dt < 4; ++dt) { v2u w; w.x = pk2(o[dt][0] * inv, o[dt][1] * inv); w.y = pk2(o[dt][2] * inv, o[dt][3] * inv);
            *(v2u*)(YA + pg8::blk_off((int)t, hq * 64 + 16 * dt + 4 * g, BRW)) = w; }
        qlo = nlo; qhi = nhi; qc0 = nc0; qc1 = nc1; qs0 = ns0; qs1 = ns1;
    }
#undef ATT_LOADQ
    __syncthreads();
}

__device__ __forceinline__ void pool_units(LAS unsigned char* lds, const bf16* PROJ, const bf16* WPT, bf16* YP, int first, int stride, int nunits) {
    int tid = threadIdx.x; asm volatile("" : "+v"(tid));
    if (first >= nunits) return;
    const int gp = first & 3, w = 2 << gp;
    const int wave = __builtin_amdgcn_readfirstlane(tid >> 6), lane = tid & 63, g = lane >> 4, c = lane & 15, mt = wave & 3, nh = wave >> 2;
    LAS float* U = (LAS float*)lds;
    LAS bf16* DA = (LAS bf16*)(U + 79 * 192);
    bf16x8_t wf[6][6];
    { const bf16* wbase = WPT + (size_t)gp * 192 * 192;
#pragma unroll
      for (int ni = 0; ni < 6; ++ni)
#pragma unroll
          for (int ks = 0; ks < 6; ++ks) wf[ni][ks] = *(const bf16x8_t*)(wbase + (size_t)(16 * (6 * nh + ni) + c) * 192 + 32 * ks + 8 * g); }
#pragma unroll 1
    for (int u = first; u < nunits; u += stride) {
        const int tile = u >> 2, t0 = tile * 64, s0 = t0 & (SEQ - 1);
        for (int idx = tid; idx < 79 * 24; idx += 512) { const int rr = idx / 24, cq = idx - rr * 24; const int srel = s0 - 15 + rr;
            v4u x = (v4u){0u, 0u, 0u, 0u}; if (srel >= 0) x = *(const v4u*)(PROJ + (size_t)(t0 - 15 + rr) * NPROJ + C_PU + gp * 192 + cq * 8);
            *(LAS f32x4*)(U + rr * 192 + cq * 8) = (f32x4){bflo(x.x), bfhi(x.x), bflo(x.y), bfhi(x.y)}; *(LAS f32x4*)(U + rr * 192 + cq * 8 + 4) = (f32x4){bflo(x.z), bfhi(x.z), bflo(x.w), bfhi(x.w)}; }
        __syncthreads();
        for (int idx = tid; idx < 8 * 192; idx += 512) { const int run = idx / 192, cc = idx - run * 192, tokb = 8 * run;
            int sq = s0 + tokb; int cnt = (sq + 1) < w ? (sq + 1) : w;
            float sum = 0.f; for (int j = 0; j < cnt; ++j) sum += U[(15 + tokb - j) * 192 + cc];
            DA[tokb * 200 + cc] = (bf16)f2bf(sum / (float)cnt - U[(15 + tokb) * 192 + cc]);
#pragma unroll
            for (int i = 1; i < 8; ++i) { const int tok = tokb + i; sq = s0 + tok; const float ut = U[(15 + tok) * 192 + cc];
                sum += ut; if (sq >= w) sum -= U[(15 + tok - w) * 192 + cc];
                cnt = (sq + 1) < w ? (sq + 1) : w;
                DA[tok * 200 + cc] = (bf16)f2bf(sum / (float)cnt - ut); } }
        __syncthreads();
        {
            bf16x8_t db[6];
#pragma unroll
            for (int ks = 0; ks < 6; ++ks) db[ks] = *(const LAS bf16x8_t*)(DA + (16 * mt + c) * 200 + 32 * ks + 8 * g);
#pragma unroll
            for (int ni = 0; ni < 6; ++ni) { const int nt = 6 * nh + ni;
                f32x4 acc = (f32x4){0.f, 0.f, 0.f, 0.f};
#pragma unroll
                for (int ks = 0; ks < 6; ++ks) acc = __builtin_amdgcn_mfma_f32_16x16x32_bf16(wf[ni][ks], db[ks], acc, 0, 0, 0);
                v2u wv; wv.x = pk2(acc[0], acc[1]); wv.y = pk2(acc[2], acc[3]);
                *(v2u*)(YP + pg8::blk_off(t0 + 16 * mt + c, gp * 192 + 16 * nt + 4 * g, BRW)) = wv; }
        }
        __syncthreads();
    }
}

constexpr size_t GP_QT = 0, GP_KST = 12288, GP_A = 24576, GP_VT = 32768, GP_DEC = 57344, GP_ITEM = 57856;
__device__ __forceinline__ void gla_pre_items(LAS unsigned char* lds, const bf16* PROJ, const float* A2, const float* ba, unsigned char* GPRE, int first, int stride, int nitems) {
    int tid = threadIdx.x; asm volatile("" : "+v"(tid));
    if (first >= nitems) return;
    LAS float* LRs = (LAS float*)lds;
    LAS float* A2s = LRs + 64 * 16;
    LAS float* Bs = A2s + 16 * 96;
    LAS bf16* QTs = (LAS bf16*)(Bs + 64 * 96);
    LAS bf16* KTs = QTs + 64 * 104;
    LAS bf16* KSTs = KTs + 64 * 104;
    LAS bf16* VTs = KSTs + 96 * 72;
    v4u rlr = (v4u){0u, 0u, 0u, 0u}, rqk[3], rv[3]; float ra2[3];
#define PRE_LOAD(it_) do { const int bh_ = (it_) >> 5, h_ = bh_ & 3; const size_t tk_ = (size_t)((bh_ >> 2) * SEQ + ((it_) & 31) * 64); \
        if (tid < 128) rlr = *(const v4u*)(PROJ + (tk_ + (tid >> 1)) * NPROJ + C_LR + (tid & 1) * 8); \
        _Pragma("unroll") for (int i_ = 0; i_ < 3; ++i_) { const int idx_ = tid + 512 * i_, t_ = idx_ / 24, cq_ = idx_ - t_ * 24; \
            rqk[i_] = *(const v4u*)(PROJ + (tk_ + t_) * NPROJ + (cq_ < 12 ? C_QG + h_ * 96 + cq_ * 8 : C_KG + h_ * 96 + (cq_ - 12) * 8)); \
            rv[i_] = *(const v4u*)(PROJ + (tk_ + t_) * NPROJ + C_VG + h_ * 192 + cq_ * 8); \
            const int r_ = idx_ / 96, d_ = idx_ - r_ * 96; ra2[i_] = A2[r_ * 384 + h_ * 96 + d_]; } } while (0)
    PRE_LOAD(first);
#pragma unroll 1
    for (int item = first; item < nitems; item += stride) {
    const int bh = item >> 5, ch = item & 31, b = bh >> 2, h = bh & 3;
    unsigned char* gp = GPRE + (size_t)item * GP_ITEM;
    if (tid < 128) { const int t = tid >> 1, hq = tid & 1; const v4u w = rlr;
        *(LAS f32x4*)(LRs + t * 16 + hq * 8) = (f32x4){bflo(w.x), bfhi(w.x), bflo(w.y), bfhi(w.y)}; *(LAS f32x4*)(LRs + t * 16 + hq * 8 + 4) = (f32x4){bflo(w.z), bfhi(w.z), bflo(w.w), bfhi(w.w)}; }
#pragma unroll
    for (int i = 0; i < 3; ++i) { const int idx = tid + 512 * i, t = idx / 24, cq = idx - t * 24;
        if (cq < 12) *(LAS v4u*)(QTs + t * 104 + cq * 8) = rqk[i]; else *(LAS v4u*)(KTs + t * 104 + (cq - 12) * 8) = rqk[i];
        A2s[idx] = ra2[i];
        const v4u w = rv[i]; LAS bf16* vp = VTs + (cq * 8) * 72 + t;
        vp[0 * 72] = (bf16)(w.x & 0xffffu); vp[1 * 72] = (bf16)(w.x >> 16); vp[2 * 72] = (bf16)(w.y & 0xffffu); vp[3 * 72] = (bf16)(w.y >> 16);
        vp[4 * 72] = (bf16)(w.z & 0xffffu); vp[5 * 72] = (bf16)(w.z >> 16); vp[6 * 72] = (bf16)(w.w & 0xffffu); vp[7 * 72] = (bf16)(w.w >> 16); }
    if (item + stride < nitems) PRE_LOAD(item + stride);
    __syncthreads();
    {
        const int wv = __builtin_amdgcn_readfirstlane(tid >> 6), ln = tid & 63, g = ln >> 4, c = ln & 15;
#pragma unroll
        for (int rep3 = 0; rep3 < 3; ++rep3) { const int id = wv + 8 * rep3, tt = id / 6, dd = id - tt * 6;
            f32x4 z = (f32x4){0.f, 0.f, 0.f, 0.f};
#pragma unroll
            for (int ks = 0; ks < 4; ++ks) z = __builtin_amdgcn_mfma_f32_16x16x4f32(LRs[(16 * tt + c) * 16 + 4 * ks + g], A2s[(4 * ks + g) * 96 + 16 * dd + c], z, 0, 0, 0);
            const float bb = ba[h * 96 + 16 * dd + c];
#pragma unroll
            for (int r = 0; r < 4; ++r) { const float zz = z[r] + bb; const float ls = fminf(zz, 0.f) - __logf(1.0f + __expf(-fabsf(zz)));
                Bs[(16 * tt + 4 * g + r) * 96 + 16 * dd + c] = ls * (1.0f / 16.0f); } }
    }
    __syncthreads();
    if (tid < 96) { float gv[64];
#pragma unroll
        for (int t = 0; t < 64; ++t) gv[t] = Bs[t * 96 + tid];
        float run = 0.f;
#pragma unroll
        for (int t = 0; t < 64; ++t) { run += gv[t]; Bs[t * 96 + tid] = run; } }
    __syncthreads();
    const float qscale = 0.10206207261596575f;
    for (int idx = tid; idx < 64 * 96; idx += 512) { const int t = idx / 96, d = idx - t * 96;
        const float bb = Bs[idx], bl = Bs[63 * 96 + d];
        const float q = bf2f(QTs[t * 104 + d]), k = bf2f(KTs[t * 104 + d]);
        QTs[t * 104 + d] = (bf16)f2bf(q * qscale * __expf(bb)); KTs[t * 104 + d] = (bf16)f2bf(k * __expf(-bb)); KSTs[d * 72 + t] = (bf16)f2bf(k * __expf(bl - bb)); }
    if (tid < 96) ((float*)(gp + GP_DEC))[tid] = __expf(Bs[63 * 96 + tid]);
    __syncthreads();
    for (int idx = tid; idx < 64 * 12; idx += 512) { const int r = idx / 12, cq = idx - r * 12; *(v4u*)(gp + GP_QT + r * 192 + cq * 16) = *(const LAS v4u*)(QTs + r * 104 + cq * 8); }
    for (int idx = tid; idx < 96 * 8; idx += 512) { const int r = idx >> 3, cq = idx & 7; *(v4u*)(gp + GP_KST + r * 128 + cq * 16) = *(const LAS v4u*)(KSTs + r * 72 + cq * 8); }
    for (int idx = tid; idx < 192 * 8; idx += 512) { const int r = idx >> 3, cq = idx & 7; *(v4u*)(gp + GP_VT + r * 128 + cq * 16) = *(const LAS v4u*)(VTs + r * 72 + cq * 8); }
    {
        const int wave = __builtin_amdgcn_readfirstlane(tid >> 6), lane = tid & 63, g = lane >> 4, c = lane & 15;
#pragma unroll
        for (int rep = 0; rep < 2; ++rep) { const int id = wave + 8 * rep, it = id >> 2, jt = id & 3;
            f32x4 acc = (f32x4){0.f, 0.f, 0.f, 0.f};
            if (jt <= it) {
#pragma unroll
                for (int ks = 0; ks < 3; ++ks) { const bf16x8_t a = *(const LAS bf16x8_t*)(KTs + (16 * jt + c) * 104 + 32 * ks + 8 * g), bq = *(const LAS bf16x8_t*)(QTs + (16 * it + c) * 104 + 32 * ks + 8 * g);
                    acc = __builtin_amdgcn_mfma_f32_16x16x32_bf16(a, bq, acc, 0, 0, 0); } }
            const int i = 16 * it + c, j0 = 16 * jt + 4 * g;
            v2u w; w.x = pk2(j0 + 0 <= i ? acc[0] : 0.f, j0 + 1 <= i ? acc[1] : 0.f); w.y = pk2(j0 + 2 <= i ? acc[2] : 0.f, j0 + 3 <= i ? acc[3] : 0.f);
            *(v2u*)(gp + GP_A + i * 128 + j0 * 2) = w; }
    }
    __syncthreads();
    }
#undef PRE_LOAD
}
constexpr int GS_QT = 0, GS_KST = 13312, GS_A = 27136, GS_VT = 36352, GS_DEC = 45568, GS_BUF = 46080;
__device__ __forceinline__ void gla_scan_unit(LAS unsigned char* lds, const unsigned char* GPRE, float* GO, int u) {
    int tid = threadIdx.x; asm volatile("" : "+v"(tid));
    const int bh = u / 3, s3 = u - 3 * bh, b = bh >> 2, h = bh & 3;
    const int wave = __builtin_amdgcn_readfirstlane(tid >> 6), lane = tid & 63, g = lane >> 4, c = lane & 15, th = wave >> 2, jt = wave & 3;
    int goff[5], loff[5];
#pragma unroll
    for (int i = 0; i < 5; ++i) { const int q = tid + 512 * i;
        if (q < 768) { const int r = q / 12, cq = q - r * 12; goff[i] = (int)GP_QT + r * 192 + cq * 16; loff[i] = GS_QT + r * 208 + cq * 16; }
        else if (q < 1536) { const int p = q - 768, r = p >> 3, cq = p & 7; goff[i] = (int)GP_KST + r * 128 + cq * 16; loff[i] = GS_KST + r * 144 + cq * 16; }
        else if (q < 2048) { const int p = q - 1536, r = p >> 3, cq = p & 7; goff[i] = (int)GP_A + r * 128 + cq * 16; loff[i] = GS_A + r * 144 + cq * 16; }
        else { const int p = q - 2048, r = p >> 3, cq = p & 7; goff[i] = (int)GP_VT + (64 * s3 + r) * 128 + cq * 16; loff[i] = GS_VT + r * 144 + cq * 16; } }
    f32x4 S[6];
#pragma unroll
    for (int i = 0; i < 6; ++i) S[i] = (f32x4){0.f, 0.f, 0.f, 0.f};
    v4u rg[5]; v4u rd = (v4u){0u, 0u, 0u, 0u};
    { const unsigned char* gp = GPRE + (size_t)(bh * 32) * GP_ITEM;
#pragma unroll
      for (int i = 0; i < 5; ++i) rg[i] = *(const v4u*)(gp + goff[i]);
      if (tid < 24) rd = *(const v4u*)(gp + GP_DEC + tid * 16);
#pragma unroll
      for (int i = 0; i < 5; ++i) *(LAS v4u*)(lds + loff[i]) = rg[i];
      if (tid < 24) *(LAS v4u*)(lds + GS_DEC + tid * 16) = rd; }
    __syncthreads();
#pragma unroll 1
    for (int ch = 0; ch < 32; ++ch) {
        LAS unsigned char* cur = lds + (ch & 1) * GS_BUF; LAS unsigned char* nxt = lds + ((ch + 1) & 1) * GS_BUF;
        if (ch + 1 < 32) { const unsigned char* gp = GPRE + (size_t)(bh * 32 + ch + 1) * GP_ITEM;
#pragma unroll
            for (int i = 0; i < 5; ++i) rg[i] = *(const v4u*)(gp + goff[i]);
            if (tid < 24) rd = *(const v4u*)(gp + GP_DEC + tid * 16); }
        const size_t tokc = (size_t)(b * SEQ + ch * 64);
        bf16x8_t vb[2];
#pragma unroll
        for (int ks = 0; ks < 2; ++ks) vb[ks] = *(const LAS bf16x8_t*)(cur + GS_VT + (16 * jt + c) * 144 + (32 * ks + 8 * g) * 2);
        bf16x8_t sb[3];
#pragma unroll
        for (int ks = 0; ks < 3; ++ks) { v4u w; w.x = pk2(S[2 * ks][0], S[2 * ks][1]); w.y = pk2(S[2 * ks][2], S[2 * ks][3]); w.z = pk2(S[2 * ks + 1][0], S[2 * ks + 1][1]); w.w = pk2(S[2 * ks + 1][2], S[2 * ks + 1][3]);
            sb[ks] = __builtin_bit_cast(bf16x8_t, w); }
#pragma unroll
        for (int ti = 0; ti < 2; ++ti) { const int it = 2 * th + ti;
            f32x4 acc = (f32x4){0.f, 0.f, 0.f, 0.f};
#pragma unroll
            for (int ks = 0; ks < 2; ++ks) { const bf16x8_t a = *(const LAS bf16x8_t*)(cur + GS_A + (16 * it + c) * 144 + (32 * ks + 8 * g) * 2);
                acc = __builtin_amdgcn_mfma_f32_16x16x32_bf16(a, vb[ks], acc, 0, 0, 0); }
#pragma unroll
            for (int ks = 0; ks < 3; ++ks) { const v2u lo = *(const LAS v2u*)(cur + GS_QT + (16 * it + c) * 208 + (32 * ks + 4 * g) * 2), hi = *(const LAS v2u*)(cur + GS_QT + (16 * it + c) * 208 + (32 * ks + 16 + 4 * g) * 2);
                const v4u w = (v4u){lo.x, lo.y, hi.x, hi.y};
                acc = __builtin_amdgcn_mfma_f32_16x16x32_bf16(__builtin_bit_cast(bf16x8_t, w), sb[ks], acc, 0, 0, 0); }
            float* op = GO + (tokc + 16 * it + 4 * g) * BRW + h * 192 + 64 * s3 + 16 * jt + c;
            op[0 * BRW] = acc[0]; op[1 * BRW] = acc[1]; op[2 * BRW] = acc[2]; op[3 * BRW] = acc[3]; }
#pragma unroll
        for (int i = 0; i < 6; ++i) { const f32x4 d4 = *(const LAS f32x4*)(cur + GS_DEC + (16 * i + 4 * g) * 4);
            S[i] = S[i] * d4;
#pragma unroll
            for (int ks = 0; ks < 2; ++ks) { const bf16x8_t a = *(const LAS bf16x8_t*)(cur + GS_KST + (16 * i + c) * 144 + (32 * ks + 8 * g) * 2);
                S[i] = __builtin_amdgcn_mfma_f32_16x16x32_bf16(a, vb[ks], S[i], 0, 0, 0); } }
        if (ch + 1 < 32) {
#pragma unroll
            for (int i = 0; i < 5; ++i) *(LAS v4u*)(nxt + loff[i]) = rg[i];
            if (tid < 24) *(LAS v4u*)(nxt + GS_DEC + tid * 16) = rd; }
        __syncthreads();
    }
}
__device__ __forceinline__ void gla_norm_phase(const float* GO, const bf16* PROJ, const float* gnorm, bf16* YG, int gw, int NGW, int lane) {
    asm volatile("" : "+v"(lane));
    f32x4 gn[3];
#pragma unroll
    for (int j = 0; j < 3; ++j) gn[j] = *(const f32x4*)(gnorm + 12 * lane + 4 * j);
#pragma unroll 1
    for (int t0 = gw; t0 < NTOK; t0 += 4 * NGW) {
        f32x4 o[4][3]; v2u og[4][3];
#pragma unroll
        for (int q = 0; q < 4; ++q) { const int tq = t0 + q * NGW; const size_t t = (size_t)(tq < NTOK ? tq : t0);
#pragma unroll
            for (int j = 0; j < 3; ++j) { o[q][j] = *(const f32x4*)(GO + t * BRW + 12 * lane + 4 * j); og[q][j] = *(const v2u*)(PROJ + t * NPROJ + C_OG + 12 * lane + 4 * j); } }
#pragma unroll
        for (int q = 0; q < 4; ++q) { const int tq = t0 + q * NGW; if (tq >= NTOK) break; const size_t t = (size_t)tq;
            float ss = 0.f;
#pragma unroll
            for (int j = 0; j < 3; ++j) ss += (o[q][j].x * o[q][j].x + o[q][j].y * o[q][j].y) + (o[q][j].z * o[q][j].z + o[q][j].w * o[q][j].w);
            ss += __shfl_xor(ss, 1); ss += __shfl_xor(ss, 2); ss += __shfl_xor(ss, 4); ss += __shfl_xor(ss, 8);
            const float rstd = 1.0f / sqrtf(ss * (1.0f / 192.0f) + EPS);
#pragma unroll
            for (int j = 0; j < 3; ++j) { const float g0 = bflo(og[q][j].x), g1 = bfhi(og[q][j].x), g2 = bflo(og[q][j].y), g3 = bfhi(og[q][j].y);
                const float y0 = o[q][j].x * rstd * gn[j].x * (g0 / (1.0f + __expf(-g0))), y1 = o[q][j].y * rstd * gn[j].y * (g1 / (1.0f + __expf(-g1)));
                const float y2 = o[q][j].z * rstd * gn[j].z * (g2 / (1.0f + __expf(-g2))), y3 = o[q][j].w * rstd * gn[j].w * (g3 / (1.0f + __expf(-g3)));
                v2u w; w.x = pk2(y0, y1); w.y = pk2(y2, y3);
                *(v2u*)(YG + pg8::blk_off((int)t, 12 * lane + 4 * j, BRW)) = w; } }
    }
}

__global__ void __launch_bounds__(NWAVES * 64, 2) mega_fwd(Args A) {
    extern __shared__ __attribute__((aligned(16))) unsigned char lds_raw[];
    LAS unsigned char* lds = (LAS unsigned char*)lds_raw;
    const int tid = threadIdx.x;
    const int G = gridDim.x, bx = blockIdx.x;
    unsigned char* ws = A.ws;
    for (int u = tid; u < (LDS_BYTES - LDSCTL_OFF) / 4; u += NWAVES * 64) ((LAS unsigned*)(lds + LDSCTL_OFF))[u] = 0u;
    __syncthreads();
    XcdBarrier bar = xcd_barrier_post((unsigned*)(ws + WS_CTL) + CW_BAR, (volatile LAS unsigned*)(lds + MISC_OFF) + 8);

    float* X = (float*)(ws + WS_X); bf16* H = (bf16*)(ws + WS_H); bf16* ACT = (bf16*)(ws + WS_ACT); bf16* PROJ = (bf16*)(ws + WS_PROJ);
    bf16* Y = (bf16*)(ws + WS_Y); float* MACC = (float*)(ws + WS_MACC); bf16* MB = (bf16*)(ws + WS_MB); float* GO = (float*)(ws + WS_GO);
    const float* COS = (const float*)(ws + WS_ROPE); const float* SIN = COS + (size_t)NTOK * 32;

    { int t_ = threadIdx.x; asm volatile("" : "+v"(t_)); const int w_ = __builtin_amdgcn_readfirstlane(t_ >> 6); p0_prologue(A, lds, bx * NWAVES + w_, G * NWAVES, w_, t_ & 63); }
    conv_until(A, lds, TL_WO1, 0);
    xcd_barrier(bar);

#pragma unroll 1
    for (int step = 0; step < 3 * DEPTH; ++step) {
        const int l = step / 3, kind = step - 3 * l;
        unsigned char* wl = ws + WS_W + (size_t)l * LW_END;
        const unsigned long long* ssq = (const unsigned long long*)(ws + WS_CTL + CTL_SSQ) + (size_t)step * NTOK; unsigned long long* ssq_next = (unsigned long long*)(ws + WS_CTL + CTL_SSQ) + (size_t)(step + 1) * NTOK;
        if (kind != 1) {
            { pg8::Gemm g{H, (const bf16*)(wl + (kind == 0 ? LW_WI1 : LW_WI2)), NTOK, NWI, DM}; pg8::StaticOrder S; S.init(NTOK, NWI, G, bx);
              pg8::EpiSwiglu E{ACT, DFF, ssq};
              pg8::gemm_phase<pg8::EpiSwiglu, pg8::StaticOrder, true, true>(lds + RING_OFF, g, S, E); }
            { const int rem1 = ((NTOK / 256) * (NWI / 256)) % G;
              conv_until(A, lds, l * TL_LAYER + (kind == 0 ? TL_WIN : TL_LAYER), (rem1 != 0 && bx >= rem1) ? 3 : 0); }
            xcd_barrier(bar);
        } else {
            const bool std256 = (G == 256);
            unsigned char* XB8 = ws + WS_X;
#pragma unroll 1
            for (int part = 0; part < 3; ++part) {
                bool do16, do8; int i16, n16, g8, c8, i8, n8;
                if (std256) { do16 = part == 0 || (part == 1 && bx < 64); i16 = part ? 2 : 0; n16 = part ? 1 : 2;
                              do8 = (part == 1 && bx >= 64) || (part == 2 && bx < 128); g8 = part == 1 ? 192 : 128; c8 = part == 1 ? bx - 64 : bx; i8 = part == 1 ? 0 : 3; n8 = part == 1 ? 2 : 3; }
                else { do16 = part == 0; i16 = 0; n16 = 1 << 20; do8 = part == 1; g8 = G; c8 = bx; i8 = 0; n8 = 1 << 20; }
                if (do16) { pg8::Gemm g{H, (const bf16*)(wl + LW_WIN), NTOK, C_GATE, DM}; pg8::RangeOrder S; S.init(NTOK, C_GATE, G, bx); S.i0 = i16; S.n = n16;
                    pg8::EpiProj E{PROJ, NPROJ, (const float*)A.in[7] + (size_t)l * 6144, 1 << 20, ssq, 1.0f};
                    pg8::gemm_phase<pg8::EpiProj, pg8::RangeOrder, true, true>(lds + RING_OFF, g, S, E); }
                if (do8) { pg8::Gemm g{(const bf16*)XB8, (const bf16*)(wl + LW_WIN + WIN8_OFF), NTOK, 6144, DM / 2}; pg8::RangeOrder S; S.init(NTOK, 6144, g8, c8); S.i0 = i8; S.n = n8;
                    pg8::EpiProj E{PROJ + C_GATE, NPROJ, (const float*)A.in[7] + (size_t)l * 6144, 0, ssq, 1.0f / 2048.0f};
                    pg8::gemm_phase<pg8::EpiProj, pg8::RangeOrder, true, true, true>(lds + RING_OFF, g, S, E); }
                if (part == 1) xcd_barrier(bar);
                if (part == 2 && (!std256 || bx >= 128)) { const int mb = std256 ? bx - 128 : bx, ms = std256 ? 128 : G;
                    if ((ms & 3) == 0) pool_units(lds, PROJ, (const bf16*)(ws + WS_WPT) + (size_t)l * 4 * 192 * 192, Y + (size_t)NTOK * BRW, mb, ms, 512);
                    else for (int u = mb; u < 512; u += ms) pool_units(lds, PROJ, (const bf16*)(ws + WS_WPT) + (size_t)l * 4 * 192 * 192, Y + (size_t)NTOK * BRW, u, 512, 512);
                    gla_pre_items(lds, PROJ, (const float*)A.in[11] + (size_t)l * 16 * 384, (const float*)A.in[12] + l * 384, ws + WS_GPRE, mb, ms, 512); }
            }
            xcd_barrier(bar);
            if (G > 96) { if (bx < 48) gla_scan_unit(lds, ws + WS_GPRE, GO, bx);
                          else for (int u = bx - 48; u < 256; u += G - 48) att_unit(lds, PROJ, COS, SIN, (const float*)A.in[8] + l * 12, Y, u); }
            else { for (int u = bx; u < 48; u += G) gla_scan_unit(lds, ws + WS_GPRE, GO, u);
                   for (int u = bx; u < 256; u += G) att_unit(lds, PROJ, COS, SIN, (const float*)A.in[8] + l * 12, Y, u); }
            conv_until(A, lds, l * TL_LAYER + TL_WI2, (G > 96 && bx >= 48) ? ((bx - 48) + (G - 48) < 256 ? 1 : 3) : 0);
            xcd_barrier(bar);
            { int t_ = threadIdx.x; asm volatile("" : "+v"(t_)); gla_norm_phase(GO, PROJ, (const float*)A.in[13] + l * 768, Y + (size_t)2 * NTOK * BRW, bx * NWAVES + __builtin_amdgcn_readfirstlane(t_ >> 6), G * NWAVES, t_ & 63); }
            xcd_barrier(bar);
            { pg8::Gemm g{Y, (const bf16*)(wl + LW_WBR), NTOK, DM, BRW, (size_t)NTOK * BRW * 2, (size_t)DM * BRW * 2}; pg8::SegOrder S; S.init(NTOK, DM, G, bx); S.nseg = 3;
              pg8::EpiMergeSeg E{PROJ + C_GATE, NPROJ, DM, MB, DM};
              pg8::gemm_phase<pg8::EpiMergeSeg, pg8::SegOrder, true, true>(lds + RING_OFF, g, S, E); }
            xcd_barrier(bar);
        }
        { const bf16* Ap = (kind == 1) ? (const bf16*)MB : (const bf16*)ACT; const int Kd = (kind == 1) ? DM : DFF;
          const bf16* Bp = (const bf16*)(wl + (kind == 0 ? LW_WO1 : (kind == 1 ? LW_WOUT : LW_WO2)));
          pg8::Gemm g{Ap, Bp, NTOK, DM, Kd}; pg8::StaticOrder S; S.init(NTOK, DM, G, bx);
          pg8::EpiResid E{H, ssq_next, DM, kind == 1 ? 1.0f : 0.5f, kind == 0 ? ws + WS_X : nullptr};
          pg8::gemm_phase<pg8::EpiResid, pg8::StaticOrder, true, true>(lds + RING_OFF, g, S, E); }
        conv_until(A, lds, l * TL_LAYER + (kind == 0 ? TL_BRA : (kind == 1 ? TL_WO2 : TL_LAYER + TL_WO1)), 0);
        xcd_barrier(bar);
    }
    { int t_ = threadIdx.x; asm volatile("" : "+v"(t_)); final_phase(H, (const unsigned long long*)(ws + WS_CTL + CTL_SSQ) + (size_t)12 * NTOK, (const float*)A.in[21], A.out, bx * NWAVES + __builtin_amdgcn_readfirstlane(t_ >> 6), G * NWAVES, t_ & 63); }
}

extern "C" void kernel_launch(void* const* d_in, const int* in_sizes, int n_in, void* d_out, int out_size, void* d_ws, size_t ws_size, hipStream_t stream) {
    static int grid = 0;
    if (grid == 0) {
        if (n_in != 22 || in_sizes[0] != NTOK * DM || out_size != NTOK * DM || ws_size < WS_END) {
            fprintf(stderr, "kernel_launch: unexpected shapes (n_in %d, in0 %d, out %d, ws %zu < %zu); nothing launched\n", n_in, n_in > 0 ? in_sizes[0] : -1, out_size, ws_size, (size_t)WS_END); grid = -1; return; }
        int dev = 0, cus = 0, per_cu = 0;
        if (hipGetDevice(&dev) != hipSuccess || hipDeviceGetAttribute(&cus, hipDeviceAttributeMultiprocessorCount, dev) != hipSuccess) { grid = -1; return; }
        if (hipFuncSetAttribute((const void*)mega_fwd, hipFuncAttributeMaxDynamicSharedMemorySize, LDS_BYTES) != hipSuccess) { fprintf(stderr, "kernel_launch: hipFuncSetAttribute failed\n"); grid = -1; return; }
        if (hipOccupancyMaxActiveBlocksPerMultiprocessor(&per_cu, (const void*)mega_fwd, NWAVES * 64, LDS_BYTES) != hipSuccess || per_cu < 1) { fprintf(stderr, "kernel_launch: occupancy query says %d\n", per_cu); (void)hipGetLastError(); grid = -1; return; }
        grid = cus;
    }
    if (grid < 0) return;
    if (hipMemsetAsync((char*)d_ws + WS_CTL, 0, CTL_ZERO_BYTES, stream) != hipSuccess) return;
    Args a{};
    for (int i = 0; i < 22; ++i) a.in[i] = d_in[i];
    a.out = (float*)d_out; a.ws = (unsigned char*)d_ws;
    hipLaunchKernelGGL(mega_fwd, dim3(grid), dim3(NWAVES * 64), LDS_BYTES, stream, a);
}
```

```cpp
#include <hip/hip_runtime.h>
#include <cstdio>
#include <cstdint>
#include <cmath>
namespace pg8 {
#define PG8_LAS __attribute__((address_space(3)))
typedef unsigned short bf16_t;
typedef short bf16x8 __attribute__((ext_vector_type(8)));
typedef float f32x4 __attribute__((ext_vector_type(4)));
typedef unsigned u32x4 __attribute__((ext_vector_type(4)));
typedef int i32x4 __attribute__((ext_vector_type(4)));
typedef int i32x8 __attribute__((ext_vector_type(8)));
constexpr int BM = 256, BK = 64, HALF = 128, HTB = HALF * BK * 2  , STAGE_BYTES = 8 * HTB, NXCD = 8, WGM = 8;

__host__ __device__ __forceinline__ int lds_byte(int r, int c) { const int st = (r >> 4) * 2 + (c >> 5), rr = r & 15, cc = c & 31, ob = rr * 64 + cc * 2; return st * 1024 + (ob ^ (((ob >> 9) & 1) << 5)); }
__host__ __device__ __forceinline__ void stage_rc(int b, int& R, int& C) { const int st = b / 1024, sb = b % 1024, swz = sb ^ (((sb >> 9) & 1) << 5); R = (st >> 1) * 16 + swz / 64; C = (st & 1) * 32 + (swz % 64) / 2; }
__host__ __device__ __forceinline__ int perm32(int rho) { const int n = rho >> 4, i = rho & 15; return 8 * (i >> 2) + 4 * n + (i & 3); }

__host__ __device__ __forceinline__ size_t blk_off(int r, int c, int C) { return ((size_t)(r >> 6) * (size_t)(C >> 6) + (size_t)(c >> 6)) * 4096 + (size_t)(r & 63) * 64 + (size_t)(c & 63); }
__host__ __device__ __forceinline__ size_t blk8_off(int r, int c, int Cb) { return ((size_t)(r >> 6) * (size_t)(Cb >> 7) + (size_t)(c >> 7)) * 8192 + (size_t)(r & 63) * 128 + (size_t)(c & 127); }
__device__ __forceinline__ unsigned cvt_pk4_fp8(float a, float b, float c, float d) {
    a = __builtin_amdgcn_fmed3f(a, -448.f, 448.f); b = __builtin_amdgcn_fmed3f(b, -448.f, 448.f); c = __builtin_amdgcn_fmed3f(c, -448.f, 448.f); d = __builtin_amdgcn_fmed3f(d, -448.f, 448.f);
    int p = __builtin_amdgcn_cvt_pk_fp8_f32(a, b, 0, false); p = __builtin_amdgcn_cvt_pk_fp8_f32(c, d, p, true); return (unsigned)p; }
struct Unit { int pm, pn, seg; };
struct Gemm { const bf16_t* A; const bf16_t* Bt; int M, N, K; size_t segA = 0, segB = 0; };

struct StaticOrder {
    int nM, nN, nwg, G, c;
    __host__ __device__ void init(int M, int N, int G_, int c_) { nM = M / BM; nN = N / BM; nwg = nM * nN; G = G_; c = c_; }
    __host__ __device__ bool next(int i, Unit& u) const {
        const long L = (long)i * G + c; if (L >= nwg) return false;
        int wgid = (int)L; { const int q = nwg / NXCD, r = nwg % NXCD, xcd = wgid % NXCD, off = wgid / NXCD; wgid = (xcd < r ? xcd * (q + 1) : r * (q + 1) + (xcd - r) * q) + off; }
        const int nig = WGM * nN, gid = wgid / nig, fm = gid * WGM, gsz = (nM - fm) < WGM ? (nM - fm) : WGM;
        u.pm = fm + ((wgid % nig) % gsz); u.pn = (wgid % nig) / gsz; u.seg = 0; return true;
    }
    __device__ __forceinline__ void a_ready(const Unit&) const {}
    __device__ __forceinline__ void done(const Unit&) const {}
};
struct RangeOrder : StaticOrder { int i0, n;
    __host__ __device__ bool next(int i, Unit& u) const { if (i >= n) return false; return StaticOrder::next(i + i0, u); } };
struct SegOrder : StaticOrder { int nseg;
    __host__ __device__ bool next(int i, Unit& u) const { const int t = i / nseg; if (!StaticOrder::next(t, u)) return false; u.seg = i - t * nseg; return true; } };
__device__ __forceinline__ unsigned cvt_pk_bf16(float lo, float hi) { unsigned r; asm volatile("v_cvt_pk_bf16_f32 %0, %1, %2" : "=v"(r) : "v"(lo), "v"(hi)); return r; }
typedef float f32x2 __attribute__((ext_vector_type(2)));
__device__ __forceinline__ float bf_lo(unsigned w) { return __uint_as_float(w << 16); }
__device__ __forceinline__ float bf_hi(unsigned w) { return __uint_as_float(w & 0xffff0000u); }
__device__ __forceinline__ float sigmoid_f(float v) { return __builtin_amdgcn_rcpf(1.0f + __builtin_amdgcn_exp2f(v * -1.4426950408889634f)); }
__device__ __forceinline__ float rstd_of(unsigned long long q) {
    const float f = (float)(unsigned)(q >> 32) * 4294967296.0f + (float)(unsigned)q; return __builtin_amdgcn_rsqf(f * (1.0f / 1048576.0f / 2048.0f) + 1e-6f); }
#define PG8_LOAD_RSTD(rs, ssq, row0) float rs[2][4]; { unsigned long long q_[2][4]; _Pragma("unroll") for (int ai = 0; ai < 2; ++ai) _Pragma("unroll") for (int m = 0; m < 4; ++m) q_[ai][m] = (ssq)[(row0) + ai * HALF + m * 16]; \
    _Pragma("unroll") for (int ai = 0; ai < 2; ++ai) _Pragma("unroll") for (int m = 0; m < 4; ++m) rs[ai][m] = rstd_of(q_[ai][m]); }
struct EpiSwiglu {
    static constexpr bool PERM = true, AFTER_DRAIN = false, SEGMENTED = false;
    bf16_t* O; int ldo; const unsigned long long* ssq;
    __device__ __forceinline__ void operator()(const f32x4 (&acc)[2][2][4][2], const Unit& u, int wr, int wc, int fr, int fq) const {
        const int row0 = u.pm * BM + wr * 64 + fr, hid0 = u.pn * HALF + wc * 32 + 8 * fq;
        PG8_LOAD_RSTD(rsv, ssq, row0)
#pragma unroll
        for (int ai = 0; ai < 2; ++ai)
#pragma unroll
            for (int m = 0; m < 4; ++m) { const int row = row0 + ai * HALF + m * 16; bf16_t* rowp = O + blk_off(row, hid0, ldo);
                const float rs = rsv[ai][m];
                f32x4 v0, v1;
#pragma unroll
                for (int j = 0; j < 4; ++j) { const float a0 = acc[ai][0][m][0][j] * rs, a1 = acc[ai][0][m][1][j] * rs;
                    v0[j] = a0 * sigmoid_f(a0) * (acc[ai][1][m][0][j] * rs); v1[j] = a1 * sigmoid_f(a1) * (acc[ai][1][m][1][j] * rs); }
                u32x4 w; w.x = cvt_pk_bf16(v0[0], v0[1]); w.y = cvt_pk_bf16(v0[2], v0[3]); w.z = cvt_pk_bf16(v1[0], v1[1]); w.w = cvt_pk_bf16(v1[2], v1[3]);
                *(u32x4*)rowp = w; }
    }
};
struct EpiResid {
    static constexpr bool PERM = true, AFTER_DRAIN = false, SEGMENTED = false;
    bf16_t* xb; unsigned long long* ssq_next; int ldc; float scale; unsigned char* x8;
    __device__ __forceinline__ void operator()(const f32x4 (&acc)[2][2][4][2], const Unit& u, int wr, int wc, int fr, int fq) const {
        const int row0 = u.pm * BM + wr * 64 + fr, col0 = u.pn * BM + wc * 32 + 8 * fq;
#pragma unroll
        for (int ai = 0; ai < 2; ++ai) {
            u32x4 t[4][2];
#pragma unroll
            for (int m = 0; m < 4; ++m)
#pragma unroll
                for (int bj = 0; bj < 2; ++bj) t[m][bj] = *(const u32x4*)(xb + blk_off(row0 + ai * HALF + m * 16, col0 + bj * HALF, ldc));
#pragma unroll
            for (int m = 0; m < 4; ++m) { const int row = row0 + ai * HALF + m * 16; float ss = 0.f;
#pragma unroll
                for (int bj = 0; bj < 2; ++bj) { const u32x4 x = t[m][bj];
                    f32x4 v0 = (f32x4){bf_lo(x.x), bf_hi(x.x), bf_lo(x.y), bf_hi(x.y)} + acc[ai][bj][m][0] * scale, v1 = (f32x4){bf_lo(x.z), bf_hi(x.z), bf_lo(x.w), bf_hi(x.w)} + acc[ai][bj][m][1] * scale;
                    u32x4 w; w.x = cvt_pk_bf16(v0[0], v0[1]); w.y = cvt_pk_bf16(v0[2], v0[3]); w.z = cvt_pk_bf16(v1[0], v1[1]); w.w = cvt_pk_bf16(v1[2], v1[3]);
                    *(u32x4*)(xb + blk_off(row, col0 + bj * HALF, ldc)) = w;
                    if (x8) { typedef unsigned v2u_ __attribute__((ext_vector_type(2))); v2u_ q; q.x = cvt_pk4_fp8(v0[0] * 8.f, v0[1] * 8.f, v0[2] * 8.f, v0[3] * 8.f); q.y = cvt_pk4_fp8(v1[0] * 8.f, v1[1] * 8.f, v1[2] * 8.f, v1[3] * 8.f);
                        *(v2u_*)(x8 + blk8_off(row, col0 + bj * HALF, ldc)) = q; }
                    ss += (v0[0] * v0[0] + v0[1] * v0[1]) + (v0[2] * v0[2] + v0[3] * v0[3]) + (v1[0] * v1[0] + v1[1] * v1[1]) + (v1[2] * v1[2] + v1[3] * v1[3]); }
                ss += __shfl_xor(ss, 16); ss += __shfl_xor(ss, 32);
                if (fq == 0) atomicAdd(ssq_next + row, (unsigned long long)(ss * 1048576.0f + 0.5f)); } }
    }
};
struct EpiProj {
    static constexpr bool PERM = true, AFTER_DRAIN = false, SEGMENTED = false;
    bf16_t* O; int ldo; const float* bias; int gate_tile0; const unsigned long long* ssq; float dsc;
    __device__ __forceinline__ void operator()(const f32x4 (&acc)[2][2][4][2], const Unit& u, int wr, int wc, int fr, int fq) const {
        const int row0 = u.pm * BM + wr * 64 + fr, col0 = u.pn * BM + wc * 32 + 8 * fq;
        const bool gate = u.pn >= gate_tile0;
        PG8_LOAD_RSTD(rsv, ssq, row0)
        f32x4 bv[2][2];
#pragma unroll
        for (int bj = 0; bj < 2; ++bj)
#pragma unroll
            for (int n = 0; n < 2; ++n) bv[bj][n] = gate ? *(const f32x4*)(bias + (col0 - gate_tile0 * BM) + bj * HALF + 4 * n) : (f32x4){0.f, 0.f, 0.f, 0.f};
#pragma unroll
        for (int ai = 0; ai < 2; ++ai)
#pragma unroll
            for (int m = 0; m < 4; ++m) { const int row = row0 + ai * HALF + m * 16; bf16_t* rowp = O + (size_t)row * ldo + col0;
                const float rs = rsv[ai][m] * dsc;
#pragma unroll
                for (int bj = 0; bj < 2; ++bj) { f32x4 v0 = acc[ai][bj][m][0] * rs + bv[bj][0], v1 = acc[ai][bj][m][1] * rs + bv[bj][1];
                    if (gate) {
#pragma unroll
                        for (int j = 0; j < 4; ++j) { v0[j] = sigmoid_f(v0[j]); v1[j] = sigmoid_f(v1[j]); } }
                    u32x4 w; w.x = cvt_pk_bf16(v0[0], v0[1]); w.y = cvt_pk_bf16(v0[2], v0[3]); w.z = cvt_pk_bf16(v1[0], v1[1]); w.w = cvt_pk_bf16(v1[2], v1[3]);
                    *(u32x4*)(rowp + bj * HALF) = w; } }
    }
};
struct EpiMergeSeg {
    static constexpr bool PERM = true, AFTER_DRAIN = false, SEGMENTED = true;
    const bf16_t* gate; int ldg; int gseg; bf16_t* outb; int ldc;
    __device__ __forceinline__ bool run(f32x4 (&acc)[2][2][4][2], const Unit& u, int wr, int wc, int fr, int fq) const {
        const int row0 = u.pm * BM + wr * 64 + fr, col0 = u.pn * BM + wc * 32 + 8 * fq;
        const bf16_t* gs = gate + (size_t)u.seg * gseg; const bool last = u.seg == 2;
#pragma unroll
        for (int ai = 0; ai < 2; ++ai) {
            u32x4 ga[4][2], gb[4][2];
#pragma unroll
            for (int m = 0; m < 4; ++m)
#pragma unroll
                for (int bj = 0; bj < 2; ++bj) { const size_t p = (size_t)(row0 + ai * HALF + m * 16) * ldg + col0 + bj * HALF;
                    ga[m][bj] = *(const u32x4*)(gs + p); gb[m][bj] = last ? ga[m][bj] : *(const u32x4*)(gs + gseg + p); }
#pragma unroll
            for (int m = 0; m < 4; ++m)
#pragma unroll
                for (int bj = 0; bj < 2; ++bj) { const u32x4 a = ga[m][bj], b = gb[m][bj];
                    float f[8] = {bf_lo(a.x), bf_hi(a.x), bf_lo(a.y), bf_hi(a.y), bf_lo(a.z), bf_hi(a.z), bf_lo(a.w), bf_hi(a.w)};
                    if (!last) { const float d[8] = {bf_lo(b.x), bf_hi(b.x), bf_lo(b.y), bf_hi(b.y), bf_lo(b.z), bf_hi(b.z), bf_lo(b.w), bf_hi(b.w)};
#pragma unroll
                        for (int j = 0; j < 8; ++j) f[j] *= __builtin_amdgcn_rcpf(fmaxf(d[j], 1e-20f)); }
                    f32x4 v0 = acc[ai][bj][m][0], v1 = acc[ai][bj][m][1];
                    v0[0] *= f[0]; v0[1] *= f[1]; v0[2] *= f[2]; v0[3] *= f[3]; v1[0] *= f[4]; v1[1] *= f[5]; v1[2] *= f[6]; v1[3] *= f[7];
                    acc[ai][bj][m][0] = v0; acc[ai][bj][m][1] = v1;
                    if (last) { u32x4 w; w.x = cvt_pk_bf16(v0[0], v0[1]); w.y = cvt_pk_bf16(v0[2], v0[3]); w.z = cvt_pk_bf16(v1[0], v1[1]); w.w = cvt_pk_bf16(v1[2], v1[3]);
                        *(u32x4*)(outb + blk_off(row0 + ai * HALF + m * 16, col0 + bj * HALF, ldc)) = w; } } }
        return last;
    }
};

template <class Epi, class Sched, bool ALIGN_EPI = false, bool SP2 = false, bool F8 = false>
__device__ __forceinline__ void gemm_phase(PG8_LAS unsigned char* lds, const Gemm g, const Sched& S, const Epi& E) {
    int tid_o = threadIdx.x; asm volatile("" : "+v"(tid_o));
    const int tid = tid_o, wid = __builtin_amdgcn_readfirstlane(tid >> 6), lane = tid & 63, wr = wid >> 2, wc = wid & 3, fr = lane & 15, fq = lane >> 4;
    const int K = g.K, nt = K / BK;
    unsigned voffA[2], voffB[2];
#pragma unroll
    for (int i = 0; i < 2; ++i) { int R, C; stage_rc(tid * 16 + i * 8192, R, C); const int Rb = Epi::PERM ? ((R & ~31) + perm32(R & 31)) : R;
        voffA[i] = (unsigned)((R >> 6) * (K >> 6) * 4096 + (R & 63) * 64 + C) * 2u; voffB[i] = (unsigned)((Rb >> 6) * (K >> 6) * 4096 + (Rb & 63) * 64 + C) * 2u; }
    const size_t kstep = (size_t)8192;
    const size_t hstep = (size_t)2 * (K >> 6) * 8192;
    const size_t tstep = 2 * hstep;
    const unsigned ldsu = (unsigned)(size_t)lds;
    const unsigned ldsw = (unsigned)wid * 1024u;
    const int aoff = lds_byte(wr * 64 + fr, fq * 8), boff = lds_byte(wc * 32 + fr, fq * 8);
#define PG8_SA(b, h) (((b) * 2 + (h)) * HTB)
#define PG8_SB(b, h) ((4 + (b) * 2 + (h)) * HTB)
#define PG8_STAGE(bufoff, gbase, voff) do { _Pragma("unroll") for (int _i = 0; _i < 2; ++_i) { \
        if constexpr (F8) { const unsigned m0v_ = ldsu + (unsigned)(bufoff) + ldsw + (unsigned)_i * 8192u; const char* gb_ = (const char*)(gbase); \
            asm volatile("s_mov_b32 m0, %0\n\ts_nop 0\n\tglobal_load_lds_dwordx4 %1, %2" :: "s"(m0v_), "v"((voff)[_i]), "s"(gb_) : "memory", "m0"); } \
        else __builtin_amdgcn_global_load_lds((const unsigned*)((const char*)(gbase) + (voff)[_i]), (PG8_LAS unsigned*)(lds + (bufoff) + ldsw + _i * 8192), 16, 0, 0); } } while (0)
#define PG8_LDA(dst, b, h) do { if constexpr (F8) { _Pragma("unroll") for (int m = 0; m < 4; ++m) { dst##8[m].lo = *(const PG8_LAS i32x4*)(lds + PG8_SA(b, h) + aoff + m * 2048); dst##8[m].hi = *(const PG8_LAS i32x4*)(lds + PG8_SA(b, h) + aoff + m * 2048 + 1024); } } \
    else { _Pragma("unroll") for (int m = 0; m < 4; ++m) _Pragma("unroll") for (int k = 0; k < 2; ++k) dst[m][k] = *(const PG8_LAS bf16x8*)(lds + PG8_SA(b, h) + aoff + m * 2048 + k * 1024); } } while (0)
#define PG8_LDB(dst, b, h) do { if constexpr (F8) { _Pragma("unroll") for (int n = 0; n < 2; ++n) { dst##8[n].lo = *(const PG8_LAS i32x4*)(lds + PG8_SB(b, h) + boff + n * 2048); dst##8[n].hi = *(const PG8_LAS i32x4*)(lds + PG8_SB(b, h) + boff + n * 2048 + 1024); } } \
    else { _Pragma("unroll") for (int n = 0; n < 2; ++n) _Pragma("unroll") for (int k = 0; k < 2; ++k) dst[n][k] = *(const PG8_LAS bf16x8*)(lds + PG8_SB(b, h) + boff + n * 2048 + k * 1024); } } while (0)
#define PG8_MMA(ai, bj, At, Bt) do { __builtin_amdgcn_s_setprio(1); if constexpr (F8) { _Pragma("unroll") for (int m = 0; m < 4; ++m) _Pragma("unroll") for (int n = 0; n < 2; ++n) \
        acc[ai][bj][m][n] = __builtin_amdgcn_mfma_scale_f32_16x16x128_f8f6f4(Bt##8[n], At##8[m], acc[ai][bj][m][n], 0, 0, 0, 0x7f7f7f7f, 0, 0x7f7f7f7f); } \
    else { _Pragma("unroll") for (int m = 0; m < 4; ++m) _Pragma("unroll") for (int n = 0; n < 2; ++n) _Pragma("unroll") for (int k = 0; k < 2; ++k) \
        acc[ai][bj][m][n] = __builtin_amdgcn_mfma_f32_16x16x32_bf16(Bt[n][k], At[m][k], acc[ai][bj][m][n], 0, 0, 0); } __builtin_amdgcn_s_setprio(0); } while (0)
#define PG8_WAIT_V(n) asm volatile("s_waitcnt vmcnt(" #n ")" ::: "memory")
#define PG8_WAIT_L(n) asm volatile("s_waitcnt lgkmcnt(" #n ")" ::: "memory")
#define PG8_BAR __builtin_amdgcn_s_barrier()
#define PG8_SCHED __builtin_amdgcn_sched_barrier(0)
    Unit cur, nxt; int ui = 0;
    if (!S.next(0, cur)) return;
    f32x4 acc[2][2][4][2];
#pragma unroll
    for (int a = 0; a < 2; ++a)
#pragma unroll
        for (int b = 0; b < 2; ++b)
#pragma unroll
            for (int m = 0; m < 4; ++m)
#pragma unroll
                for (int n = 0; n < 2; ++n) acc[a][b][m][n] = (f32x4){0.f, 0.f, 0.f, 0.f};
    bf16x8 At[4][2], B0[2][2], B1[2][2]; i32x8 At8[4], B08[2], B18[2];
    const char* cA = (const char*)g.A + (size_t)cur.pm * tstep + (size_t)cur.seg * g.segA; const char* cB = (const char*)g.Bt + (size_t)cur.pn * tstep + (size_t)cur.seg * g.segB;
    S.a_ready(cur);
    if constexpr (SP2) {
        PG8_STAGE(PG8_SB(0, 0), cB, voffB); PG8_STAGE(PG8_SB(0, 1), cB + hstep, voffB); PG8_STAGE(PG8_SA(0, 0), cA, voffA); PG8_STAGE(PG8_SA(0, 1), cA + hstep, voffA);
        if (wr == 1) PG8_BAR;
        PG8_WAIT_V(2); PG8_BAR;
        PG8_STAGE(PG8_SB(1, 0), cB + kstep, voffB); PG8_STAGE(PG8_SA(1, 0), cA + kstep, voffA); PG8_STAGE(PG8_SB(1, 1), cB + hstep + kstep, voffB);
        PG8_WAIT_V(6); PG8_BAR;
    } else {
        PG8_STAGE(PG8_SB(0, 0), cB, voffB); PG8_STAGE(PG8_SA(0, 0), cA, voffA); PG8_STAGE(PG8_SB(0, 1), cB + hstep, voffB); PG8_STAGE(PG8_SA(0, 1), cA + hstep, voffA);
        if (wr == 1) PG8_BAR;
        PG8_WAIT_V(4); PG8_BAR;
        PG8_STAGE(PG8_SB(1, 0), cB + kstep, voffB); PG8_STAGE(PG8_SA(1, 0), cA + kstep, voffA); PG8_STAGE(PG8_SB(1, 1), cB + hstep + kstep, voffB);
        PG8_WAIT_V(6); PG8_BAR;
    }
    for (;;) {
        const bool has_next = S.next(ui + 1, nxt);
        const char* nA = has_next ? (const char*)g.A + (size_t)nxt.pm * tstep + (size_t)nxt.seg * g.segA : cA; const char* nB = has_next ? (const char*)g.Bt + (size_t)nxt.pn * tstep + (size_t)nxt.seg * g.segB : cB;
        for (int t = 0; t < nt; t += 2) {
            const bool last = (t == nt - 2);
            const char* a1 = cA + (size_t)(t + 1) * kstep;
            const char* a2 = last ? nA : cA + (size_t)(t + 2) * kstep; const char* b2 = last ? nB : cB + (size_t)(t + 2) * kstep;
            const char* a3 = a2 + kstep; const char* b3 = b2 + kstep;
            if (last && has_next) S.a_ready(nxt);
            if constexpr (SP2) {
            PG8_LDB(B0, 0, 0); PG8_LDB(B1, 0, 1); PG8_SCHED; PG8_LDA(At, 0, 0); PG8_STAGE(PG8_SA(1, 1), a1 + hstep, voffA);
            PG8_WAIT_V(8); PG8_WAIT_L(0); PG8_BAR; PG8_MMA(0, 0, At, B0); PG8_MMA(0, 1, At, B1); PG8_BAR; PG8_SCHED;
            PG8_LDA(At, 0, 1); PG8_STAGE(PG8_SB(0, 0), b2, voffB); PG8_STAGE(PG8_SB(0, 1), b2 + hstep, voffB); PG8_STAGE(PG8_SA(0, 0), a2, voffA);
            PG8_WAIT_V(8); PG8_WAIT_L(0); PG8_BAR; PG8_MMA(1, 0, At, B0); PG8_MMA(1, 1, At, B1); PG8_BAR; PG8_SCHED;
            PG8_LDB(B0, 1, 0); PG8_LDB(B1, 1, 1); PG8_SCHED; PG8_LDA(At, 1, 0); PG8_STAGE(PG8_SA(0, 1), a2 + hstep, voffA);
            PG8_WAIT_V(8); PG8_WAIT_L(0); PG8_BAR; PG8_MMA(0, 0, At, B0); PG8_MMA(0, 1, At, B1); PG8_BAR; PG8_SCHED;
            PG8_LDA(At, 1, 1); PG8_STAGE(PG8_SB(1, 0), b3, voffB); PG8_STAGE(PG8_SB(1, 1), b3 + hstep, voffB); PG8_STAGE(PG8_SA(1, 0), a3, voffA);
            PG8_WAIT_V(8); PG8_WAIT_L(0); PG8_BAR; PG8_MMA(1, 0, At, B0); PG8_MMA(1, 1, At, B1); PG8_BAR; PG8_SCHED;
            } else {
            PG8_LDB(B0, 0, 0); PG8_SCHED; PG8_LDA(At, 0, 0); PG8_STAGE(PG8_SA(1, 1), a1 + hstep, voffA);
            PG8_WAIT_L(8); PG8_BAR; PG8_WAIT_L(0); PG8_MMA(0, 0, At, B0); PG8_BAR; PG8_SCHED;
            PG8_LDB(B1, 0, 1); PG8_STAGE(PG8_SB(0, 0), b2, voffB);
            PG8_BAR; PG8_WAIT_L(0); PG8_MMA(0, 1, At, B1); PG8_BAR;
            PG8_LDA(At, 0, 1); PG8_STAGE(PG8_SA(0, 0), a2, voffA);
            PG8_BAR; PG8_WAIT_L(0); PG8_MMA(1, 0, At, B0); PG8_BAR; PG8_SCHED;
            PG8_STAGE(PG8_SB(0, 1), b2 + hstep, voffB);
            PG8_WAIT_V(6); PG8_BAR; PG8_MMA(1, 1, At, B1); PG8_BAR;
            PG8_LDB(B0, 1, 0); PG8_SCHED; PG8_LDA(At, 1, 0); PG8_STAGE(PG8_SA(0, 1), a2 + hstep, voffA);
            PG8_WAIT_L(8); PG8_BAR; PG8_WAIT_L(0); PG8_MMA(0, 0, At, B0); PG8_BAR; PG8_SCHED;
            PG8_LDB(B1, 1, 1); PG8_STAGE(PG8_SB(1, 0), b3, voffB);
            PG8_BAR; PG8_WAIT_L(0); PG8_MMA(0, 1, At, B1); PG8_BAR;
            PG8_LDA(At, 1, 1); PG8_STAGE(PG8_SA(1, 0), a3, voffA);
            PG8_BAR; PG8_WAIT_L(0); PG8_MMA(1, 0, At, B0); PG8_BAR; PG8_SCHED;
            PG8_STAGE(PG8_SB(1, 1), b3 + hstep, voffB);
            PG8_WAIT_V(6); PG8_BAR; PG8_MMA(1, 1, At, B1); PG8_BAR;
            }
        }
        if constexpr (ALIGN_EPI) { if (wr == 0) PG8_BAR; }
        bool zero_acc = true;
        if constexpr (Epi::SEGMENTED) { zero_acc = E.run(acc, cur, wr, wc, fr, fq); S.done(cur); }
        else if constexpr (!Epi::AFTER_DRAIN) {
            if constexpr (F8) { int t2 = threadIdx.x; asm volatile("" : "+v"(t2));
                const int w2 = __builtin_amdgcn_readfirstlane(t2 >> 6); E(acc, cur, w2 >> 2, w2 & 3, t2 & 15, (t2 & 63) >> 4); }
            else E(acc, cur, wr, wc, fr, fq);
            S.done(cur); }
        if (!has_next) break;
        if (zero_acc) {
#pragma unroll
        for (int a = 0; a < 2; ++a)
#pragma unroll
            for (int b = 0; b < 2; ++b)
#pragma unroll
                for (int m = 0; m < 4; ++m)
#pragma unroll
                    for (int n = 0; n < 2; ++n) acc[a][b][m][n] = (f32x4){0.f, 0.f, 0.f, 0.f};
        }
        cur = nxt; cA = nA; cB = nB; ++ui;
        if constexpr (ALIGN_EPI) { if (wr == 1) PG8_BAR; }
    }
    PG8_WAIT_V(0);
    if constexpr (!ALIGN_EPI) { if (wr == 0) PG8_BAR; }
    PG8_BAR;
    if constexpr (Epi::AFTER_DRAIN) { E.fused(acc, cur, wr, wc, fr, fq, lds, wid, lane); S.done(cur); }
#undef PG8_SA
#undef PG8_SB
#undef PG8_STAGE
#undef PG8_LDA
#undef PG8_LDB
#undef PG8_MMA
#undef PG8_WAIT_V
#undef PG8_WAIT_L
#undef PG8_BAR
#undef PG8_SCHED
}
}

constexpr int NWAVES = 8;
constexpr int NB = 4, SEQ = 2048, NTOK = NB * SEQ, DM = 2048, DEPTH = 4;
constexpr int DFF = 5632, NWI = 2 * DFF;
constexpr int NPROJ_SRC = 10512, NPROJ = 10752;
constexpr int C_QA = 0, C_KA = 768, C_VA = 1024, C_PU = 1280, C_QG = 2048, C_KG = 2432, C_VG = 2816, C_OG = 3584, C_LR = 4352, C_GATE = 4608;
constexpr int GATE_TILE0 = C_GATE / 256;
constexpr int BRW = 768;
constexpr float EPS = 1e-6f;

constexpr size_t MiB = 1u << 20;
constexpr size_t WS_CTL = 0, CTL_ZERO_BYTES = 1 * MiB;
constexpr size_t SZ_WI = (size_t)NWI * DM * 2, SZ_WO = (size_t)DM * DFF * 2, SZ_WIN = (size_t)NPROJ * DM * 2, SZ_WBR = (size_t)3 * DM * BRW * 2, SZ_WOUT = (size_t)DM * DM * 2;
constexpr size_t LW_WI1 = 0, LW_WO1 = LW_WI1 + SZ_WI, LW_WIN = LW_WO1 + SZ_WO, LW_WBR = LW_WIN + SZ_WIN, LW_WOUT = LW_WBR + SZ_WBR, LW_WI2 = LW_WOUT + SZ_WOUT, LW_WO2 = LW_WI2 + SZ_WI, LW_END = LW_WO2 + SZ_WO;
constexpr size_t WS_W = 2 * MiB;
constexpr size_t WS_X = ((WS_W + DEPTH * LW_END + MiB - 1) / MiB) * MiB;
constexpr size_t WS_H = WS_X + (size_t)NTOK * DM * 4;
constexpr size_t WS_ACT = WS_H + (size_t)NTOK * DM * 2;
constexpr size_t WS_PROJ = WS_ACT + (size_t)NTOK * DFF * 2;
constexpr size_t WS_Y = WS_PROJ + (size_t)NTOK * NPROJ * 2;
constexpr size_t WS_MACC = WS_Y + (size_t)3 * NTOK * BRW * 2;
constexpr size_t WS_MB = WS_MACC + (size_t)NTOK * DM * 4;
constexpr size_t WS_GO = WS_MB + (size_t)NTOK * DM * 2;
constexpr size_t WS_ROPE = WS_GO + (size_t)NTOK * BRW * 4;
constexpr size_t WS_GPRE = WS_ROPE + (size_t)2 * NTOK * 32 * 4;
constexpr size_t WS_WPT = WS_GPRE + (size_t)512 * 57856;
constexpr size_t WS_END = WS_WPT + (size_t)DEPTH * 4 * 192 * 192 * 2;
constexpr int CW_BAR = 4096;
constexpr size_t CTL_SSQ = 65536; static_assert(CTL_SSQ + (size_t)13 * 8192 * 8 <= CTL_ZERO_BYTES, "SSQ inside the zeroed CTL region");

constexpr int RING_OFF = 0, RING_BYTES = 131072;
constexpr int LDSCTL_OFF = RING_BYTES, MISC_OFF = LDSCTL_OFF + 320;
constexpr int LDS_BYTES = 147456;

#define GAS __attribute__((address_space(1)))
#define LAS __attribute__((address_space(3)))
typedef unsigned short bf16;
typedef unsigned v4u __attribute__((ext_vector_type(4)));
typedef float f32x4 __attribute__((ext_vector_type(4)));
#define LDS_WAIT() asm volatile("s_waitcnt lgkmcnt(0)" ::: "memory")
__device__ __forceinline__ unsigned f2bf(float f) { unsigned u = __builtin_bit_cast(unsigned, f); return (u + 0x7fffu + ((u >> 16) & 1u)) >> 16; }
__device__ __forceinline__ unsigned pk2(float lo, float hi) { return f2bf(lo) | (f2bf(hi) << 16); }
__device__ __forceinline__ float bf2f(bf16 b) { return __uint_as_float(((unsigned)b) << 16); }
__device__ __forceinline__ float bflo(unsigned w) { return __uint_as_float(w << 16); }
__device__ __forceinline__ float bfhi(unsigned w) { return __uint_as_float(w & 0xffff0000u); }
__device__ __forceinline__ float wave_sum(float v) {
#pragma unroll
    for (int o = 1; o < 64; o <<= 1) v += __shfl_xor(v, o);
    return v;
}

#define XB_TMO      128
#define XB_XCNT(j)  (256  + 64 * (j))
#define XB_XSUB(j)  (1280 + 64 * (j))
#define XB_XGEN(j)  (2304 + 64 * (j))
#define XB_TOP      3328
#define XB_TOPGEN   3392
#define XCD_BAR_WORDS 3456
#define XB_SPIN_CAP (1u << 18)

__device__ __forceinline__ unsigned xb_ld(unsigned* p)              { return __hip_atomic_load(p, __ATOMIC_RELAXED, __HIP_MEMORY_SCOPE_AGENT); }
__device__ __forceinline__ unsigned xb_add(unsigned* p, unsigned v) { return __hip_atomic_fetch_add(p, v, __ATOMIC_RELAXED, __HIP_MEMORY_SCOPE_AGENT); }
__device__ __forceinline__ unsigned xb_xcc_id() { return (unsigned)__builtin_amdgcn_s_getreg((3 << 11) | 20) & 0xFu; }
#define XB_SPIN(cond, bar) do { unsigned _sp = 0; while (cond) { __builtin_amdgcn_s_sleep(1); \
    if ((++_sp & 255u) == 0u) { if (xb_ld(&(bar)[XB_TMO])) break; if (_sp > XB_SPIN_CAP) { atomicAdd(&(bar)[XB_TMO], 1u); break; } } } } while (0)

struct XcdBarrier {
    unsigned* bar; unsigned x;
    volatile LAS unsigned* st;
};

__device__ __forceinline__ XcdBarrier xcd_barrier_post(unsigned* bar, volatile LAS unsigned* st) {
    XcdBarrier b; b.bar = bar; b.x = xb_xcc_id(); b.st = st;
    if (threadIdx.x == 0) (void)xb_add(&bar[XB_XCNT(b.x)], 1u);
    return b;
}
__device__ __forceinline__ void xcd_barrier_complete(unsigned* bar, unsigned x, unsigned& nloc, unsigned& nx) {
    const unsigned G = gridDim.x * gridDim.y * gridDim.z;
    unsigned sum, cnt, mine, sp = 0u;
    for (;;) {
        sum = 0u; cnt = 0u; mine = 0u;
#pragma unroll
        for (unsigned j = 0; j < 16; ++j) { const unsigned c = xb_ld(&bar[XB_XCNT(j)]); sum += c; cnt += (c > 0u) ? 1u : 0u; mine = (j == x) ? c : mine; }
        if (sum == G) break;
        __builtin_amdgcn_s_sleep(1);
        if ((++sp & 255u) == 0u) { if (xb_ld(&bar[XB_TMO])) break; if (sp > XB_SPIN_CAP) { atomicAdd(&bar[XB_TMO], 1u); break; } }
    }
    nloc = mine > 0u ? mine : 1u; nx = cnt > 0u ? cnt : 1u;
}

__device__ __forceinline__ void xcd_barrier(const XcdBarrier& b) {
    asm volatile("s_waitcnt vmcnt(0)" ::: "memory");
    __syncthreads();
    if (threadIdx.x == 0) {
        unsigned* bar = b.bar; const unsigned bx_ = xb_xcc_id();
        __builtin_amdgcn_s_waitcnt(0);
        unsigned nloc = b.st[0], nx = b.st[1];
        if (nloc == 0u) { xcd_barrier_complete(bar, bx_, nloc, nx); b.st[0] = nloc; b.st[1] = nx; }
        const unsigned old = xb_add(&bar[XB_XSUB(bx_)], 1u);
        const unsigned gen = old / nloc;
        if (old + 1u == (gen + 1u) * nloc) {
            __builtin_amdgcn_fence(__ATOMIC_RELEASE, "agent");
            asm volatile("s_waitcnt vmcnt(0)" ::: "memory");
            const unsigned og = xb_add(&bar[XB_TOP], 1u);
            const unsigned tg = og / nx;
            if (og + 1u == (tg + 1u) * nx) xb_add(&bar[XB_TOPGEN], 1u);
            else XB_SPIN(xb_ld(&bar[XB_TOPGEN]) == tg, bar);
            __builtin_amdgcn_fence(__ATOMIC_ACQUIRE, "agent");
            xb_add(&bar[XB_XGEN(bx_)], 1u);
            asm volatile("s_waitcnt vmcnt(0)" ::: "memory");
        } else {
            XB_SPIN(xb_ld(&bar[XB_XGEN(bx_)]) == gen, bar);
            __builtin_amdgcn_fence(__ATOMIC_ACQUIRE, "agent");
            asm volatile("s_waitcnt vmcnt(0)" ::: "memory");
        }
    }
    __syncthreads();
}


template <int MAP> __device__ __forceinline__ int map_row(int n) {
    if (MAP == 1) { const int isb = n >= DFF ? 1 : 0; const int h = n - isb * DFF; return (h >> 7) * 256 + isb * 128 + (h & 127); }
    if (MAP == 2) return n < 4368 ? n : n + 240;
    return n;
}
struct TrJob { const float* W; bf16* WT; const float* gain; int K, N, map; };
constexpr int GATE_SRC0 = 4368;
constexpr size_t WIN8_OFF = (size_t)C_GATE * DM * 2;
__device__ __forceinline__ int map_row_rt(int map, int n) { return map == 1 ? map_row<1>(n) : (map == 2 ? map_row<2>(n) : n); }
__device__ __forceinline__ void tr_load(const TrJob& jb, int tile, int tid, f32x4 (&v)[8][2], int& k0, int& n0) {
    const int nblk = (jb.N + 127) / 128, kt = tile / nblk, nt = tile - kt * nblk; k0 = 256 * kt; n0 = 128 * nt;
    const int c4 = (tid & 15) + 16 * ((tid >> 6) & 1), rp = ((tid >> 4) & 3) + 4 * (tid >> 7);
    int col = n0 + 4 * c4; col = col < jb.N - 4 ? col : jb.N - 4;
    const float* wp = jb.W + (size_t)(k0 + 2 * rp) * jb.N + col;
#pragma unroll
    for (int i = 0; i < 8; ++i) { v[i][0] = *(const f32x4*)(wp + (size_t)(32 * i) * jb.N); v[i][1] = *(const f32x4*)(wp + (size_t)(32 * i + 1) * jb.N); }
    if (jb.gain) {
#pragma unroll
        for (int i = 0; i < 8; ++i) { const float ga = jb.gain[k0 + 32 * i + 2 * rp], gb = jb.gain[k0 + 32 * i + 2 * rp + 1]; v[i][0] = v[i][0] * ga; v[i][1] = v[i][1] * gb; } }
}
__device__ __forceinline__ void tr_to_lds(LAS unsigned* T, int tid, const f32x4 (&v)[8][2]) {
    const int c4 = (tid & 15) + 16 * ((tid >> 6) & 1), rp = ((tid >> 4) & 3) + 4 * (tid >> 7);
#pragma unroll
    for (int i = 0; i < 8; ++i)
#pragma unroll
        for (int j = 0; j < 4; ++j) T[(4 * c4 + j) * 132 + 16 * i + rp] = pk2(v[i][0][j], v[i][1][j]);
}
__device__ __forceinline__ void tr_store(const TrJob& jb, const LAS unsigned* T, int tid, int k0, int n0) {
    const int w = tid >> 6, lane = tid & 63, c = 8 * (w >> 1) + (lane & 7), nb = 64 * (w & 1) + (lane >> 3);
#pragma unroll
    for (int j = 0; j < 8; ++j) { const int n = nb + 8 * j; const v4u o = *(const LAS v4u*)(T + n * 132 + 4 * c);
        if (n0 + n < jb.N) {
            if (jb.map == 2 && n0 + n >= GATE_SRC0) {
                typedef unsigned v2u_ __attribute__((ext_vector_type(2))); v2u_ q;
                q.x = pg8::cvt_pk4_fp8(bflo(o.x) * 256.f, bfhi(o.x) * 256.f, bflo(o.y) * 256.f, bfhi(o.y) * 256.f); q.y = pg8::cvt_pk4_fp8(bflo(o.z) * 256.f, bfhi(o.z) * 256.f, bflo(o.w) * 256.f, bfhi(o.w) * 256.f);
                *(v2u_*)((unsigned char*)jb.WT + WIN8_OFF + pg8::blk8_off(n0 + n - GATE_SRC0, k0 + 8 * c, jb.K)) = q; }
            else *(v4u*)(jb.WT + pg8::blk_off(map_row_rt(jb.map, n0 + n), k0 + 8 * c, jb.K)) = o; } }
}

struct Args { const void* in[22]; float* out; unsigned char* ws; };

constexpr int TL_WI1 = 0, TL_WO1 = 704, TL_WIN = 1056, TL_BRA = 1720, TL_BRP = 1768, TL_BRG = 1816, TL_WOUT = 1864, TL_WI2 = 1992, TL_WO2 = 2696, TL_LAYER = 3048, TL_ALL = DEPTH * TL_LAYER;
constexpr int CW_CLAIM = 8192;
__device__ __forceinline__ void conv_job(const Args& A, int T, TrJob& jb, int& t) {
    const int l = T / TL_LAYER, r = T - l * TL_LAYER;
    unsigned char* wl = A.ws + WS_W + (size_t)l * LW_END;
    if (r < TL_WO1)       { jb = TrJob{(const float*)A.in[3] + (size_t)l * DM * NWI, (bf16*)(wl + LW_WI1), (const float*)A.in[2] + (size_t)l * DM, DM, NWI, 1}; t = r; }
    else if (r < TL_WIN)  { jb = TrJob{(const float*)A.in[4] + (size_t)l * DFF * DM, (bf16*)(wl + LW_WO1), nullptr, DFF, DM, 0}; t = r - TL_WO1; }
    else if (r < TL_BRA)  { jb = TrJob{(const float*)A.in[6] + (size_t)l * DM * NPROJ_SRC, (bf16*)(wl + LW_WIN), (const float*)A.in[5] + (size_t)l * DM, DM, NPROJ_SRC, 2}; t = r - TL_WIN; }
    else if (r < TL_BRP)  { jb = TrJob{(const float*)A.in[14] + (size_t)l * BRW * DM, (bf16*)(wl + LW_WBR), nullptr, BRW, DM, 0}; t = r - TL_BRA; }
    else if (r < TL_BRG)  { jb = TrJob{(const float*)A.in[15] + (size_t)l * BRW * DM, (bf16*)(wl + LW_WBR) + (size_t)DM * BRW, nullptr, BRW, DM, 0}; t = r - TL_BRP; }
    else if (r < TL_WOUT) { jb = TrJob{(const float*)A.in[16] + (size_t)l * BRW * DM, (bf16*)(wl + LW_WBR) + (size_t)2 * DM * BRW, nullptr, BRW, DM, 0}; t = r - TL_BRG; }
    else if (r < TL_WI2)  { jb = TrJob{(const float*)A.in[17] + (size_t)l * DM * DM, (bf16*)(wl + LW_WOUT), nullptr, DM, DM, 0}; t = r - TL_WOUT; }
    else if (r < TL_WO2)  { jb = TrJob{(const float*)A.in[19] + (size_t)l * DM * NWI, (bf16*)(wl + LW_WI2), (const float*)A.in[18] + (size_t)l * DM, DM, NWI, 1}; t = r - TL_WI2; }
    else                  { jb = TrJob{(const float*)A.in[20] + (size_t)l * DFF * DM, (bf16*)(wl + LW_WO2), nullptr, DFF, DM, 0}; t = r - TL_WO2; }
}
__device__ __forceinline__ unsigned conv_claim(unsigned* ctr, volatile LAS unsigned* slot, int limit, int extra, unsigned known, bool peek) {
    if (peek) known = __hip_atomic_load(ctr, __ATOMIC_RELAXED, __HIP_MEMORY_SCOPE_AGENT);
    const bool need = (int)known < limit, opt = !need && extra > 0 && (int)known < TL_ALL;
    unsigned T = 0xffffffffu;
    if (need || opt) { T = __hip_atomic_fetch_add(ctr, 1u, __ATOMIC_RELAXED, __HIP_MEMORY_SCOPE_AGENT); known = T + 1u; if ((int)T >= TL_ALL) T = 0xffffffffu; }
    slot[0] = T; slot[1] = need ? 0u : 1u;
    return known;
}
__device__ __forceinline__ void conv_until(const Args& A, LAS unsigned char* lds, int limit, int extra) {
    unsigned* ctr = (unsigned*)(A.ws + WS_CTL) + CW_CLAIM; volatile LAS unsigned* slot = (volatile LAS unsigned*)(lds + MISC_OFF) + 16;
    LAS unsigned* Tl = (LAS unsigned*)(lds + RING_OFF);
    if (limit > TL_ALL) limit = TL_ALL;
    int tid = threadIdx.x; asm volatile("" : "+v"(tid));
    unsigned known = 0u;
    if (tid == 0) known = conv_claim(ctr, slot, limit, extra, 0u, true);
    __syncthreads();
    unsigned T = slot[0]; if (slot[1]) --extra;
    __syncthreads();
    if (T == 0xffffffffu) return;
    f32x4 v[8][2]; TrJob jb; int t, k0, n0;
    conv_job(A, (int)T, jb, t); tr_load(jb, t, tid, v, k0, n0);
#pragma unroll 1
    for (;;) {
        tr_to_lds(Tl, tid, v);
        if (tid == 0) known = conv_claim(ctr, slot, limit, extra, known, false);
        __syncthreads();
        const unsigned Tn = slot[0]; if (slot[1]) --extra;
        const TrJob cj = jb; const int ck0 = k0, cn0 = n0;
        if (Tn != 0xffffffffu) { conv_job(A, (int)Tn, jb, t); tr_load(jb, t, tid, v, k0, n0); }
        tr_store(cj, Tl, tid, ck0, cn0);
        __syncthreads();
        if (Tn == 0xffffffffu) break;
    }
}

__device__ __forceinline__ void p0_prologue(const Args& A, LAS unsigned char* lds, int gw, int NGW, int wave, int lane) {
    for (int i = gw * 64 + lane; i < DEPTH * 240 * DM / 8; i += NGW * 64) { const int l = i / (240 * DM / 8), j = i - l * (240 * DM / 8);
        *(v4u*)((bf16*)(A.ws + WS_W + (size_t)l * LW_END + LW_WIN) + pg8::blk_off(4368 + (j >> 8), 8 * (j & 255), DM)) = (v4u){0u, 0u, 0u, 0u}; }
    { const float* x = (const float*)A.in[0]; bf16* XB = (bf16*)(A.ws + WS_H); unsigned long long* ssq0 = (unsigned long long*)(A.ws + WS_CTL + CTL_SSQ);
      for (int r = gw; r < NTOK; r += NGW) { const f32x4* xr = (const f32x4*)(x + (size_t)r * DM); float sq = 0.f;
#pragma unroll
          for (int j = 0; j < 4; ++j) { const f32x4 a = xr[j * 128 + lane * 2], b = xr[j * 128 + lane * 2 + 1];
              sq += (a.x * a.x + a.y * a.y) + (a.z * a.z + a.w * a.w) + (b.x * b.x + b.y * b.y) + (b.z * b.z + b.w * b.w);
              v4u o; o.x = pk2(a.x, a.y); o.y = pk2(a.z, a.w); o.z = pk2(b.x, b.y); o.w = pk2(b.z, b.w);
              *(v4u*)(XB + pg8::blk_off(r, j * 512 + lane * 8, DM)) = o; }
          sq = wave_sum(sq); if (lane == 0) ssq0[r] = (unsigned long long)(sq * 1048576.0f + 0.5f); } }
    { const float* wp = (const float*)A.in[9]; const float* ps = (const float*)A.in[10]; bf16* wpt = (bf16*)(A.ws + WS_WPT);
      for (int i = gw * 64 + lane; i < DEPTH * 4 * 192 * 192; i += NGW * 64) { const int cc = i % 192, d = (i / 192) % 192, lg = i / (192 * 192);
          wpt[i] = (bf16)f2bf(wp[((size_t)lg * 192 + cc) * 192 + d] * ps[lg * 192 + d]); } }
    const int* pos = (const int*)A.in[1];
    float* cs = (float*)(A.ws + WS_ROPE); float* sn = cs + (size_t)NTOK * 32;
    for (int i = gw * 64 + lane; i < NTOK * 32; i += NGW * 64) { const int t = i >> 5, f = i & 31;
        const double inv = exp(-(double)f * (9.210340371976184 / 32.0));
        const double ang = (double)pos[t] * inv; cs[i] = (float)cos(ang); sn[i] = (float)sin(ang); }
}

__device__ __forceinline__ void rmsnorm_phase(const float* X, const float* g, bf16* H, int gw, int NGW, int lane) {
    asm volatile("" : "+v"(lane));
    for (int r = gw; r < NTOK; r += NGW) {
        const f32x4* xr = (const f32x4*)(X + (size_t)r * DM);
        f32x4 v[8]; float s = 0.f;
#pragma unroll
        for (int j = 0; j < 4; ++j) { v[2 * j] = xr[j * 128 + lane * 2]; v[2 * j + 1] = xr[j * 128 + lane * 2 + 1]; }
#pragma unroll
        for (int j = 0; j < 8; ++j) s += (v[j].x * v[j].x + v[j].y * v[j].y) + (v[j].z * v[j].z + v[j].w * v[j].w);
        const float rstd = 1.0f / sqrtf(wave_sum(s) * (1.0f / DM) + EPS);
#pragma unroll
        for (int j = 0; j < 4; ++j) { const f32x4 g0 = ((const f32x4*)g)[j * 128 + lane * 2], g1 = ((const f32x4*)g)[j * 128 + lane * 2 + 1];
            const f32x4 a = v[2 * j] * rstd * g0, b = v[2 * j + 1] * rstd * g1;
            v4u o; o.x = pk2(a.x, a.y); o.y = pk2(a.z, a.w); o.z = pk2(b.x, b.y); o.w = pk2(b.z, b.w);
            *(v4u*)(H + (size_t)r * DM + j * 512 + lane * 8) = o; }
    }
}
__device__ __forceinline__ void final_phase(const bf16* XB, const unsigned long long* ssq, const float* g, float* out, int gw, int NGW, int lane) {
    asm volatile("" : "+v"(lane));
    for (int r = gw; r < NTOK; r += NGW) {
        const float rstd = pg8::rstd_of(ssq[r]);
#pragma unroll
        for (int j = 0; j < 4; ++j) { const int c0 = j * 512 + lane * 8; const v4u x = *(const v4u*)(XB + pg8::blk_off(r, c0, DM));
            const f32x4 g0 = *(const f32x4*)(g + c0), g1 = *(const f32x4*)(g + c0 + 4);
            *(f32x4*)(out + (size_t)r * DM + c0) = (f32x4){bflo(x.x), bfhi(x.x), bflo(x.y), bfhi(x.y)} * rstd * g0;
            *(f32x4*)(out + (size_t)r * DM + c0 + 4) = (f32x4){bflo(x.z), bfhi(x.z), bflo(x.w), bfhi(x.w)} * rstd * g1; }
    }
}

typedef short bf16x8_t __attribute__((ext_vector_type(8)));
typedef unsigned v2u __attribute__((ext_vector_type(2)));
__device__ __forceinline__ void att_unit(LAS unsigned char* lds, const bf16* PROJ, const float* COS, const float* SIN, const float* sinks, bf16* YA, int u) {
    int tid = threadIdx.x; asm volatile("" : "+v"(tid));
    const int b = u >> 6, kvh = (u >> 4) & 3, blk = u & 15;
    LAS bf16* Ks = (LAS bf16*)lds;
    LAS bf16* VT = Ks + 256 * 72;
    const int tok0 = b * SEQ + 128 * (blk - 1);
    const int kk0 = blk == 0 ? 128 : 0;
    for (int idx = tid; idx < 256 * 4; idx += 512) { const int kk = idx >> 2, c4 = idx & 3;
        v4u w1 = (v4u){0u, 0u, 0u, 0u}, w2 = w1;
        if (kk >= kk0) { const size_t t = (size_t)(tok0 + kk);
            const v4u lo = *(const v4u*)(PROJ + t * NPROJ + C_KA + kvh * 64 + 8 * c4), hi = *(const v4u*)(PROJ + t * NPROJ + C_KA + kvh * 64 + 32 + 8 * c4);
            const f32x4 c0 = *(const f32x4*)(COS + t * 32 + 8 * c4), c1 = *(const f32x4*)(COS + t * 32 + 8 * c4 + 4), s0 = *(const f32x4*)(SIN + t * 32 + 8 * c4), s1 = *(const f32x4*)(SIN + t * 32 + 8 * c4 + 4);
            const float x1[8] = {bflo(lo.x), bfhi(lo.x), bflo(lo.y), bfhi(lo.y), bflo(lo.z), bfhi(lo.z), bflo(lo.w), bfhi(lo.w)};
            const float x2[8] = {bflo(hi.x), bfhi(hi.x), bflo(hi.y), bfhi(hi.y), bflo(hi.z), bfhi(hi.z), bflo(hi.w), bfhi(hi.w)};
            const float cc[8] = {c0.x, c0.y, c0.z, c0.w, c1.x, c1.y, c1.z, c1.w}, ss[8] = {s0.x, s0.y, s0.z, s0.w, s1.x, s1.y, s1.z, s1.w};
            float q1[8], q2[8];
#pragma unroll
            for (int j = 0; j < 8; ++j) { q1[j] = x1[j] * cc[j] - x2[j] * ss[j]; q2[j] = x2[j] * cc[j] + x1[j] * ss[j]; }
            w1.x = pk2(q1[0], q1[1]); w1.y = pk2(q1[2], q1[3]); w1.z = pk2(q1[4], q1[5]); w1.w = pk2(q1[6], q1[7]);
            w2.x = pk2(q2[0], q2[1]); w2.y = pk2(q2[2], q2[3]); w2.z = pk2(q2[4], q2[5]); w2.w = pk2(q2[6], q2[7]); }
        *(LAS v4u*)(Ks + kk * 72 + 8 * c4) = w1; *(LAS v4u*)(Ks + kk * 72 + 32 + 8 * c4) = w2; }
    for (int idx = tid; idx < 256 * 8; idx += 512) { const int ch = idx >> 8, kk = idx & 255;
        v4u w = (v4u){0u, 0u, 0u, 0u};
        if (kk >= kk0) w = *(const v4u*)(PROJ + (size_t)(tok0 + kk) * NPROJ + C_VA + kvh * 64 + ch * 8);
        LAS bf16* vp = VT + (ch * 8) * 264 + kk;
        vp[0 * 264] = (bf16)(w.x & 0xffffu); vp[1 * 264] = (bf16)(w.x >> 16); vp[2 * 264] = (bf16)(w.y & 0xffffu); vp[3 * 264] = (bf16)(w.y >> 16);
        vp[4 * 264] = (bf16)(w.z & 0xffffu); vp[5 * 264] = (bf16)(w.z >> 16); vp[6 * 264] = (bf16)(w.w & 0xffffu); vp[7 * 264] = (bf16)(w.w >> 16); }
    const int wave = __builtin_amdgcn_readfirstlane(tid >> 6), lane = tid & 63, g = lane >> 4, c = lane & 15;
    v4u qlo, qhi, nlo, nhi; f32x4 qc0, qc1, qs0, qs1, nc0, nc1, ns0, ns1;
#define ATT_LOADQ(LO, HI, C0, C1, S0, S1, ti_) do { const int id_ = 3 * wave + (ti_), hq_ = kvh * 3 + (id_ >> 3); const size_t t_ = (size_t)(b * SEQ + 128 * blk + 16 * (id_ & 7) + c); \
        LO = *(const v4u*)(PROJ + t_ * NPROJ + C_QA + hq_ * 64 + 8 * g); HI = *(const v4u*)(PROJ + t_ * NPROJ + C_QA + hq_ * 64 + 32 + 8 * g); \
        C0 = *(const f32x4*)(COS + t_ * 32 + 8 * g); C1 = *(const f32x4*)(COS + t_ * 32 + 8 * g + 4); S0 = *(const f32x4*)(SIN + t_ * 32 + 8 * g); S1 = *(const f32x4*)(SIN + t_ * 32 + 8 * g + 4); } while (0)
    ATT_LOADQ(qlo, qhi, qc0, qc1, qs0, qs1, 0);
    __syncthreads();
#pragma unroll 1
    for (int ti = 0; ti < 3; ++ti) {
        const int id = 3 * wave + ti, gq = id >> 3, qt = id & 7, hq = kvh * 3 + gq, qi = 16 * qt + c, kb0 = qt >> 1;
        const size_t t = (size_t)(b * SEQ + 128 * blk + qi);
        if (ti + 1 < 3) ATT_LOADQ(nlo, nhi, nc0, nc1, ns0, ns1, ti + 1);
        bf16x8_t qb[2];
        { const float x1[8] = {bflo(qlo.x), bfhi(qlo.x), bflo(qlo.y), bfhi(qlo.y), bflo(qlo.z), bfhi(qlo.z), bflo(qlo.w), bfhi(qlo.w)};
          const float x2[8] = {bflo(qhi.x), bfhi(qhi.x), bflo(qhi.y), bfhi(qhi.y), bflo(qhi.z), bfhi(qhi.z), bflo(qhi.w), bfhi(qhi.w)};
          const float cc[8] = {qc0.x, qc0.y, qc0.z, qc0.w, qc1.x, qc1.y, qc1.z, qc1.w}, ss[8] = {qs0.x, qs0.y, qs0.z, qs0.w, qs1.x, qs1.y, qs1.z, qs1.w};
          float q1[8], q2[8];
#pragma unroll
          for (int j = 0; j < 8; ++j) { q1[j] = (x1[j] * cc[j] - x2[j] * ss[j]) * 0.125f; q2[j] = (x2[j] * cc[j] + x1[j] * ss[j]) * 0.125f; }
          v4u w1, w2; w1.x = pk2(q1[0], q1[1]); w1.y = pk2(q1[2], q1[3]); w1.z = pk2(q1[4], q1[5]); w1.w = pk2(q1[6], q1[7]);
          w2.x = pk2(q2[0], q2[1]); w2.y = pk2(q2[2], q2[3]); w2.z = pk2(q2[4], q2[5]); w2.w = pk2(q2[6], q2[7]);
          qb[0] = __builtin_bit_cast(bf16x8_t, w1); qb[1] = __builtin_bit_cast(bf16x8_t, w2); }
        bf16x8_t kf[10][2];
#pragma unroll
        for (int kt = 0; kt < 10; ++kt)
#pragma unroll
            for (int ks = 0; ks < 2; ++ks) kf[kt][ks] = *(const LAS bf16x8_t*)(Ks + (32 * kb0 + 16 * kt + c) * 72 + 32 * ks + 8 * g);
        __builtin_amdgcn_sched_barrier(0);
        f32x4 st[10];
#pragma unroll
        for (int kt = 0; kt < 10; ++kt) { f32x4 acc = (f32x4){0.f, 0.f, 0.f, 0.f};
#pragma unroll
            for (int ks = 0; ks < 2; ++ks) acc = __builtin_amdgcn_mfma_f32_16x16x32_bf16(kf[kt][ks], qb[ks], acc, 0, 0, 0);
            st[kt] = acc; }
        v2u vlo[5][4], vhi[5][4];
#pragma unroll
        for (int ks = 0; ks < 5; ++ks)
#pragma unroll
            for (int dt = 0; dt < 4; ++dt) { const LAS bf16* vr = VT + (16 * dt + c) * 264 + 32 * (kb0 + ks) + 4 * g; vlo[ks][dt] = *(const LAS v2u*)vr; vhi[ks][dt] = *(const LAS v2u*)(vr + 16); }
        const float sink = sinks[hq];
        float m = sink;
#pragma unroll
        for (int kt = 0; kt < 10; ++kt)
#pragma unroll
            for (int r = 0; r < 4; ++r) { const int kk = 32 * kb0 + 16 * kt + 4 * g + r; const bool ok = (kk >= qi + 1) && (kk <= qi + 128) && (kk >= kk0);
                st[kt][r] = ok ? st[kt][r] : -1e30f; m = fmaxf(m, st[kt][r]); }
        m = fmaxf(m, __shfl_xor(m, 16)); m = fmaxf(m, __shfl_xor(m, 32));
        float l = 0.f;
#pragma unroll
        for (int kt = 0; kt < 10; ++kt)
#pragma unroll
            for (int r = 0; r < 4; ++r) { const float p = (st[kt][r] > -1e29f) ? __expf(st[kt][r] - m) : 0.f; st[kt][r] = p; l += p; }
        l += __shfl_xor(l, 16); l += __shfl_xor(l, 32);
        l += __expf(sink - m);
        f32x4 o[4];
#pragma unroll
        for (int dt = 0; dt < 4; ++dt) o[dt] = (f32x4){0.f, 0.f, 0.f, 0.f};
#pragma unroll
        for (int ks = 0; ks < 5; ++ks) { v4u pw; pw.x = pk2(st[2 * ks][0], st[2 * ks][1]); pw.y = pk2(st[2 * ks][2], st[2 * ks][3]); pw.z = pk2(st[2 * ks + 1][0], st[2 * ks + 1][1]); pw.w = pk2(st[2 * ks + 1][2], st[2 * ks + 1][3]);
            const bf16x8_t pb = __builtin_bit_cast(bf16x8_t, pw);
#pragma unroll
            for (int dt = 0; dt < 4; ++dt) { const v4u aw = (v4u){vlo[ks][dt].x, vlo[ks][dt].y, vhi[ks][dt].x, vhi[ks][dt].y};
                o[dt] = __builtin_amdgcn_mfma_f32_16x16x32_bf16(__builtin_bit_cast(bf16x8_t, aw), pb, o[dt], 0, 0, 0); } }
        const float inv = 1.0f / l;
#pragma unroll
        for (int dt = 0; dt < 4; ++dt) { v2u w; w.x = pk2(o[dt][0] * inv, o[dt][1] * inv); w.y = pk2(o[dt][2] * inv, o[dt][3] * inv);
            *(v2u*)(YA + pg8::blk_off((int)t, hq * 64 + 16 * dt + 4 * g, BRW)) = w; }
        qlo = nlo; qhi = nhi; qc0 = nc0; qc1 = nc1; qs0 = ns0; qs1 = ns1;
    }
#undef ATT_LOADQ
    __syncthreads();
}

__device__ __forceinline__ void pool_units(LAS unsigned char* lds, const bf16* PROJ, const bf16* WPT, bf16* YP, int first, int stride, int nunits) {
    int tid = threadIdx.x; asm volatile("" : "+v"(tid));
    if (first >= nunits) return;
    const int gp = first & 3, w = 2 << gp;
    const int wave = __builtin_amdgcn_readfirstlane(tid >> 6), lane = tid & 63, g = lane >> 4, c = lane & 15, mt = wave & 3, nh = wave >> 2;
    LAS float* U = (LAS float*)lds;
    LAS bf16* DA = (LAS bf16*)(U + 79 * 192);
    bf16x8_t wf[6][6];
    { const bf16* wbase = WPT + (size_t)gp * 192 * 192;
#pragma unroll
      for (int ni = 0; ni < 6; ++ni)
#pragma unroll
          for (int ks = 0; ks < 6; ++ks) wf[ni][ks] = *(const bf16x8_t*)(wbase + (size_t)(16 * (6 * nh + ni) + c) * 192 + 32 * ks + 8 * g); }
#pragma unroll 1
    for (int u = first; u < nunits; u += stride) {
        const int tile = u >> 2, t0 = tile * 64, s0 = t0 & (SEQ - 1);
        for (int idx = tid; idx < 79 * 24; idx += 512) { const int rr = idx / 24, cq = idx - rr * 24; const int srel = s0 - 15 + rr;
            v4u x = (v4u){0u, 0u, 0u, 0u}; if (srel >= 0) x = *(const v4u*)(PROJ + (size_t)(t0 - 15 + rr) * NPROJ + C_PU + gp * 192 + cq * 8);
            *(LAS f32x4*)(U + rr * 192 + cq * 8) = (f32x4){bflo(x.x), bfhi(x.x), bflo(x.y), bfhi(x.y)}; *(LAS f32x4*)(U + rr * 192 + cq * 8 + 4) = (f32x4){bflo(x.z), bfhi(x.z), bflo(x.w), bfhi(x.w)}; }
        __syncthreads();
        for (int idx = tid; idx < 8 * 192; idx += 512) { const int run = idx / 192, cc = idx - run * 192, tokb = 8 * run;
            int sq = s0 + tokb; int cnt = (sq + 1) < w ? (sq + 1) : w;
            float sum = 0.f; for (int j = 0; j < cnt; ++j) sum += U[(15 + tokb - j) * 192 + cc];
            DA[tokb * 200 + cc] = (bf16)f2bf(sum / (float)cnt - U[(15 + tokb) * 192 + cc]);
#pragma unroll
            for (int i = 1; i < 8; ++i) { const int tok = tokb + i; sq = s0 + tok; const float ut = U[(15 + tok) * 192 + cc];
                sum += ut; if (sq >= w) sum -= U[(15 + tok - w) * 192 + cc];
                cnt = (sq + 1) < w ? (sq + 1) : w;
                DA[tok * 200 + cc] = (bf16)f2bf(sum / (float)cnt - ut); } }
        __syncthreads();
        {
            bf16x8_t db[6];
#pragma unroll
            for (int ks = 0; ks < 6; ++ks) db[ks] = *(const LAS bf16x8_t*)(DA + (16 * mt + c) * 200 + 32 * ks + 8 * g);
#pragma unroll
            for (int ni = 0; ni < 6; ++ni) { const int nt = 6 * nh + ni;
                f32x4 acc = (f32x4){0.f, 0.f, 0.f, 0.f};
#pragma unroll
                for (int ks = 0; ks < 6; ++ks) acc = __builtin_amdgcn_mfma_f32_16x16x32_bf16(wf[ni][ks], db[ks], acc, 0, 0, 0);
                v2u wv; wv.x = pk2(acc[0], acc[1]); wv.y = pk2(acc[2], acc[3]);
                *(v2u*)(YP + pg8::blk_off(t0 + 16 * mt + c, gp * 192 + 16 * nt + 4 * g, BRW)) = wv; }
        }
        __syncthreads();
    }
}

constexpr size_t GP_QT = 0, GP_KST = 12288, GP_A = 24576, GP_VT = 32768, GP_DEC = 57344, GP_ITEM = 57856;
__device__ __forceinline__ void gla_pre_items(LAS unsigned char* lds, const bf16* PROJ, const float* A2, const float* ba, unsigned char* GPRE, int first, int stride, int nitems) {
    int tid = threadIdx.x; asm volatile("" : "+v"(tid));
    if (first >= nitems) return;
    LAS float* LRs = (LAS float*)lds;
    LAS float* A2s = LRs + 64 * 16;
    LAS float* Bs = A2s + 16 * 96;
    LAS bf16* QTs = (LAS bf16*)(Bs + 64 * 96);
    LAS bf16* KTs = QTs + 64 * 104;
    LAS bf16* KSTs = KTs + 64 * 104;
    LAS bf16* VTs = KSTs + 96 * 72;
    v4u rlr = (v4u){0u, 0u, 0u, 0u}, rqk[3], rv[3]; float ra2[3];
#define PRE_LOAD(it_) do { const int bh_ = (it_) >> 5, h_ = bh_ & 3; const size_t tk_ = (size_t)((bh_ >> 2) * SEQ + ((it_) & 31) * 64); \
        if (tid < 128) rlr = *(const v4u*)(PROJ + (tk_ + (tid >> 1)) * NPROJ + C_LR + (tid & 1) * 8); \
        _Pragma("unroll") for (int i_ = 0; i_ < 3; ++i_) { const int idx_ = tid + 512 * i_, t_ = idx_ / 24, cq_ = idx_ - t_ * 24; \
            rqk[i_] = *(const v4u*)(PROJ + (tk_ + t_) * NPROJ + (cq_ < 12 ? C_QG + h_ * 96 + cq_ * 8 : C_KG + h_ * 96 + (cq_ - 12) * 8)); \
            rv[i_] = *(const v4u*)(PROJ + (tk_ + t_) * NPROJ + C_VG + h_ * 192 + cq_ * 8); \
            const int r_ = idx_ / 96, d_ = idx_ - r_ * 96; ra2[i_] = A2[r_ * 384 + h_ * 96 + d_]; } } while (0)
    PRE_LOAD(first);
#pragma unroll 1
    for (int item = first; item < nitems; item += stride) {
    const int bh = item >> 5, ch = item & 31, b = bh >> 2, h = bh & 3;
    unsigned char* gp = GPRE + (size_t)item * GP_ITEM;
    if (tid < 128) { const int t = tid >> 1, hq = tid & 1; const v4u w = rlr;
        *(LAS f32x4*)(LRs + t * 16 + hq * 8) = (f32x4){bflo(w.x), bfhi(w.x), bflo(w.y), bfhi(w.y)}; *(LAS f32x4*)(LRs + t * 16 + hq * 8 + 4) = (f32x4){bflo(w.z), bfhi(w.z), bflo(w.w), bfhi(w.w)}; }
#pragma unroll
    for (int i = 0; i < 3; ++i) { const int idx = tid + 512 * i, t = idx / 24, cq = idx - t * 24;
        if (cq < 12) *(LAS v4u*)(QTs + t * 104 + cq * 8) = rqk[i]; else *(LAS v4u*)(KTs + t * 104 + (cq - 12) * 8) = rqk[i];
        A2s[idx] = ra2[i];
        const v4u w = rv[i]; LAS bf16* vp = VTs + (cq * 8) * 72 + t;
        vp[0 * 72] = (bf16)(w.x & 0xffffu); vp[1 * 72] = (bf16)(w.x >> 16); vp[2 * 72] = (bf16)(w.y & 0xffffu); vp[3 * 72] = (bf16)(w.y >> 16);
        vp[4 * 72] = (bf16)(w.z & 0xffffu); vp[5 * 72] = (bf16)(w.z >> 16); vp[6 * 72] = (bf16)(w.w & 0xffffu); vp[7 * 72] = (bf16)(w.w >> 16); }
    if (item + stride < nitems) PRE_LOAD(item + stride);
    __syncthreads();
    {
        const int wv = __builtin_amdgcn_readfirstlane(tid >> 6), ln = tid & 63, g = ln >> 4, c = ln & 15;
#pragma unroll
        for (int rep3 = 0; rep3 < 3; ++rep3) { const int id = wv + 8 * rep3, tt = id / 6, dd = id - tt * 6;
            f32x4 z = (f32x4){0.f, 0.f, 0.f, 0.f};
#pragma unroll
            for (int ks = 0; ks < 4; ++ks) z = __builtin_amdgcn_mfma_f32_16x16x4f32(LRs[(16 * tt + c) * 16 + 4 * ks + g], A2s[(4 * ks + g) * 96 + 16 * dd + c], z, 0, 0, 0);
            const float bb = ba[h * 96 + 16 * dd + c];
#pragma unroll
            for (int r = 0; r < 4; ++r) { const float zz = z[r] + bb; const float ls = fminf(zz, 0.f) - __logf(1.0f + __expf(-fabsf(zz)));
                Bs[(16 * tt + 4 * g + r) * 96 + 16 * dd + c] = ls * (1.0f / 16.0f); } }
    }
    __syncthreads();
    if (tid < 96) { float gv[64];
#pragma unroll
        for (int t = 0; t < 64; ++t) gv[t] = Bs[t * 96 + tid];
        float run = 0.f;
#pragma unroll
        for (int t = 0; t < 64; ++t) { run += gv[t]; Bs[t * 96 + tid] = run; } }
    __syncthreads();
    const float qscale = 0.10206207261596575f;
    for (int idx = tid; idx < 64 * 96; idx += 512) { const int t = idx / 96, d = idx - t * 96;
        const float bb = Bs[idx], bl = Bs[63 * 96 + d];
        const float q = bf2f(QTs[t * 104 + d]), k = bf2f(KTs[t * 104 + d]);
        QTs[t * 104 + d] = (bf16)f2bf(q * qscale * __expf(bb)); KTs[t * 104 + d] = (bf16)f2bf(k * __expf(-bb)); KSTs[d * 72 + t] = (bf16)f2bf(k * __expf(bl - bb)); }
    if (tid < 96) ((float*)(gp + GP_DEC))[tid] = __expf(Bs[63 * 96 + tid]);
    __syncthreads();
    for (int idx = tid; idx < 64 * 12; idx += 512) { const int r = idx / 12, cq = idx - r * 12; *(v4u*)(gp + GP_QT + r * 192 + cq * 16) = *(const LAS v4u*)(QTs + r * 104 + cq * 8); }
    for (int idx = tid; idx < 96 * 8; idx += 512) { const int r = idx >> 3, cq = idx & 7; *(v4u*)(gp + GP_KST + r * 128 + cq * 16) = *(const LAS v4u*)(KSTs + r * 72 + cq * 8); }
    for (int idx = tid; idx < 192 * 8; idx += 512) { const int r = idx >> 3, cq = idx & 7; *(v4u*)(gp + GP_VT + r * 128 + cq * 16) = *(const LAS v4u*)(VTs + r * 72 + cq * 8); }
    {
        const int wave = __builtin_amdgcn_readfirstlane(tid >> 6), lane = tid & 63, g = lane >> 4, c = lane & 15;
#pragma unroll
        for (int rep = 0; rep < 2; ++rep) { const int id = wave + 8 * rep, it = id >> 2, jt = id & 3;
            f32x4 acc = (f32x4){0.f, 0.f, 0.f, 0.f};
            if (jt <= it) {
#pragma unroll
                for (int ks = 0; ks < 3; ++ks) { const bf16x8_t a = *(const LAS bf16x8_t*)(KTs + (16 * jt + c) * 104 + 32 * ks + 8 * g), bq = *(const LAS bf16x8_t*)(QTs + (16 * it + c) * 104 + 32 * ks + 8 * g);
                    acc = __builtin_amdgcn_mfma_f32_16x16x32_bf16(a, bq, acc, 0, 0, 0); } }
            const int i = 16 * it + c, j0 = 16 * jt + 4 * g;
            v2u w; w.x = pk2(j0 + 0 <= i ? acc[0] : 0.f, j0 + 1 <= i ? acc[1] : 0.f); w.y = pk2(j0 + 2 <= i ? acc[2] : 0.f, j0 + 3 <= i ? acc[3] : 0.f);
            *(v2u*)(gp + GP_A + i * 128 + j0 * 2) = w; }
    }
    __syncthreads();
    }
#undef PRE_LOAD
}
constexpr int GS_QT = 0, GS_KST = 13312, GS_A = 27136, GS_VT = 36352, GS_DEC = 45568, GS_BUF = 46080;
__device__ __forceinline__ void gla_scan_unit(LAS unsigned char* lds, const unsigned char* GPRE, float* GO, int u) {
    int tid = threadIdx.x; asm volatile("" : "+v"(tid));
    const int bh = u / 3, s3 = u - 3 * bh, b = bh >> 2, h = bh & 3;
    const int wave = __builtin_amdgcn_readfirstlane(tid >> 6), lane = tid & 63, g = lane >> 4, c = lane & 15, th = wave >> 2, jt = wave & 3;
    int goff[5], loff[5];
#pragma unroll
    for (int i = 0; i < 5; ++i) { const int q = tid + 512 * i;
        if (q < 768) { const int r = q / 12, cq = q - r * 12; goff[i] = (int)GP_QT + r * 192 + cq * 16; loff[i] = GS_QT + r * 208 + cq * 16; }
        else if (q < 1536) { const int p = q - 768, r = p >> 3, cq = p & 7; goff[i] = (int)GP_KST + r * 128 + cq * 16; loff[i] = GS_KST + r * 144 + cq * 16; }
        else if (q < 2048) { const int p = q - 1536, r = p >> 3, cq = p & 7; goff[i] = (int)GP_A + r * 128 + cq * 16; loff[i] = GS_A + r * 144 + cq * 16; }
        else { const int p = q - 2048, r = p >> 3, cq = p & 7; goff[i] = (int)GP_VT + (64 * s3 + r) * 128 + cq * 16; loff[i] = GS_VT + r * 144 + cq * 16; } }
    f32x4 S[6];
#pragma unroll
    for (int i = 0; i < 6; ++i) S[i] = (f32x4){0.f, 0.f, 0.f, 0.f};
    v4u rg[5]; v4u rd = (v4u){0u, 0u, 0u, 0u};
    { const unsigned char* gp = GPRE + (size_t)(bh * 32) * GP_ITEM;
#pragma unroll
      for (int i = 0; i < 5; ++i) rg[i] = *(const v4u*)(gp + goff[i]);
      if (tid < 24) rd = *(const v4u*)(gp + GP_DEC + tid * 16);
#pragma unroll
      for (int i = 0; i < 5; ++i) *(LAS v4u*)(lds + loff[i]) = rg[i];
      if (tid < 24) *(LAS v4u*)(lds + GS_DEC + tid * 16) = rd; }
    __syncthreads();
#pragma unroll 1
    for (int ch = 0; ch < 32; ++ch) {
        LAS unsigned char* cur = lds + (ch & 1) * GS_BUF; LAS unsigned char* nxt = lds + ((ch + 1) & 1) * GS_BUF;
        if (ch + 1 < 32) { const unsigned char* gp = GPRE + (size_t)(bh * 32 + ch + 1) * GP_ITEM;
#pragma unroll
            for (int i = 0; i < 5; ++i) rg[i] = *(const v4u*)(gp + goff[i]);
            if (tid < 24) rd = *(const v4u*)(gp + GP_DEC + tid * 16); }
        const size_t tokc = (size_t)(b * SEQ + ch * 64);
        bf16x8_t vb[2];
#pragma unroll
        for (int ks = 0; ks < 2; ++ks) vb[ks] = *(const LAS bf16x8_t*)(cur + GS_VT + (16 * jt + c) * 144 + (32 * ks + 8 * g) * 2);
        bf16x8_t sb[3];
#pragma unroll
        for (int ks = 0; ks < 3; ++ks) { v4u w; w.x = pk2(S[2 * ks][0], S[2 * ks][1]); w.y = pk2(S[2 * ks][2], S[2 * ks][3]); w.z = pk2(S[2 * ks + 1][0], S[2 * ks + 1][1]); w.w = pk2(S[2 * ks + 1][2], S[2 * ks + 1][3]);
            sb[ks] = __builtin_bit_cast(bf16x8_t, w); }
#pragma unroll
        for (int ti = 0; ti < 2; ++ti) { const int it = 2 * th + ti;
            f32x4 acc = (f32x4){0.f, 0.f, 0.f, 0.f};
#pragma unroll
            for (int ks = 0; ks < 2; ++ks) { const bf16x8_t a = *(const LAS bf16x8_t*)(cur + GS_A + (16 * it + c) * 144 + (32 * ks + 8 * g) * 2);
                acc = __builtin_amdgcn_mfma_f32_16x16x32_bf16(a, vb[ks], acc, 0, 0, 0); }
#pragma unroll
            for (int ks = 0; ks < 3; ++ks) { const v2u lo = *(const LAS v2u*)(cur + GS_QT + (16 * it + c) * 208 + (32 * ks + 4 * g) * 2), hi = *(const LAS v2u*)(cur + GS_QT + (16 * it + c) * 208 + (32 * ks + 16 + 4 * g) * 2);
                const v4u w = (v4u){lo.x, lo.y, hi.x, hi.y};
                acc = __builtin_amdgcn_mfma_f32_16x16x32_bf16(__builtin_bit_cast(bf16x8_t, w), sb[ks], acc, 0, 0, 0); }
            float* op = GO + (tokc + 16 * it + 4 * g) * BRW + h * 192 + 64 * s3 + 16 * jt + c;
            op[0 * BRW] = acc[0]; op[1 * BRW] = acc[1]; op[2 * BRW] = acc[2]; op[3 * BRW] = acc[3]; }
#pragma unroll
        for (int i = 0; i < 6; ++i) { const f32x4 d4 = *(const LAS f32x4*)(cur + GS_DEC + (16 * i + 4 * g) * 4);
            S[i] = S[i] * d4;
#pragma unroll
            for (int ks = 0; ks < 2; ++ks) { const bf16x8_t a = *(const LAS bf16x8_t*)(cur + GS_KST + (16 * i + c) * 144 + (32 * ks + 8 * g) * 2);
                S[i] = __builtin_amdgcn_mfma_f32_16x16x32_bf16(a, vb[ks], S[i], 0, 0, 0); } }
        if (ch + 1 < 32) {
#pragma unroll
            for (int i = 0; i < 5; ++i) *(LAS v4u*)(nxt + loff[i]) = rg[i];
            if (tid < 24) *(LAS v4u*)(nxt + GS_DEC + tid * 16) = rd; }
        __syncthreads();
    }
}
__device__ __forceinline__ void gla_norm_phase(const float* GO, const bf16* PROJ, const float* gnorm, bf16* YG, int gw, int NGW, int lane) {
    asm volatile("" : "+v"(lane));
    f32x4 gn[3];
#pragma unroll
    for (int j = 0; j < 3; ++j) gn[j] = *(const f32x4*)(gnorm + 12 * lane + 4 * j);
#pragma unroll 1
    for (int t0 = gw; t0 < NTOK; t0 += 4 * NGW) {
        f32x4 o[4][3]; v2u og[4][3];
#pragma unroll
        for (int q = 0; q < 4; ++q) { const int tq = t0 + q * NGW; const size_t t = (size_t)(tq < NTOK ? tq : t0);
#pragma unroll
            for (int j = 0; j < 3; ++j) { o[q][j] = *(const f32x4*)(GO + t * BRW + 12 * lane + 4 * j); og[q][j] = *(const v2u*)(PROJ + t * NPROJ + C_OG + 12 * lane + 4 * j); } }
#pragma unroll
        for (int q = 0; q < 4; ++q) { const int tq = t0 + q * NGW; if (tq >= NTOK) break; const size_t t = (size_t)tq;
            float ss = 0.f;
#pragma unroll
            for (int j = 0; j < 3; ++j) ss += (o[q][j].x * o[q][j].x + o[q][j].y * o[q][j].y) + (o[q][j].z * o[q][j].z + o[q][j].w * o[q][j].w);
            ss += __shfl_xor(ss, 1); ss += __shfl_xor(ss, 2); ss += __shfl_xor(ss, 4); ss += __shfl_xor(ss, 8);
            const float rstd = 1.0f / sqrtf(ss * (1.0f / 192.0f) + EPS);
#pragma unroll
            for (int j = 0; j < 3; ++j) { const float g0 = bflo(og[q][j].x), g1 = bfhi(og[q][j].x), g2 = bflo(og[q][j].y), g3 = bfhi(og[q][j].y);
                const float y0 = o[q][j].x * rstd * gn[j].x * (g0 / (1.0f + __expf(-g0))), y1 = o[q][j].y * rstd * gn[j].y * (g1 / (1.0f + __expf(-g1)));
                const float y2 = o[q][j].z * rstd * gn[j].z * (g2 / (1.0f + __expf(-g2))), y3 = o[q][j].w * rstd * gn[j].w * (g3 / (1.0f + __expf(-g3)));
                v2u w; w.x = pk2(y0, y1); w.y = pk2(y2, y3);
                *(v2u*)(YG + pg8::blk_off((int)t, 12 * lane + 4 * j, BRW)) = w; } }
    }
}

__global__ void __launch_bounds__(NWAVES * 64, 2) mega_fwd(Args A) {
    extern __shared__ __attribute__((aligned(16))) unsigned char lds_raw[];
    LAS unsigned char* lds = (LAS unsigned char*)lds_raw;
    const int tid = threadIdx.x;
    const int G = gridDim.x, bx = blockIdx.x;
    unsigned char* ws = A.ws;
    for (int u = tid; u < (LDS_BYTES - LDSCTL_OFF) / 4; u += NWAVES * 64) ((LAS unsigned*)(lds + LDSCTL_OFF))[u] = 0u;
    __syncthreads();
    XcdBarrier bar = xcd_barrier_post((unsigned*)(ws + WS_CTL) + CW_BAR, (volatile LAS unsigned*)(lds + MISC_OFF) + 8);

    float* X = (float*)(ws + WS_X); bf16* H = (bf16*)(ws + WS_H); bf16* ACT = (bf16*)(ws + WS_ACT); bf16* PROJ = (bf16*)(ws + WS_PROJ);
    bf16* Y = (bf16*)(ws + WS_Y); float* MACC = (float*)(ws + WS_MACC); bf16* MB = (bf16*)(ws + WS_MB); float* GO = (float*)(ws + WS_GO);
    const float* COS = (const float*)(ws + WS_ROPE); const float* SIN = COS + (size_t)NTOK * 32;

    { int t_ = threadIdx.x; asm volatile("" : "+v"(t_)); const int w_ = __builtin_amdgcn_readfirstlane(t_ >> 6); p0_prologue(A, lds, bx * NWAVES + w_, G * NWAVES, w_, t_ & 63); }
    conv_until(A, lds, TL_WO1, 0);
    xcd_barrier(bar);

#pragma unroll 1
    for (int step = 0; step < 3 * DEPTH; ++step) {
        const int l = step / 3, kind = step - 3 * l;
        unsigned char* wl = ws + WS_W + (size_t)l * LW_END;
        const unsigned long long* ssq = (const unsigned long long*)(ws + WS_CTL + CTL_SSQ) + (size_t)step * NTOK; unsigned long long* ssq_next = (unsigned long long*)(ws + WS_CTL + CTL_SSQ) + (size_t)(step + 1) * NTOK;
        if (kind != 1) {
            { pg8::Gemm g{H, (const bf16*)(wl + (kind == 0 ? LW_WI1 : LW_WI2)), NTOK, NWI, DM}; pg8::StaticOrder S; S.init(NTOK, NWI, G, bx);
              pg8::EpiSwiglu E{ACT, DFF, ssq};
              pg8::gemm_phase<pg8::EpiSwiglu, pg8::StaticOrder, true, true>(lds + RING_OFF, g, S, E); }
            { const int rem1 = ((NTOK / 256) * (NWI / 256)) % G;
              conv_until(A, lds, l * TL_LAYER + (kind == 0 ? TL_WIN : TL_LAYER), (rem1 != 0 && bx >= rem1) ? 3 : 0); }
            xcd_barrier(bar);
        } else {
            const bool std256 = (G == 256);
            unsigned char* XB8 = ws + WS_X;
#pragma unroll 1
            for (int part = 0; part < 3; ++part) {
                bool do16, do8; int i16, n16, g8, c8, i8, n8;
                if (std256) { do16 = part == 0 || (part == 1 && bx < 64); i16 = part ? 2 : 0; n16 = part ? 1 : 2;
                              do8 = (part == 1 && bx >= 64) || (part == 2 && bx < 128); g8 = part == 1 ? 192 : 128; c8 = part == 1 ? bx - 64 : bx; i8 = part == 1 ? 0 : 3; n8 = part == 1 ? 2 : 3; }
                else { do16 = part == 0; i16 = 0; n16 = 1 << 20; do8 = part == 1; g8 = G; c8 = bx; i8 = 0; n8 = 1 << 20; }
                if (do16) { pg8::Gemm g{H, (const bf16*)(wl + LW_WIN), NTOK, C_GATE, DM}; pg8::RangeOrder S; S.init(NTOK, C_GATE, G, bx); S.i0 = i16; S.n = n16;
                    pg8::EpiProj E{PROJ, NPROJ, (const float*)A.in[7] + (size_t)l * 6144, 1 << 20, ssq, 1.0f};
                    pg8::gemm_phase<pg8::EpiProj, pg8::RangeOrder, true, true>(lds + RING_OFF, g, S, E); }
                if (do8) { pg8::Gemm g{(const bf16*)XB8, (const bf16*)(wl + LW_WIN + WIN8_OFF), NTOK, 6144, DM / 2}; pg8::RangeOrder S; S.init(NTOK, 6144, g8, c8); S.i0 = i8; S.n = n8;
                    pg8::EpiProj E{PROJ + C_GATE, NPROJ, (const float*)A.in[7] + (size_t)l * 6144, 0, ssq, 1.0f / 2048.0f};
                    pg8::gemm_phase<pg8::EpiProj, pg8::RangeOrder, true, false, true>(lds + RING_OFF, g, S, E); }
                if (part == 1) xcd_barrier(bar);
                if (part == 2 && (!std256 || bx >= 128)) { const int mb = std256 ? bx - 128 : bx, ms = std256 ? 128 : G;
                    if ((ms & 3) == 0) pool_units(lds, PROJ, (const bf16*)(ws + WS_WPT) + (size_t)l * 4 * 192 * 192, Y + (size_t)NTOK * BRW, mb, ms, 512);
                    else for (int u = mb; u < 512; u += ms) pool_units(lds, PROJ, (const bf16*)(ws + WS_WPT) + (size_t)l * 4 * 192 * 192, Y + (size_t)NTOK * BRW, u, 512, 512);
                    gla_pre_items(lds, PROJ, (const float*)A.in[11] + (size_t)l * 16 * 384, (const float*)A.in[12] + l * 384, ws + WS_GPRE, mb, ms, 512); }
            }
            xcd_barrier(bar);
            if (G > 96) { if (bx < 48) gla_scan_unit(lds, ws + WS_GPRE, GO, bx);
                          else for (int u = bx - 48; u < 256; u += G - 48) att_unit(lds, PROJ, COS, SIN, (const float*)A.in[8] + l * 12, Y, u); }
            else { for (int u = bx; u < 48; u += G) gla_scan_unit(lds, ws + WS_GPRE, GO, u);
                   for (int u = bx; u < 256; u += G) att_unit(lds, PROJ, COS, SIN, (const float*)A.in[8] + l * 12, Y, u); }
            conv_until(A, lds, l * TL_LAYER + TL_WI2, (G > 96 && bx >= 48) ? ((bx - 48) + (G - 48) < 256 ? 1 : 3) : 0);
            xcd_barrier(bar);
            { int t_ = threadIdx.x; asm volatile("" : "+v"(t_)); gla_norm_phase(GO, PROJ, (const float*)A.in[13] + l * 768, Y + (size_t)2 * NTOK * BRW, bx * NWAVES + __builtin_amdgcn_readfirstlane(t_ >> 6), G * NWAVES, t_ & 63); }
            xcd_barrier(bar);
            { pg8::Gemm g{Y, (const bf16*)(wl + LW_WBR), NTOK, DM, BRW, (size_t)NTOK * BRW * 2, (size_t)DM * BRW * 2}; pg8::SegOrder S; S.init(NTOK, DM, G, bx); S.nseg = 3;
              pg8::EpiMergeSeg E{PROJ + C_GATE, NPROJ, DM, MB, DM};
              pg8::gemm_phase<pg8::EpiMergeSeg, pg8::SegOrder, true, true>(lds + RING_OFF, g, S, E); }
            xcd_barrier(bar);
        }
        { const bf16* Ap = (kind == 1) ? (const bf16*)MB : (const bf16*)ACT; const int Kd = (kind == 1) ? DM : DFF;
          const bf16* Bp = (const bf16*)(wl + (kind == 0 ? LW_WO1 : (kind == 1 ? LW_WOUT : LW_WO2)));
          pg8::Gemm g{Ap, Bp, NTOK, DM, Kd}; pg8::StaticOrder S; S.init(NTOK, DM, G, bx);
          pg8::EpiResid E{H, ssq_next, DM, kind == 1 ? 1.0f : 0.5f, kind == 0 ? ws + WS_X : nullptr};
          pg8::gemm_phase<pg8::EpiResid, pg8::StaticOrder, true, true>(lds + RING_OFF, g, S, E); }
        conv_until(A, lds, l * TL_LAYER + (kind == 0 ? TL_BRA : (kind == 1 ? TL_WO2 : TL_LAYER + TL_WO1)), 0);
        xcd_barrier(bar);
    }
    { int t_ = threadIdx.x; asm volatile("" : "+v"(t_)); final_phase(H, (const unsigned long long*)(ws + WS_CTL + CTL_SSQ) + (size_t)12 * NTOK, (const float*)A.in[21], A.out, bx * NWAVES + __builtin_amdgcn_readfirstlane(t_ >> 6), G * NWAVES, t_ & 63); }
}

extern "C" void kernel_launch(void* const* d_in, const int* in_sizes, int n_in, void* d_out, int out_size, void* d_ws, size_t ws_size, hipStream_t stream) {
    static int grid = 0;
    if (grid == 0) {
        if (n_in != 22 || in_sizes[0] != NTOK * DM || out_size != NTOK * DM || ws_size < WS_END) {
            fprintf(stderr, "kernel_launch: unexpected shapes (n_in %d, in0 %d, out %d, ws %zu < %zu); nothing launched\n", n_in, n_in > 0 ? in_sizes[0] : -1, out_size, ws_size, (size_t)WS_END); grid = -1; return; }
        int dev = 0, cus = 0, per_cu = 0;
        if (hipGetDevice(&dev) != hipSuccess || hipDeviceGetAttribute(&cus, hipDeviceAttributeMultiprocessorCount, dev) != hipSuccess) { grid = -1; return; }
        if (hipFuncSetAttribute((const void*)mega_fwd, hipFuncAttributeMaxDynamicSharedMemorySize, LDS_BYTES) != hipSuccess) { fprintf(stderr, "kernel_launch: hipFuncSetAttribute failed\n"); grid = -1; return; }
        if (hipOccupancyMaxActiveBlocksPerMultiprocessor(&per_cu, (const void*)mega_fwd, NWAVES * 64, LDS_BYTES) != hipSuccess || per_cu < 1) { fprintf(stderr, "kernel_launch: occupancy query says %d\n", per_cu); (void)hipGetLastError(); grid = -1; return; }
        grid = cus;
    }
    if (grid < 0) return;
    if (hipMemsetAsync((char*)d_ws + WS_CTL, 0, CTL_ZERO_BYTES, stream) != hipSuccess) return;
    Args a{};
    for (int i = 0; i < 22; ++i) a.in[i] = d_in[i];
    a.out = (float*)d_out; a.ws = (unsigned char*)d_ws;
    hipLaunchKernelGGL(mega_fwd, dim3(grid), dim3(NWAVES * 64), LDS_BYTES, stream, a);
}
```
